# Optimizing an MI355X kernel written in HIP

```python
import math
import jax, jax.numpy as jnp
from jax import lax
import numpy as np

D_MODEL = 1024
BATCH = 4
SEQ = 8192
DEPTH = 1

ATT_HEADS = 8
HEAD_DIM = 64
ATT_WIDTH = ATT_HEADS * HEAD_DIM
MOBA_BLOCK = 256
MOBA_TOPK = 3
Q_CHUNK = 64
ATT_SCALE = 1.0 / math.sqrt(HEAD_DIM)
SSM_WIDTH = D_MODEL // 2
SSM_GROUP = 16
SSM_GROUPS = SSM_WIDTH // SSM_GROUP
SSM_STATE = 64
DT_MIN = 1e-3
DT_MAX = 1e-1
D_FF = 2816
N_ADA = 9
EPS = 1e-6
NEG = -1e30
IN_SPLITS = [ATT_WIDTH, 2 * ATT_WIDTH, 3 * ATT_WIDTH, 3 * ATT_WIDTH + SSM_WIDTH,
             3 * ATT_WIDTH + SSM_WIDTH + D_MODEL]
IN_COLS = 3 * ATT_WIDTH + SSM_WIDTH + 2 * D_MODEL

kernel_name = "hybrid_moba_s5_macaron_adaln"


def rmsnorm(x, g):
    xf = x.astype(jnp.float32)
    y = xf * lax.rsqrt(jnp.mean(xf * xf, axis=-1, keepdims=True) + EPS)
    return (y * g.astype(jnp.float32)).astype(x.dtype)


def modulate(h, shift, scale):
    return h * (1.0 + scale[:, None, :]) + shift[:, None, :]


def swiglu(h, w_gu, w_down):
    g, u = jnp.split(h @ w_gu, 2, axis=-1)
    return (jax.nn.silu(g) * u) @ w_down


def alibi_slopes():
    return jnp.asarray([2.0 ** (-8.0 * (h + 1) / ATT_HEADS) for h in range(ATT_HEADS)],
                       dtype=jnp.float32)


def moba_attention(q, k, v):
    bsz, s = q.shape[0], q.shape[1]
    nb = -(-s // MOBA_BLOCK)
    s_pad = nb * MOBA_BLOCK
    n_sel = min(MOBA_TOPK, nb)
    pad = ((0, 0), (0, s_pad - s), (0, 0), (0, 0))
    q, k, v = [jnp.pad(t, pad).transpose(0, 2, 1, 3) for t in (q, k, v)]
    kb = k.reshape(bsz, ATT_HEADS, nb, MOBA_BLOCK, HEAD_DIM)
    vb = v.reshape(bsz, ATT_HEADS, nb, MOBA_BLOCK, HEAD_DIM)
    kmean = jnp.mean(kb.astype(jnp.float32), axis=3)
    slopes = alibi_slopes()[None, :, None, None]
    bi = jnp.arange(bsz)[:, None, None]
    hi = jnp.arange(ATT_HEADS)[None, :, None]
    blk_ids = jnp.arange(nb)
    key_off = jnp.arange(MOBA_BLOCK)

    def chunk(ci):
        q0 = ci * Q_CHUNK
        own = q0 // MOBA_BLOCK
        qc = lax.dynamic_slice_in_dim(q, q0, Q_CHUNK, axis=2)
        tq = (q0 + jnp.arange(Q_CHUNK)).astype(jnp.float32)
        gate = jnp.einsum('bhqd,bhnd->bhqn', qc.astype(jnp.float32), kmean)
        gate = jnp.where(blk_ids < own, gate, NEG)
        _, sel = lax.top_k(gate, n_sel)
        scores, vals = [], []
        for j in range(n_sel):
            idx = sel[..., j]
            kj = kb[bi, hi, idx]
            vj = vb[bi, hi, idx]
            sj = jnp.einsum('bhqd,bhqkd->bhqk', qc, kj).astype(jnp.float32) * ATT_SCALE
            kpos = (idx[..., None] * MOBA_BLOCK + key_off).astype(jnp.float32)
            sj = sj - slopes * (tq[:, None] - kpos)
            sj = jnp.where(j < own, sj, NEG)
            scores.append(sj)
            vals.append(vj)
        ko = lax.dynamic_slice_in_dim(k, own * MOBA_BLOCK, MOBA_BLOCK, axis=2)
        vo = lax.dynamic_slice_in_dim(v, own * MOBA_BLOCK, MOBA_BLOCK, axis=2)
        so = jnp.einsum('bhqd,bhkd->bhqk', qc, ko).astype(jnp.float32) * ATT_SCALE
        dist = tq[:, None] - (own * MOBA_BLOCK + key_off).astype(jnp.float32)[None, :]
        so = jnp.where(dist >= 0, so - slopes * dist, NEG)
        scores.append(so)
        p = jax.nn.softmax(jnp.concatenate(scores, axis=-1), axis=-1).astype(v.dtype)
        p = p.reshape(bsz, ATT_HEADS, Q_CHUNK, n_sel + 1, MOBA_BLOCK)
        out = jnp.einsum('bhqk,bhkd->bhqd', p[..., n_sel, :], vo)
        for j in range(n_sel):
            out = out + jnp.einsum('bhqk,bhqkd->bhqd', p[..., j, :], vals[j])
        return out

    out = lax.map(chunk, jnp.arange(s_pad // Q_CHUNK))
    out = out.transpose(1, 0, 3, 2, 4).reshape(bsz, s_pad, ATT_WIDTH)
    return out[:, :s]


def s5_mixer(u, lam_re, lam_im, log_dt, b_re, b_im, c_re, c_im, d_skip, w_glu, b_glu):
    bsz, s, _ = u.shape
    f32 = jnp.float32
    uf = u.astype(f32)
    ug = uf.reshape(bsz, s, SSM_GROUPS, SSM_GROUP)
    lr, li = lam_re.astype(f32), lam_im.astype(f32)
    dt = jnp.exp(log_dt.astype(f32))[:, None]
    mag = jnp.exp(lr * dt)
    ang = li * dt
    ab_re, ab_im = mag * jnp.cos(ang), mag * jnp.sin(ang)
    nr, ni = ab_re - 1.0, ab_im
    den = lr * lr + li * li
    f_re = (nr * lr + ni * li) / den
    f_im = (ni * lr - nr * li) / den
    br, bim = b_re.astype(f32), b_im.astype(f32)
    bb_re = f_re[..., None] * br - f_im[..., None] * bim
    bb_im = f_re[..., None] * bim + f_im[..., None] * br
    bu_re = jnp.einsum('bsgc,gpc->sbgp', ug, bb_re)
    bu_im = jnp.einsum('bsgc,gpc->sbgp', ug, bb_im)
    a_re = jnp.broadcast_to(ab_re, bu_re.shape)
    a_im = jnp.broadcast_to(ab_im, bu_im.shape)

    def combine(e1, e2):
        a1r, a1i, b1r, b1i = e1
        a2r, a2i, b2r, b2i = e2
        return (a2r * a1r - a2i * a1i,
                a2r * a1i + a2i * a1r,
                a2r * b1r - a2i * b1i + b2r,
                a2r * b1i + a2i * b1r + b2i)

    _, _, xr, xi = lax.associative_scan(combine, (a_re, a_im, bu_re, bu_im), axis=0)
    y = (jnp.einsum('sbgp,gcp->bsgc', xr, c_re.astype(f32))
         - jnp.einsum('sbgp,gcp->bsgc', xi, c_im.astype(f32)))
    y = y.reshape(bsz, s, SSM_WIDTH) + d_skip.astype(f32) * uf
    y = jax.nn.gelu(y)
    y = y * jax.nn.sigmoid(y @ w_glu.astype(f32) + b_glu.astype(f32))
    return y.astype(u.dtype)


def setup_inputs(seed: int = 0) -> dict:
    key = jax.random.key(seed)
    ks = jax.random.split(key, 32)
    n = lambda k, shape, s: jax.random.normal(k, shape, jnp.float32) * s
    L, D, G, P, C = DEPTH, D_MODEL, SSM_GROUPS, SSM_STATE, SSM_GROUP
    lam_im0 = jnp.pi * jnp.arange(P, dtype=jnp.float32)
    return {
        "x": n(ks[0], (BATCH, SEQ, D), 1.0),
        "c": n(ks[1], (BATCH, D), 1.0),
        "w_ada": n(ks[2], (L, D, N_ADA * D), D ** -0.5),
        "b_ada": n(ks[3], (L, N_ADA * D), 0.01),
        "norm_ffn1": 1.0 + n(ks[4], (L, D), 0.02),
        "w_ffn1_in": n(ks[5], (L, D, 2 * D_FF), D ** -0.5),
        "w_ffn1_out": n(ks[6], (L, D_FF, D), D_FF ** -0.5),
        "norm_mix": 1.0 + n(ks[7], (L, D), 0.02),
        "w_in": n(ks[8], (L, D, IN_COLS), D ** -0.5),
        "lam_re": -0.5 + n(ks[9], (L, G, P), 0.01),
        "lam_im": lam_im0 + n(ks[10], (L, G, P), 0.01),
        "log_dt": jax.random.uniform(ks[11], (L, G), jnp.float32,
                                     math.log(DT_MIN), math.log(DT_MAX)),
        "ssm_b_re": n(ks[12], (L, G, P, C), (2 * C) ** -0.5),
        "ssm_b_im": n(ks[13], (L, G, P, C), (2 * C) ** -0.5),
        "ssm_c_re": n(ks[14], (L, G, C, P), (2 * P) ** -0.5 * 4.0),
        "ssm_c_im": n(ks[15], (L, G, C, P), (2 * P) ** -0.5 * 4.0),
        "ssm_d": n(ks[16], (L, SSM_WIDTH), 1.0),
        "w_glu": n(ks[17], (L, SSM_WIDTH, SSM_WIDTH), SSM_WIDTH ** -0.5),
        "b_glu": n(ks[18], (L, SSM_WIDTH), 0.01),
        "w_br_att": n(ks[19], (L, ATT_WIDTH, D), ATT_WIDTH ** -0.5),
        "w_br_ssm": n(ks[20], (L, SSM_WIDTH, D), SSM_WIDTH ** -0.5),
        "w_out": n(ks[21], (L, D, D), D ** -0.5),
        "norm_ffn2": 1.0 + n(ks[22], (L, D), 0.02),
        "w_ffn2_in": n(ks[23], (L, D, 2 * D_FF), D ** -0.5),
        "w_ffn2_out": n(ks[24], (L, D_FF, D), D_FF ** -0.5),
        "norm_final": 1.0 + n(ks[25], (D,), 0.02),
    }


def reference(x, c, w_ada, b_ada, norm_ffn1, w_ffn1_in, w_ffn1_out, norm_mix, w_in,
              lam_re, lam_im, log_dt, ssm_b_re, ssm_b_im, ssm_c_re, ssm_c_im, ssm_d,
              w_glu, b_glu, w_br_att, w_br_ssm, w_out, norm_ffn2, w_ffn2_in, w_ffn2_out,
              norm_final):
    bsz, s, _ = x.shape
    for l in range(DEPTH):
        ada = jax.nn.silu(c) @ w_ada[l] + b_ada[l]
        sh1, sc1, g1, sh2, sc2, g2, sh3, sc3, g3 = jnp.split(ada, N_ADA, axis=-1)
        h = modulate(rmsnorm(x, norm_ffn1[l]), sh1, sc1)
        x = x + 0.5 * g1[:, None, :] * swiglu(h, w_ffn1_in[l], w_ffn1_out[l])
        h = modulate(rmsnorm(x, norm_mix[l]), sh2, sc2)
        q, k, v, u, ga, gs = jnp.split(h @ w_in[l], IN_SPLITS, axis=-1)
        hd = (bsz, s, ATT_HEADS, HEAD_DIM)
        y_att = moba_attention(q.reshape(hd), k.reshape(hd), v.reshape(hd))
        y_ssm = s5_mixer(u, lam_re[l], lam_im[l], log_dt[l], ssm_b_re[l], ssm_b_im[l],
                         ssm_c_re[l], ssm_c_im[l], ssm_d[l], w_glu[l], b_glu[l])
        merged = (jax.nn.sigmoid(ga) * (y_att @ w_br_att[l])
                  + jax.nn.sigmoid(gs) * (y_ssm @ w_br_ssm[l]))
        x = x + g2[:, None, :] * (merged @ w_out[l])
        h = modulate(rmsnorm(x, norm_ffn2[l]), sh3, sc3)
        x = x + 0.5 * g3[:, None, :] * swiglu(h, w_ffn2_in[l], w_ffn2_out[l])
    return rmsnorm(x, norm_final)
```

```cpp
#include <hip/hip_runtime.h>
#include <hip/hip_bf16.h>
#include <cstdio>
#include <cstdint>

#ifndef MK_N_LAUNCHES
#define MK_N_LAUNCHES 1
#endif

constexpr int BATCH = 4, SEQ = 8192, T = BATCH * SEQ, D = 1024, FF = 2816, NGU = 2 * FF, NIN = 4096, AW = 512, SW = 512, NH = 8, HD = 64;
constexpr int NBLK = 32, MBLK = 256;
constexpr int SG = 32, SC = 16, SP = 64, SL = 32, NCH = SEQ / SL, KSSM = SC * SL + 2 * SP;
constexpr int NADA = 9 * D;
constexpr float EPS = 1e-6f;
constexpr float LOG2E = 1.4426950408889634f;
constexpr float QSCALE = 0.125f * LOG2E;
constexpr int N_PHASES = 13;

constexpr size_t MiB = 1u << 20;
constexpr size_t WS_CTL = 0, CTL_ZERO_BYTES = 1 * MiB;
constexpr size_t WS_ADA = 1 * MiB;
constexpr size_t WS_CS2 = WS_ADA + 147456;
constexpr size_t WS_CS3 = WS_CS2 + 16384;
constexpr size_t WS_BIAS2 = WS_CS3 + 16384;
constexpr size_t WS_BIAS3 = WS_BIAS2 + 65536;
constexpr size_t WS_KMEANP = 1 * MiB + 512 * 1024;
constexpr size_t WS_SEL = 2 * MiB;
constexpr size_t WS_LSE = 3 * MiB;
constexpr size_t WS_ROWSS = 6 * MiB;
constexpr size_t WS_WINT = 8 * MiB, WS_WGLU = 16 * MiB, WS_WBRA = 17 * MiB, WS_WBRS = 18 * MiB, WS_WOUT = 19 * MiB;
constexpr size_t WS_W1T = 21 * MiB, WS_W2T = 32 * MiB, WS_W3T = 37 * MiB + 512 * 1024, WS_W4T = 48 * MiB + 512 * 1024;
constexpr size_t WS_BM = 54 * MiB, WS_BS = 74 * MiB;
constexpr size_t WS_ARENA = 82 * MiB;
constexpr size_t WS_SGA = WS_ARENA, WS_SGS = WS_ARENA + 64 * MiB;
constexpr size_t WS_Q = WS_ARENA + 128 * MiB, WS_K = WS_ARENA + 160 * MiB, WS_V = WS_ARENA + 192 * MiB;
constexpr size_t WS_PART = WS_ARENA + 224 * MiB;
constexpr size_t WS_Y1 = WS_ARENA + 320 * MiB;
constexpr size_t WS_SSMA = WS_ARENA + 352 * MiB;
constexpr size_t WS_YSSM = WS_ARENA + 352 * MiB, WS_YATT = WS_ARENA + 224 * MiB;
constexpr size_t WS_X1S = WS_ARENA + 224 * MiB, WS_ACT = WS_ARENA, WS_MERGED = WS_ARENA + 128 * MiB, WS_X2S = WS_ARENA + 224 * MiB;
constexpr size_t WS_END = WS_ARENA + 416 * MiB;
static_assert(WS_BIAS3 + 90112 <= WS_KMEANP && WS_W4T + (size_t)D * FF * 2 <= WS_BM && WS_BM + (size_t)SG * 512 * KSSM * 2 <= WS_BS && WS_BS + (size_t)SG * 256 * 512 * 2 <= WS_ARENA, "ws map");
static_assert((size_t)SG * 1024 * KSSM * 2 <= 40 * MiB && (size_t)T * FF * 2 <= 176 * MiB, "ws map 2");
constexpr int CW_BAR = 4096;
constexpr int CW_QUEUE = 256;

constexpr int RING_OFF = 0, RING_BYTES = 131072;
constexpr int SILU_OFF = 131072;
constexpr int LDS_BYTES = 163840;
constexpr int MISC_OFF = LDS_BYTES - 256;

#define GAS __attribute__((address_space(1)))
#define LAS __attribute__((address_space(3)))
typedef unsigned short bf16;
typedef unsigned v4u __attribute__((ext_vector_type(4)));
typedef unsigned v2u __attribute__((ext_vector_type(2)));
typedef float f32x4 __attribute__((ext_vector_type(4)));
typedef float f32x2 __attribute__((ext_vector_type(2)));
typedef short bf16x8 __attribute__((ext_vector_type(8)));
typedef GAS unsigned gu32;
#define RLX_AGENT __ATOMIC_RELAXED, __HIP_MEMORY_SCOPE_AGENT
#define LDS_WAIT() asm volatile("s_waitcnt lgkmcnt(0)" ::: "memory")
#define VM_WAIT() asm volatile("s_waitcnt vmcnt(0)" ::: "memory")
constexpr int NWAVES = 8;

__device__ __forceinline__ unsigned f2bf(float f) { unsigned u = __builtin_bit_cast(unsigned, f); return (u + 0x7fffu + ((u >> 16) & 1u)) >> 16; }
__device__ __forceinline__ unsigned pk2(float lo, float hi) { return f2bf(lo) | (f2bf(hi) << 16); }
__device__ __forceinline__ float bf2f(unsigned short h) { return __builtin_bit_cast(float, (unsigned)h << 16); }
__device__ __forceinline__ float bflo(unsigned w) { return __builtin_bit_cast(float, w << 16); }
__device__ __forceinline__ float bfhi(unsigned w) { return __builtin_bit_cast(float, w & 0xffff0000u); }
__device__ __forceinline__ float fast_exp2(float x) { return __builtin_amdgcn_exp2f(x); }
__device__ __forceinline__ float fast_rcp(float x) { return __builtin_amdgcn_rcpf(x); }
__device__ __forceinline__ float sigmoidf_(float x) { return fast_rcp(1.0f + fast_exp2(-LOG2E * x)); }
__device__ __forceinline__ float siluf_(float x) { return x * sigmoidf_(x); }
__device__ __forceinline__ float gelu_tanh(float v) { const float u = 1.5957691216057308f * (v + 0.044715f * v * v * v); return v * fast_rcp(1.0f + fast_exp2(-LOG2E * u)); }
__device__ __forceinline__ float wave_sum(float v) {
#pragma unroll
    for (int o = 1; o < 64; o <<= 1) v += __shfl_xor(v, o);
    return v;
}
__device__ __forceinline__ float wave_max(float v) {
#pragma unroll
    for (int o = 1; o < 64; o <<= 1) v = fmaxf(v, __shfl_xor(v, o));
    return v;
}

namespace pg8 {
#define PG8_LAS __attribute__((address_space(3)))
typedef unsigned short bf16_t;
typedef short bf16x8 __attribute__((ext_vector_type(8)));
typedef float f32x4 __attribute__((ext_vector_type(4)));
typedef unsigned u32x4 __attribute__((ext_vector_type(4)));
constexpr int BM = 256, BK = 64, HALF = 128, HTB = HALF * BK * 2, STAGE_BYTES = 8 * HTB, NXCD = 8, WGM = 8;

__host__ __device__ __forceinline__ int lds_byte(int r, int c) { const int st = (r >> 4) * 2 + (c >> 5), rr = r & 15, cc = c & 31, ob = rr * 64 + cc * 2; return st * 1024 + (ob ^ (((ob >> 9) & 1) << 5)); }
__host__ __device__ __forceinline__ void stage_rc(int b, int& R, int& C) { const int st = b / 1024, sb = b % 1024, swz = sb ^ (((sb >> 9) & 1) << 5); R = (st >> 1) * 16 + swz / 64; C = (st & 1) * 32 + (swz % 64) / 2; }
__host__ __device__ __forceinline__ int perm32(int rho) { const int n = rho >> 4, i = rho & 15; return 8 * (i >> 2) + 4 * n + (i & 3); }

struct Unit { int pm, pn; };
struct Gemm { const bf16_t* A; const bf16_t* Bt; int lda, ldb, K; const bf16_t* A2; const bf16_t* Bt2; int K2; };

struct StaticOrder {
    int nM, nN, nwg, G, c;
    __host__ __device__ void init(int M, int N, int G_, int c_) { nM = M / BM; nN = N / BM; nwg = nM * nN; G = G_; c = c_; }
    __host__ __device__ bool next(int i, Unit& u) const {
        const long L = (long)i * G + c; if (L >= nwg) return false;
        int wgid = (int)L; { const int q = nwg / NXCD, r = nwg % NXCD, xcd = wgid % NXCD, off = wgid / NXCD; wgid = (xcd < r ? xcd * (q + 1) : r * (q + 1) + (xcd - r) * q) + off; }
        const int nig = WGM * nN, gid = wgid / nig, fm = gid * WGM, gsz = (nM - fm) < WGM ? (nM - fm) : WGM;
        u.pm = fm + ((wgid % nig) % gsz); u.pn = (wgid % nig) / gsz; return true;
    }
};
struct BlockDiagOrder {
    int RM, RN, n, G, c, first;
    __host__ __device__ void init(int ngroups, int RM_, int RN_, int G_, int c_, int first_ = 0) { RM = RM_; RN = RN_; n = ngroups * RM_ * RN_; G = G_; c = c_; first = first_; }
    __host__ __device__ bool next(int i, Unit& u) const {
        const int L = i * G + c; if (L >= n || (first && i > 0)) return false;
        const int g = L / (RM * RN), r = L % (RM * RN); u.pm = g * RM + r / RN; u.pn = g * RN + r % RN; return true;
    }
};

__device__ __forceinline__ unsigned cvt_pk_bf16(float lo, float hi) { unsigned r; asm volatile("v_cvt_pk_bf16_f32 %0, %1, %2" : "=v"(r) : "v"(lo), "v"(hi)); return r; }

template <class Epi, class Sched, bool ALIGN_EPI = false, bool SP2 = true>
__device__ __forceinline__ void gemm_phase(PG8_LAS unsigned char* lds, const Gemm g, const Sched S, const Epi E) {
    const int tid = threadIdx.x, wid = __builtin_amdgcn_readfirstlane(tid >> 6), lane = tid & 63, wr = wid >> 2, wc = wid & 3, fr = lane & 15, fq = lane >> 4;
    const int nt1 = g.K / BK, nt = (g.K + g.K2) / BK;
    unsigned voffA[2], voffB[2];
#pragma unroll
    for (int i = 0; i < 2; ++i) { int R, C; stage_rc(tid * 16 + i * 8192, R, C); const int Rb = Epi::PERM ? ((R & ~31) + perm32(R & 31)) : R;
        voffA[i] = (unsigned)(R * g.lda + C) * 2u; voffB[i] = (unsigned)(Rb * g.ldb + C) * 2u; }
    const size_t kstep = (size_t)(BK * 2);
    const size_t hstepA = (size_t)HALF * g.lda * 2, hstepB = (size_t)HALF * g.ldb * 2;
    const size_t tstepA = 2 * hstepA, tstepB = 2 * hstepB;
    const unsigned ldsw = (unsigned)wid * 1024u;
    const int aoff = lds_byte(wr * 64 + fr, fq * 8), boff = lds_byte(wc * 32 + fr, fq * 8);
#define PG8_SA(b, h) (((b) * 2 + (h)) * HTB)
#define PG8_SB(b, h) ((4 + (b) * 2 + (h)) * HTB)
#define PG8_STAGE(bufoff, gbase, voff) do { _Pragma("unroll") for (int _i = 0; _i < 2; ++_i) \
        __builtin_amdgcn_global_load_lds((const unsigned*)((const char*)(gbase) + (voff)[_i]), (PG8_LAS unsigned*)(lds + (bufoff) + ldsw + _i * 8192), 16, 0, 0); } while (0)
#define PG8_LDA(dst, b, h) do { _Pragma("unroll") for (int m = 0; m < 4; ++m) _Pragma("unroll") for (int k = 0; k < 2; ++k) dst[m][k] = *(const PG8_LAS bf16x8*)(lds + PG8_SA(b, h) + aoff + m * 2048 + k * 1024); } while (0)
#define PG8_LDB(dst, b, h) do { _Pragma("unroll") for (int n = 0; n < 2; ++n) _Pragma("unroll") for (int k = 0; k < 2; ++k) dst[n][k] = *(const PG8_LAS bf16x8*)(lds + PG8_SB(b, h) + boff + n * 2048 + k * 1024); } while (0)
#define PG8_MMA(ai, bj, At, Bt) do { __builtin_amdgcn_s_setprio(1); _Pragma("unroll") for (int m = 0; m < 4; ++m) _Pragma("unroll") for (int n = 0; n < 2; ++n) _Pragma("unroll") for (int k = 0; k < 2; ++k) \
        acc[ai][bj][m][n] = __builtin_amdgcn_mfma_f32_16x16x32_bf16(Bt[n][k], At[m][k], acc[ai][bj][m][n], 0, 0, 0); __builtin_amdgcn_s_setprio(0); } while (0)
#define PG8_WAIT_V(n) asm volatile("s_waitcnt vmcnt(" #n ")" ::: "memory")
#define PG8_WAIT_L(n) asm volatile("s_waitcnt lgkmcnt(" #n ")" ::: "memory")
#define PG8_BAR __builtin_amdgcn_s_barrier()
#define PG8_SCHED __builtin_amdgcn_sched_barrier(0)
    Unit cur, nxt; int ui = 0;
    if (!S.next(0, cur)) return;
    f32x4 acc[2][2][4][2];
#pragma unroll
    for (int a = 0; a < 2; ++a)
#pragma unroll
        for (int b = 0; b < 2; ++b)
#pragma unroll
            for (int m = 0; m < 4; ++m)
#pragma unroll
                for (int n = 0; n < 2; ++n) acc[a][b][m][n] = (f32x4){0.f, 0.f, 0.f, 0.f};
    bf16x8 At[4][2], B0[2][2], B1[2][2];
    const char* cA = (const char*)g.A + (size_t)cur.pm * tstepA; const char* cB = (const char*)g.Bt + (size_t)cur.pn * tstepB;
    const char* cA2 = (const char*)g.A2 + (size_t)cur.pm * tstepA; const char* cB2 = (const char*)g.Bt2 + (size_t)cur.pn * tstepB;
    {
        PG8_STAGE(PG8_SB(0, 0), cB, voffB); PG8_STAGE(PG8_SB(0, 1), cB + hstepB, voffB); PG8_STAGE(PG8_SA(0, 0), cA, voffA); PG8_STAGE(PG8_SA(0, 1), cA + hstepA, voffA);
        if (wr == 1) PG8_BAR;
        PG8_WAIT_V(2); PG8_BAR;
        PG8_STAGE(PG8_SB(1, 0), cB + kstep, voffB); PG8_STAGE(PG8_SA(1, 0), cA + kstep, voffA); PG8_STAGE(PG8_SB(1, 1), cB + hstepB + kstep, voffB);
        PG8_WAIT_V(6); PG8_BAR;
    }
    for (;;) {
        const bool has_next = S.next(ui + 1, nxt);
        const char* nA = has_next ? (const char*)g.A + (size_t)nxt.pm * tstepA : cA; const char* nB = has_next ? (const char*)g.Bt + (size_t)nxt.pn * tstepB : cB;
        for (int t = 0; t < nt; t += 2) {
            const bool last = (t == nt - 2);
            if constexpr (Epi::HAS_MID) { if (t == nt1) E.mid(acc, cur, wr, wc, fr, fq); }
            const char* a0 = (t < nt1) ? cA + (size_t)t * kstep : cA2 + (size_t)(t - nt1) * kstep;
            const char* a1 = a0 + kstep;
            const char* a2 = last ? nA : ((t + 2 < nt1) ? cA + (size_t)(t + 2) * kstep : cA2 + (size_t)(t + 2 - nt1) * kstep);
            const char* b2 = last ? nB : ((t + 2 < nt1) ? cB + (size_t)(t + 2) * kstep : cB2 + (size_t)(t + 2 - nt1) * kstep);
            const char* a3 = a2 + kstep; const char* b3 = b2 + kstep;
            PG8_LDB(B0, 0, 0); PG8_LDB(B1, 0, 1); PG8_SCHED; PG8_LDA(At, 0, 0); PG8_STAGE(PG8_SA(1, 1), a1 + hstepA, voffA);
            PG8_WAIT_V(8); PG8_WAIT_L(0); PG8_BAR; PG8_MMA(0, 0, At, B0); PG8_MMA(0, 1, At, B1); PG8_BAR; PG8_SCHED;
            PG8_LDA(At, 0, 1); PG8_STAGE(PG8_SB(0, 0), b2, voffB); PG8_STAGE(PG8_SB(0, 1), b2 + hstepB, voffB); PG8_STAGE(PG8_SA(0, 0), a2, voffA);
            PG8_WAIT_V(8); PG8_WAIT_L(0); PG8_BAR; PG8_MMA(1, 0, At, B0); PG8_MMA(1, 1, At, B1); PG8_BAR; PG8_SCHED;
            PG8_LDB(B0, 1, 0); PG8_LDB(B1, 1, 1); PG8_SCHED; PG8_LDA(At, 1, 0); PG8_STAGE(PG8_SA(0, 1), a2 + hstepA, voffA);
            PG8_WAIT_V(8); PG8_WAIT_L(0); PG8_BAR; PG8_MMA(0, 0, At, B0); PG8_MMA(0, 1, At, B1); PG8_BAR; PG8_SCHED;
            PG8_LDA(At, 1, 1); PG8_STAGE(PG8_SB(1, 0), b3, voffB); PG8_STAGE(PG8_SB(1, 1), b3 + hstepB, voffB); PG8_STAGE(PG8_SA(1, 0), a3, voffA);
            PG8_WAIT_V(8); PG8_WAIT_L(0); PG8_BAR; PG8_MMA(1, 0, At, B0); PG8_MMA(1, 1, At, B1); PG8_BAR; PG8_SCHED;
        }
        if constexpr (ALIGN_EPI) { if (wr == 0) PG8_BAR; }
        if constexpr (!Epi::AFTER_DRAIN) { E(acc, cur, wr, wc, fr, fq); }
        if (!has_next) break;
#pragma unroll
        for (int a = 0; a < 2; ++a)
#pragma unroll
            for (int b = 0; b < 2; ++b)
#pragma unroll
                for (int m = 0; m < 4; ++m)
#pragma unroll
                    for (int n = 0; n < 2; ++n) acc[a][b][m][n] = (f32x4){0.f, 0.f, 0.f, 0.f};
        cur = nxt; cA = nA; cB = nB; ++ui;
        cA2 = (const char*)g.A2 + (size_t)cur.pm * tstepA; cB2 = (const char*)g.Bt2 + (size_t)cur.pn * tstepB;
        if constexpr (ALIGN_EPI) { if (wr == 1) PG8_BAR; }
    }
    PG8_WAIT_V(0);
    if constexpr (!ALIGN_EPI) { if (wr == 0) PG8_BAR; }
    PG8_BAR;
    if constexpr (Epi::AFTER_DRAIN) { E.fused(acc, cur, wr, wc, fr, fq, lds, wid, lane); }
#undef PG8_SA
#undef PG8_SB
#undef PG8_STAGE
#undef PG8_LDA
#undef PG8_LDB
#undef PG8_MMA
#undef PG8_WAIT_V
#undef PG8_WAIT_L
#undef PG8_BAR
#undef PG8_SCHED
}

__device__ __forceinline__ float row_rnorm(const float* rowss, int row) {
    const f32x4* p = (const f32x4*)(rowss + (size_t)row * 16);
    const f32x4 a = p[0], b = p[1], c = p[2], d = p[3];
    const float s = ((a[0] + a[1]) + (a[2] + a[3])) + ((b[0] + b[1]) + (b[2] + b[3])) + ((c[0] + c[1]) + (c[2] + c[3])) + ((d[0] + d[1]) + (d[2] + d[3]));
    return __builtin_amdgcn_rsqf(s * (1.0f / 1024.0f) + EPS);
}

template <bool NORM> struct EpiSwiGLU {
    static constexpr bool PERM = true, AFTER_DRAIN = false, HAS_MID = false;
    bf16_t* O; const float* rowss; const float* bias;
    __device__ __forceinline__ void operator()(const f32x4 (&acc)[2][2][4][2], const Unit& u, int wr, int wc, int fr, int fq) const {
        const int row0 = u.pm * BM + wr * 64 + fr, b = u.pm >> 5;
        const int colB0 = u.pn * BM + wc * 32 + 8 * fq, ocol0 = u.pn * 128 + wc * 32 + 8 * fq;
        f32x4 bg[2], bu[2];
#pragma unroll
        for (int n = 0; n < 2; ++n) { bg[n] = NORM ? *(const f32x4*)(bias + (size_t)b * NGU + colB0 + 4 * n) : (f32x4){0.f, 0.f, 0.f, 0.f}; bu[n] = NORM ? *(const f32x4*)(bias + (size_t)b * NGU + colB0 + 128 + 4 * n) : (f32x4){0.f, 0.f, 0.f, 0.f}; }
#pragma unroll
        for (int ai = 0; ai < 2; ++ai)
#pragma unroll
            for (int m = 0; m < 4; ++m) {
                const int row = row0 + ai * HALF + m * 16;
                const float r = NORM ? row_rnorm(rowss, row) : 1.0f;
                float o[8];
#pragma unroll
                for (int n = 0; n < 2; ++n) {
                    f32x4 gv = acc[ai][0][m][n], uv = acc[ai][1][m][n];
                    if (NORM) { gv = gv * r + bg[n]; uv = uv * r + bu[n]; }
#pragma unroll
                    for (int j = 0; j < 4; ++j) o[4 * n + j] = siluf_(gv[j]) * uv[j];
                }
                u32x4 w; w.x = cvt_pk_bf16(o[0], o[1]); w.y = cvt_pk_bf16(o[2], o[3]); w.z = cvt_pk_bf16(o[4], o[5]); w.w = cvt_pk_bf16(o[6], o[7]);
                *(u32x4*)(O + (size_t)row * FF + ocol0) = w;
            }
    }
};

template <bool XS, int TAG> struct EpiResid {
    static constexpr bool PERM = false, AFTER_DRAIN = false, HAS_MID = false;
    const float* xin; float* xout; const float* gate; bf16_t* xs; const float* cs; float* rowss; float gscale;
    __device__ __forceinline__ void operator()(const f32x4 (&acc)[2][2][4][2], const Unit& u, int wr, int wc, int fr, int fq) const {
        const int row0 = u.pm * BM + wr * 64 + fr, b = u.pm >> 5, col0 = u.pn * BM + wc * 32 + 4 * fq;
        f32x4 gv[2][2], cv[2][2];
#pragma unroll
        for (int bj = 0; bj < 2; ++bj)
#pragma unroll
            for (int n = 0; n < 2; ++n) { const f32x4 g_ = *(const f32x4*)(gate + (size_t)b * NADA + col0 + bj * HALF + n * 16); const float gsc = gscale;
                gv[bj][n] = (f32x4){g_[0] * gsc, g_[1] * gsc, g_[2] * gsc, g_[3] * gsc};
                cv[bj][n] = XS ? *(const f32x4*)(cs + (size_t)b * D + col0 + bj * HALF + n * 16) : (f32x4){0.f, 0.f, 0.f, 0.f}; }
#pragma unroll
        for (int ai = 0; ai < 2; ++ai)
#pragma unroll
            for (int m = 0; m < 4; ++m) {
                const int row = row0 + ai * HALF + m * 16; const size_t off = (size_t)row * D + col0;
                float ss = 0.f;
#pragma unroll
                for (int bj = 0; bj < 2; ++bj)
#pragma unroll
                    for (int n = 0; n < 2; ++n) {
                        const f32x4 xv = *(const f32x4*)(xin + off + bj * HALF + n * 16);
                        const f32x4 v = xv + gv[bj][n] * acc[ai][bj][m][n];
                        *(f32x4*)(xout + off + bj * HALF + n * 16) = v;
                        ss += (v[0] * v[0] + v[1] * v[1]) + (v[2] * v[2] + v[3] * v[3]);
                        if (XS) { const f32x4 s = v * cv[bj][n]; v2u w; w.x = cvt_pk_bf16(s[0], s[1]); w.y = cvt_pk_bf16(s[2], s[3]); *(v2u*)(xs + off + bj * HALF + n * 16) = w; }
                    }
                ss += __shfl_xor(ss, 16); ss += __shfl_xor(ss, 32);
                if (fq == 0) rowss[(size_t)row * 16 + u.pn * 4 + wc] = ss;
            }
    }
};

struct EpiIn {
    static constexpr bool PERM = true, AFTER_DRAIN = false, HAS_MID = false;
    const float* rowss; const float* bias; bf16_t* q; bf16_t* k; bf16_t* v; bf16_t* ssmA; bf16_t* sga; bf16_t* sgs; float* kmeanp;
    __device__ __forceinline__ void operator()(const f32x4 (&acc)[2][2][4][2], const Unit& u, int wr, int wc, int fr, int fq) const {
        const int row0 = u.pm * BM + wr * 64 + fr, b = u.pm >> 5, nb = u.pm & 31;
        const int c0 = u.pn * BM + wc * 32 + 8 * fq;
        const int region = u.pn >> 1;
        f32x4 bv[2][2];
#pragma unroll
        for (int bj = 0; bj < 2; ++bj)
#pragma unroll
            for (int n = 0; n < 2; ++n) bv[bj][n] = *(const f32x4*)(bias + (size_t)b * NIN + c0 + bj * HALF + 4 * n);
        float cs[2][8];
#pragma unroll
        for (int bj = 0; bj < 2; ++bj)
#pragma unroll
            for (int j = 0; j < 8; ++j) cs[bj][j] = 0.f;
#pragma unroll
        for (int ai = 0; ai < 2; ++ai)
#pragma unroll
            for (int m = 0; m < 4; ++m) {
                const int row = row0 + ai * HALF + m * 16;
                const float r = row_rnorm(rowss, row);
#pragma unroll
                for (int bj = 0; bj < 2; ++bj) {
                    const f32x4 v0 = acc[ai][bj][m][0] * r + bv[bj][0], v1 = acc[ai][bj][m][1] * r + bv[bj][1];
                    float o[8] = {v0[0], v0[1], v0[2], v0[3], v1[0], v1[1], v1[2], v1[3]};
                    const int c = c0 + bj * HALF;
                    bf16_t* dst;
                    if (region == 0) {
#pragma unroll
                        for (int j = 0; j < 8; ++j) o[j] *= QSCALE;
                        dst = q + (size_t)row * AW + c;
                    } else if (region == 1) {
#pragma unroll
                        for (int j = 0; j < 8; ++j) cs[bj][j] += o[j];
                        dst = k + (size_t)row * AW + (c - 512);
                    } else if (region == 2) {
                        dst = v + (size_t)row * AW + (c - 1024);
                    } else if (region == 3) {
                        const int cc = c - 1536, gidx = cc >> 4, ch = cc & 15, t = row & (SEQ - 1);
                        dst = ssmA + ((size_t)(gidx * 1024 + b * NCH + (t >> 5)) * KSSM + (t & 31) * SC + ch);
                    } else if (region < 6) {
#pragma unroll
                        for (int j = 0; j < 8; ++j) o[j] = sigmoidf_(o[j]);
                        dst = sga + (size_t)row * D + (c - 2048);
                    } else {
#pragma unroll
                        for (int j = 0; j < 8; ++j) o[j] = fmaxf(sigmoidf_(o[j]), 1e-30f);
                        dst = sgs + (size_t)row * D + (c - 3072);
                    }
                    u32x4 w; w.x = cvt_pk_bf16(o[0], o[1]); w.y = cvt_pk_bf16(o[2], o[3]); w.z = cvt_pk_bf16(o[4], o[5]); w.w = cvt_pk_bf16(o[6], o[7]);
                    *(u32x4*)dst = w;
                }
            }
        if (region == 1) {
#pragma unroll
            for (int bj = 0; bj < 2; ++bj)
#pragma unroll
                for (int j = 0; j < 8; ++j) { float s = cs[bj][j]; s += __shfl_xor(s, 1); s += __shfl_xor(s, 2); s += __shfl_xor(s, 4); s += __shfl_xor(s, 8); cs[bj][j] = s; }
            if (fr == 0) {
#pragma unroll
                for (int bj = 0; bj < 2; ++bj) {
                    float* dstp = kmeanp + ((size_t)((b * NBLK + nb) * 2 + wr) * AW + (c0 + bj * HALF - 512));
                    *(f32x4*)dstp = (f32x4){cs[bj][0], cs[bj][1], cs[bj][2], cs[bj][3]}; *(f32x4*)(dstp + 4) = (f32x4){cs[bj][4], cs[bj][5], cs[bj][6], cs[bj][7]};
                }
            }
        }
    }
};

struct EpiGlu {
    static constexpr bool PERM = true, AFTER_DRAIN = false, HAS_MID = false;
    const bf16_t* y1; const float* bglu; bf16_t* yssm;
    __device__ __forceinline__ void operator()(const f32x4 (&acc)[2][2][4][2], const Unit& u, int wr, int wc, int fr, int fq) const {
        const int row0 = u.pm * BM + wr * 64 + fr, c0 = u.pn * BM + wc * 32 + 8 * fq;
        f32x4 bv[2][2];
#pragma unroll
        for (int bj = 0; bj < 2; ++bj)
#pragma unroll
            for (int n = 0; n < 2; ++n) bv[bj][n] = *(const f32x4*)(bglu + c0 + bj * HALF + 4 * n);
#pragma unroll
        for (int ai = 0; ai < 2; ++ai)
#pragma unroll
            for (int m = 0; m < 4; ++m) {
                const int row = row0 + ai * HALF + m * 16;
#pragma unroll
                for (int bj = 0; bj < 2; ++bj) {
                    const size_t off = (size_t)row * SW + c0 + bj * HALF;
                    const u32x4 yv = *(const u32x4*)(y1 + off);
                    const f32x4 z0 = acc[ai][bj][m][0] + bv[bj][0], z1 = acc[ai][bj][m][1] + bv[bj][1];
                    float o[8];
                    o[0] = bflo(yv.x) * sigmoidf_(z0[0]); o[1] = bfhi(yv.x) * sigmoidf_(z0[1]); o[2] = bflo(yv.y) * sigmoidf_(z0[2]); o[3] = bfhi(yv.y) * sigmoidf_(z0[3]);
                    o[4] = bflo(yv.z) * sigmoidf_(z1[0]); o[5] = bfhi(yv.z) * sigmoidf_(z1[1]); o[6] = bflo(yv.w) * sigmoidf_(z1[2]); o[7] = bfhi(yv.w) * sigmoidf_(z1[3]);
                    u32x4 w; w.x = cvt_pk_bf16(o[0], o[1]); w.y = cvt_pk_bf16(o[2], o[3]); w.z = cvt_pk_bf16(o[4], o[5]); w.w = cvt_pk_bf16(o[6], o[7]);
                    *(u32x4*)(yssm + off) = w;
                }
            }
    }
};

struct EpiMerge {
    static constexpr bool PERM = true, AFTER_DRAIN = false, HAS_MID = true;
    const bf16_t* sga; const bf16_t* sgs; bf16_t* merged;
    __device__ __forceinline__ void mid(f32x4 (&acc)[2][2][4][2], const Unit& u, int wr, int wc, int fr, int fq) const {
        int row0 = u.pm * BM + wr * 64 + fr, c0 = u.pn * BM + wc * 32 + 8 * fq;
        asm volatile("" : "+v"(row0), "+v"(c0));
#pragma unroll
        for (int ai = 0; ai < 2; ++ai)
#pragma unroll
            for (int m = 0; m < 4; ++m)
#pragma unroll
                for (int bj = 0; bj < 2; ++bj) {
                    const size_t off = (size_t)(row0 + ai * HALF + m * 16) * D + c0 + bj * HALF;
                    const u32x4 a = *(const u32x4*)(sga + off), s = *(const u32x4*)(sgs + off);
                    f32x4 r0, r1;
                    r0[0] = bflo(a.x) * fast_rcp(bflo(s.x)); r0[1] = bfhi(a.x) * fast_rcp(bfhi(s.x)); r0[2] = bflo(a.y) * fast_rcp(bflo(s.y)); r0[3] = bfhi(a.y) * fast_rcp(bfhi(s.y));
                    r1[0] = bflo(a.z) * fast_rcp(bflo(s.z)); r1[1] = bfhi(a.z) * fast_rcp(bfhi(s.z)); r1[2] = bflo(a.w) * fast_rcp(bflo(s.w)); r1[3] = bfhi(a.w) * fast_rcp(bfhi(s.w));
                    acc[ai][bj][m][0] *= r0; acc[ai][bj][m][1] *= r1;
                    if (bj == 1) asm volatile("" ::: "memory");
                }
    }
    __device__ __forceinline__ void operator()(const f32x4 (&acc)[2][2][4][2], const Unit& u, int wr, int wc, int fr, int fq) const {
        const int row0 = u.pm * BM + wr * 64 + fr, c0 = u.pn * BM + wc * 32 + 8 * fq;
#pragma unroll
        for (int ai = 0; ai < 2; ++ai)
#pragma unroll
            for (int m = 0; m < 4; ++m)
#pragma unroll
                for (int bj = 0; bj < 2; ++bj) {
                    const size_t off = (size_t)(row0 + ai * HALF + m * 16) * D + c0 + bj * HALF;
                    const u32x4 s = *(const u32x4*)(sgs + off);
                    const f32x4 v0 = acc[ai][bj][m][0], v1 = acc[ai][bj][m][1];
                    u32x4 w; w.x = cvt_pk_bf16(v0[0] * bflo(s.x), v0[1] * bfhi(s.x)); w.y = cvt_pk_bf16(v0[2] * bflo(s.y), v0[3] * bfhi(s.y));
                    w.z = cvt_pk_bf16(v1[0] * bflo(s.z), v1[1] * bfhi(s.z)); w.w = cvt_pk_bf16(v1[2] * bflo(s.w), v1[3] * bfhi(s.w));
                    *(u32x4*)(merged + off) = w;
                    if (bj == 1) asm volatile("" ::: "memory");
                }
    }
};
}

#define XB_TMO      128
#define XB_XCNT(j)  (256  + 64 * (j))
#define XB_XSUB(j)  (1280 + 64 * (j))
#define XB_XGEN(j)  (2304 + 64 * (j))
#define XB_TOP      3328
#define XB_TOPGEN   3392
#define XCD_BAR_WORDS 3456
#define XB_SPIN_CAP (1u << 20)

__device__ __forceinline__ unsigned xb_ld(unsigned* p)              { return __hip_atomic_load(p, __ATOMIC_RELAXED, __HIP_MEMORY_SCOPE_AGENT); }
__device__ __forceinline__ unsigned xb_add(unsigned* p, unsigned v) { return __hip_atomic_fetch_add(p, v, __ATOMIC_RELAXED, __HIP_MEMORY_SCOPE_AGENT); }
__device__ __forceinline__ unsigned xb_xcc_id() { return (unsigned)__builtin_amdgcn_s_getreg((3 << 11) | 20) & 0xFu; }
#define XB_SPIN(cond, bar) do { unsigned _sp = 0; while (cond) { __builtin_amdgcn_s_sleep(1); \
    if ((++_sp & 255u) == 0u) { if (xb_ld(&(bar)[XB_TMO])) break; if (_sp > XB_SPIN_CAP) { atomicAdd(&(bar)[XB_TMO], 1u); break; } } } } while (0)

struct XcdBarrier { unsigned* bar; unsigned x; volatile LAS unsigned* st; };
__device__ __forceinline__ XcdBarrier xcd_barrier_post(unsigned* bar, volatile LAS unsigned* st) {
    XcdBarrier b; b.bar = bar; b.x = xb_xcc_id(); b.st = st;
    if (threadIdx.x == 0) (void)xb_add(&bar[XB_XCNT(b.x)], 1u);
    return b;
}
__device__ __forceinline__ void xcd_barrier_complete(unsigned* bar, unsigned x, unsigned& nloc, unsigned& nx) {
    const unsigned G = gridDim.x * gridDim.y * gridDim.z;
    unsigned sum, cnt, mine, sp = 0u;
    for (;;) {
        sum = 0u; cnt = 0u; mine = 0u;
#pragma unroll
        for (unsigned j = 0; j < 16; ++j) { const unsigned c = xb_ld(&bar[XB_XCNT(j)]); sum += c; cnt += (c > 0u) ? 1u : 0u; mine = (j == x) ? c : mine; }
        if (sum == G) break;
        __builtin_amdgcn_s_sleep(1);
        if ((++sp & 255u) == 0u) { if (xb_ld(&bar[XB_TMO])) break; if (sp > XB_SPIN_CAP) { atomicAdd(&bar[XB_TMO], 1u); break; } }
    }
    nloc = mine > 0u ? mine : 1u; nx = cnt > 0u ? cnt : 1u;
}
__device__ __forceinline__ void xcd_barrier(const XcdBarrier& b) {
    asm volatile("s_waitcnt vmcnt(0)" ::: "memory");
    __syncthreads();
    if (threadIdx.x == 0) {
        unsigned* bar = b.bar;
        __builtin_amdgcn_s_waitcnt(0);
        unsigned nloc = b.st[0], nx = b.st[1];
        if (nloc == 0u) { xcd_barrier_complete(bar, b.x, nloc, nx); b.st[0] = nloc; b.st[1] = nx; }
        const unsigned old = xb_add(&bar[XB_XSUB(b.x)], 1u);
        const unsigned gen = old / nloc;
        if (old + 1u == (gen + 1u) * nloc) {
            __builtin_amdgcn_fence(__ATOMIC_RELEASE, "agent");
            asm volatile("s_waitcnt vmcnt(0)" ::: "memory");
            const unsigned og = xb_add(&bar[XB_TOP], 1u);
            const unsigned tg = og / nx;
            if (og + 1u == (tg + 1u) * nx) xb_add(&bar[XB_TOPGEN], 1u);
            else XB_SPIN(xb_ld(&bar[XB_TOPGEN]) == tg, bar);
            __builtin_amdgcn_fence(__ATOMIC_ACQUIRE, "agent");
            xb_add(&bar[XB_XGEN(b.x)], 1u);
            asm volatile("s_waitcnt vmcnt(0)" ::: "memory");
        } else {
            XB_SPIN(xb_ld(&bar[XB_XGEN(b.x)]) == gen, bar);
            __builtin_amdgcn_fence(__ATOMIC_ACQUIRE, "agent");
            asm volatile("s_waitcnt vmcnt(0)" ::: "memory");
        }
    }
    __syncthreads();
}

struct Frame {
    LAS unsigned char* lds;
    volatile LAS unsigned* MISC;
    gu32* ctl;
    int tid, lane, wave, vcu, G;
    unsigned char* ws;
    const float* in[26];
    float* out;
};
enum { IN_X = 0, IN_C, IN_WADA, IN_BADA, IN_NFFN1, IN_WFFN1IN, IN_WFFN1OUT, IN_NMIX, IN_WIN, IN_LAMRE, IN_LAMIM, IN_LOGDT, IN_BRE, IN_BIM, IN_CRE, IN_CIM, IN_SSMD,
       IN_WGLU, IN_BGLU, IN_WBRATT, IN_WBRSSM, IN_WOUT, IN_NFFN2, IN_WFFN2IN, IN_WFFN2OUT, IN_NFINAL };

__device__ __forceinline__ int gu_row(int n) { return n < FF ? ((n >> 7) << 8) + (n & 127) : (((n - FF) >> 7) << 8) + 128 + ((n - FF) & 127); }
__device__ __forceinline__ void p0_transpose_item(const float* W, int K, int N, bf16* WT, int mode, LAS float* scr, int item, int lane) {
    const int nblk = N / 32, kb = item / nblk, nb = item % nblk, k0 = 64 * kb, n0 = 32 * nb;
    const int r0 = mode ? gu_row(n0) : n0;
#pragma unroll 8
    for (int i = 0; i < 32; ++i) { const int kk = 2 * i + (lane >> 5); scr[kk * 33 + (lane & 31)] = W[(size_t)(k0 + kk) * N + n0 + (lane & 31)]; }
    LDS_WAIT(); asm volatile("" ::: "memory");
    const int c = lane & 7;
#pragma unroll
    for (int j = 0; j < 4; ++j) { const int n = (lane >> 3) + 8 * j; const LAS float* s = scr + (8 * c) * 33 + n;
        v4u o; o.x = pk2(s[0 * 33], s[1 * 33]); o.y = pk2(s[2 * 33], s[3 * 33]); o.z = pk2(s[4 * 33], s[5 * 33]); o.w = pk2(s[6 * 33], s[7 * 33]);
        *(GAS v4u*)(WT + (size_t)(r0 + n) * K + k0 + 8 * c) = o; }
    LDS_WAIT(); asm volatile("" ::: "memory");
}

__device__ __forceinline__ void p0_prologue(Frame& F) {
    LAS float* sl = (LAS float*)(F.lds + SILU_OFF);
    for (int i = F.tid; i < BATCH * D; i += NWAVES * 64) sl[i] = siluf_(F.in[IN_C][i]);
    __syncthreads();
    LAS float* scr = (LAS float*)(F.lds + RING_OFF + F.wave * 16384);
    const int gw = F.vcu * NWAVES + F.wave, NGW = F.G * NWAVES;
    bf16* ws16 = (bf16*)F.ws;
    constexpr int I_ADA = NADA / 64;
    constexpr int I_UP = (D / 64) * (NGU / 32), I_DN = (FF / 64) * (D / 32), I_IN = (D / 64) * (NIN / 32), I_GLU = (SW / 64) * (SW / 32), I_BR = (AW / 64) * (D / 32), I_OUT = (D / 64) * (D / 32);
    constexpr int NITEMS = I_ADA + 2 * I_UP + 2 * I_DN + I_IN + I_GLU + 2 * I_BR + I_OUT;
    for (int it = gw; it < NITEMS; it += NGW) {
        int r = it;
        if (r < I_ADA) {
            const int n = r * 64 + F.lane; const float* W = F.in[IN_WADA] + n;
            float a0 = 0.f, a1 = 0.f, a2 = 0.f, a3 = 0.f;
#pragma unroll 2
            for (int k = 0; k < D; k += 4) {
                const f32x4 s0 = *(const LAS f32x4*)(sl + k), s1 = *(const LAS f32x4*)(sl + D + k), s2 = *(const LAS f32x4*)(sl + 2 * D + k), s3 = *(const LAS f32x4*)(sl + 3 * D + k);
#pragma unroll
                for (int i = 0; i < 4; ++i) { const float w = W[(size_t)(k + i) * NADA]; a0 += s0[i] * w; a1 += s1[i] * w; a2 += s2[i] * w; a3 += s3[i] * w; }
            }
            float* ada = (float*)(F.ws + WS_ADA); const float bb = F.in[IN_BADA][n];
            ada[n] = a0 + bb; ada[NADA + n] = a1 + bb; ada[2 * NADA + n] = a2 + bb; ada[3 * NADA + n] = a3 + bb;
            continue;
        }
        r -= I_ADA;
        if (r < I_UP) { p0_transpose_item(F.in[IN_WFFN1IN], D, NGU, ws16 + WS_W1T / 2, 1, scr, r, F.lane); continue; } r -= I_UP;
        if (r < I_UP) { p0_transpose_item(F.in[IN_WFFN2IN], D, NGU, ws16 + WS_W3T / 2, 1, scr, r, F.lane); continue; } r -= I_UP;
        if (r < I_DN) { p0_transpose_item(F.in[IN_WFFN1OUT], FF, D, ws16 + WS_W2T / 2, 0, scr, r, F.lane); continue; } r -= I_DN;
        if (r < I_DN) { p0_transpose_item(F.in[IN_WFFN2OUT], FF, D, ws16 + WS_W4T / 2, 0, scr, r, F.lane); continue; } r -= I_DN;
        if (r < I_IN) { p0_transpose_item(F.in[IN_WIN], D, NIN, ws16 + WS_WINT / 2, 0, scr, r, F.lane); continue; } r -= I_IN;
        if (r < I_GLU) { p0_transpose_item(F.in[IN_WGLU], SW, SW, ws16 + WS_WGLU / 2, 0, scr, r, F.lane); continue; } r -= I_GLU;
        if (r < I_BR) { p0_transpose_item(F.in[IN_WBRATT], AW, D, ws16 + WS_WBRA / 2, 0, scr, r, F.lane); continue; } r -= I_BR;
        if (r < I_BR) { p0_transpose_item(F.in[IN_WBRSSM], SW, D, ws16 + WS_WBRS / 2, 0, scr, r, F.lane); continue; } r -= I_BR;
        p0_transpose_item(F.in[IN_WOUT], D, D, ws16 + WS_WOUT / 2, 0, scr, r, F.lane);
    }
}

__device__ __forceinline__ void p1_phase(Frame& F) {
    const int gw = F.vcu * NWAVES + F.wave, NGW = F.G * NWAVES;
    const float* ada = (const float*)(F.ws + WS_ADA);
    for (int i = gw * 64 + F.lane; i < 2 * BATCH * D; i += NGW * 64) {
        const int which = i / (BATCH * D), r = i % (BATCH * D), b = r / D, c = r % D;
        const float gwt = which ? F.in[IN_NFFN2][c] : F.in[IN_NMIX][c];
        const float sc = ada[b * NADA + (which ? 7 : 4) * D + c];
        ((float*)(F.ws + (which ? WS_CS3 : WS_CS2)))[r] = gwt * (1.0f + sc);
    }
    for (int it = gw; it < NIN + NGU; it += NGW) {
        const bool second = it >= NIN; const int n = second ? it - NIN : it;
        const bf16* wrow = (const bf16*)(F.ws + (second ? WS_W3T : WS_WINT)) + (size_t)n * D;
        const float* sh = ada + (second ? 6 : 3) * D;
        float a[4] = {0.f, 0.f, 0.f, 0.f};
#pragma unroll
        for (int j = 0; j < 2; ++j) {
            const int k = 8 * F.lane + 512 * j;
            const v4u w = *(const GAS v4u*)(wrow + k);
            const float wf[8] = {bflo(w.x), bfhi(w.x), bflo(w.y), bfhi(w.y), bflo(w.z), bfhi(w.z), bflo(w.w), bfhi(w.w)};
#pragma unroll
            for (int b = 0; b < 4; ++b) { const f32x4 s0 = *(const f32x4*)(sh + b * NADA + k), s1 = *(const f32x4*)(sh + b * NADA + k + 4);
                a[b] += wf[0] * s0[0] + wf[1] * s0[1] + wf[2] * s0[2] + wf[3] * s0[3] + wf[4] * s1[0] + wf[5] * s1[1] + wf[6] * s1[2] + wf[7] * s1[3]; }
        }
#pragma unroll
        for (int b = 0; b < 4; ++b) a[b] = wave_sum(a[b]);
        if (F.lane == 0) { float* dst = (float*)(F.ws + (second ? WS_BIAS3 : WS_BIAS2)); const int N = second ? NGU : NIN;
#pragma unroll
            for (int b = 0; b < 4; ++b) dst[b * N + n] = a[b]; }
    }
    bf16* h1 = (bf16*)F.out;
    for (int m = gw; m < T; m += NGW) {
        const int b = m / SEQ;
        const GAS f32x4* xr = (const GAS f32x4*)(F.in[IN_X] + (size_t)m * D) + F.lane;
        f32x4 v[4]; float s = 0.f;
#pragma unroll
        for (int j = 0; j < 4; ++j) { v[j] = xr[64 * j]; s += (v[j].x * v[j].x + v[j].y * v[j].y) + (v[j].z * v[j].z + v[j].w * v[j].w); }
        const float rstd = __builtin_amdgcn_rsqf(wave_sum(s) * (1.f / D) + EPS);
        GAS unsigned long long* o8 = (GAS unsigned long long*)(h1 + (size_t)m * D) + F.lane;
#pragma unroll
        for (int j = 0; j < 4; ++j) {
            const int c = 4 * F.lane + 256 * j;
            const f32x4 g = *(const f32x4*)(F.in[IN_NFFN1] + c), sh = *(const f32x4*)(ada + b * NADA + c), sc = *(const f32x4*)(ada + b * NADA + D + c);
            const f32x4 h = v[j] * rstd * g * (sc + 1.0f) + sh;
            o8[64 * j] = (unsigned long long)pk2(h.x, h.y) | ((unsigned long long)pk2(h.z, h.w) << 32);
        }
    }
}

__device__ __forceinline__ void final_norm_phase(Frame& F) {
    const int gw = F.vcu * NWAVES + F.wave, NGW = F.G * NWAVES;
    const float* rowss = (const float*)(F.ws + WS_ROWSS);
    for (int m = gw; m < T; m += NGW) {
        const float r = pg8::row_rnorm(rowss, m);
        GAS f32x4* xr = (GAS f32x4*)(F.out + (size_t)m * D) + F.lane;
#pragma unroll
        for (int j = 0; j < 4; ++j) { const f32x4 g = *(const f32x4*)(F.in[IN_NFINAL] + 4 * F.lane + 256 * j); xr[64 * j] = xr[64 * j] * r * g; }
    }
}

__device__ __forceinline__ void gating_phase(Frame& F) {
    LAS float* km = (LAS float*)(F.lds + RING_OFF);
    const float* kmeanp = (const float*)(F.ws + WS_KMEANP);
    const bf16* q = (const bf16*)(F.ws + WS_Q);
    unsigned* sel = (unsigned*)(F.ws + WS_SEL);
    constexpr int NITEM = BATCH * NH * NBLK;
    for (int it = F.vcu; it < NITEM; it += F.G) {
        const int i = it & 31, h = (it >> 5) & 7, b = it >> 8;
        __syncthreads();
        for (int e = F.tid; e < i * 64; e += NWAVES * 64) { const int n = e >> 6, d = e & 63;
            km[e] = (kmeanp[(size_t)((b * NBLK + n) * 2 + 0) * AW + h * HD + d] + kmeanp[(size_t)((b * NBLK + n) * 2 + 1) * AW + h * HD + d]) * (1.0f / 256.0f); }
        __syncthreads();
        const int ql = F.lane & 31, half = F.lane >> 5, t = i * MBLK + F.wave * 32 + ql;
        const bf16* qrow = q + (size_t)(b * SEQ + t) * AW + h * HD;
        float qf[64];
#pragma unroll
        for (int c = 0; c < 8; ++c) { const v4u w = *(const GAS v4u*)(qrow + 8 * c);
            qf[8 * c + 0] = bflo(w.x); qf[8 * c + 1] = bfhi(w.x); qf[8 * c + 2] = bflo(w.y); qf[8 * c + 3] = bfhi(w.y); qf[8 * c + 4] = bflo(w.z); qf[8 * c + 5] = bfhi(w.z); qf[8 * c + 6] = bflo(w.w); qf[8 * c + 7] = bfhi(w.w); }
        float v0 = -3e38f, v1 = -3e38f, v2 = -3e38f; int i0 = 255, i1 = 255, i2 = 255;
        for (int n = half; n < i; n += 2) {
            const LAS f32x4* kr = (const LAS f32x4*)(km + n * 64);
            float dot = 0.f;
#pragma unroll
            for (int c = 0; c < 16; ++c) { const f32x4 kv = kr[c]; dot += qf[4 * c] * kv[0] + qf[4 * c + 1] * kv[1] + qf[4 * c + 2] * kv[2] + qf[4 * c + 3] * kv[3]; }
            if (dot > v0) { v2 = v1; i2 = i1; v1 = v0; i1 = i0; v0 = dot; i0 = n; }
            else if (dot > v1) { v2 = v1; i2 = i1; v1 = dot; i1 = n; }
            else if (dot > v2) { v2 = dot; i2 = n; }
        }
        const float ov[3] = {__shfl_xor(v0, 32), __shfl_xor(v1, 32), __shfl_xor(v2, 32)};
        const int oi[3] = {__shfl_xor(i0, 32), __shfl_xor(i1, 32), __shfl_xor(i2, 32)};
#pragma unroll
        for (int k = 0; k < 3; ++k) {
            const float d = ov[k]; const int n = oi[k];
            if (d > v0 || (d == v0 && n < i0)) { v2 = v1; i2 = i1; v1 = v0; i1 = i0; v0 = d; i0 = n; }
            else if (d > v1 || (d == v1 && n < i1)) { v2 = v1; i2 = i1; v1 = d; i1 = n; }
            else if (d > v2 || (d == v2 && n < i2)) { v2 = d; i2 = n; }
        }
        if (half == 0) sel[(size_t)(b * NH + h) * SEQ + t] = (unsigned)i0 | ((unsigned)i1 << 8) | ((unsigned)i2 << 16);
    }
}

__device__ __forceinline__ void attn_simple_phase(Frame& F) {
    LAS float* qs = (LAS float*)(F.lds + RING_OFF + F.wave * 8192);
    LAS float* pb = qs + 64;
    const bf16* q = (const bf16*)(F.ws + WS_Q); const bf16* k = (const bf16*)(F.ws + WS_K); const bf16* v = (const bf16*)(F.ws + WS_V);
    const unsigned* sel = (const unsigned*)(F.ws + WS_SEL);
    bf16* yatt = (bf16*)(F.ws + WS_YATT);
    const int gw = F.vcu * NWAVES + F.wave, NGW = F.G * NWAVES;
    for (int id = gw; id < BATCH * NH * SEQ; id += NGW) {
        const int t = id & (SEQ - 1), h = (id >> 13) & 7, b = id >> 16;
        const int own = t >> 8, nvalid = own < 3 ? own : 3;
        const float slope2 = exp2f(-(float)(h + 1)) * LOG2E;
        const size_t rowq = (size_t)(b * SEQ + t) * AW + h * HD;
        qs[F.lane] = bf2f(q[rowq + F.lane]);
        LDS_WAIT(); asm volatile("" ::: "memory");
        float qf[64];
#pragma unroll
        for (int c = 0; c < 16; ++c) { const f32x4 x = *(const LAS f32x4*)(qs + 4 * c); qf[4 * c] = x[0]; qf[4 * c + 1] = x[1]; qf[4 * c + 2] = x[2]; qf[4 * c + 3] = x[3]; }
        const unsigned sw = sel[(size_t)(b * NH + h) * SEQ + t];
        int blk[4]; blk[0] = sw & 255; blk[1] = (sw >> 8) & 255; blk[2] = (sw >> 16) & 255; blk[3] = own;
        float sc[16]; float mx = -1e30f;
#pragma unroll
        for (int s = 0; s < 4; ++s) {
            const bool valid = (s == 3) || (s < nvalid);
#pragma unroll
            for (int kk = 0; kk < 4; ++kk) {
                float val = -1e30f;
                if (valid) {
                    const int kpos = blk[s] * MBLK + kk * 64 + F.lane;
                    if (s < 3 || kpos <= t) {
                        const bf16* kr = k + (size_t)(b * SEQ + kpos) * AW + h * HD;
                        float dot = 0.f;
#pragma unroll
                        for (int c = 0; c < 8; ++c) { const v4u w = *(const GAS v4u*)(kr + 8 * c);
                            dot += qf[8 * c] * bflo(w.x) + qf[8 * c + 1] * bfhi(w.x) + qf[8 * c + 2] * bflo(w.y) + qf[8 * c + 3] * bfhi(w.y) + qf[8 * c + 4] * bflo(w.z) + qf[8 * c + 5] * bfhi(w.z) + qf[8 * c + 6] * bflo(w.w) + qf[8 * c + 7] * bfhi(w.w); }
                        val = dot + slope2 * (float)(kpos - t);
                    }
                }
                sc[s * 4 + kk] = val; mx = fmaxf(mx, val);
            }
        }
        mx = wave_max(mx);
        float l = 0.f;
#pragma unroll
        for (int i = 0; i < 16; ++i) { const float p = fast_exp2(sc[i] - mx); l += p; pb[i * 64 + F.lane] = p; }
        l = wave_sum(l);
        LDS_WAIT(); asm volatile("" ::: "memory");
        float o = 0.f;
#pragma unroll
        for (int s = 0; s < 4; ++s) {
            const bool valid = (s == 3) || (s < nvalid);
            if (!valid) continue;
            const int nk = (s == 3) ? (t & 255) + 1 : 256;
            const bf16* vb = v + (size_t)(b * SEQ + blk[s] * MBLK) * AW + h * HD + F.lane;
            const LAS float* pp = pb + s * 256;
#pragma unroll 8
            for (int j = 0; j < nk; ++j) o += pp[j] * bf2f(vb[(size_t)j * AW]);
        }
        yatt[rowq + F.lane] = (bf16)f2bf(o / l);
        LDS_WAIT(); asm volatile("" ::: "memory");
    }
}

__device__ __forceinline__ void ssm_simple_phase(Frame& F) {
    const int gw = F.vcu * NWAVES + F.wave;
    if (gw >= BATCH * SG) return;
    const int g = gw % SG, b = gw / SG, p = F.lane;
    const float lr = F.in[IN_LAMRE][g * SP + p], li = F.in[IN_LAMIM][g * SP + p], dt = expf(F.in[IN_LOGDT][g]);
    const float mag = expf(lr * dt), ang = li * dt;
    float sn_, cs_; sincosf(ang, &sn_, &cs_);
    const float ar = mag * cs_, ai = mag * sn_;
    const float nr = ar - 1.0f, ni = ai, den = lr * lr + li * li;
    const float fr = (nr * lr + ni * li) / den, fi = (ni * lr - nr * li) / den;
    float bbr[16], bbi[16], cr[16], ci[16];
#pragma unroll
    for (int c = 0; c < 16; ++c) {
        const float br = F.in[IN_BRE][(g * SP + p) * SC + c], bi = F.in[IN_BIM][(g * SP + p) * SC + c];
        bbr[c] = fr * br - fi * bi; bbi[c] = fr * bi + fi * br;
        cr[c] = F.in[IN_CRE][(g * SC + c) * SP + p]; ci[c] = F.in[IN_CIM][(g * SC + c) * SP + p];
    }
    const bf16* A = (const bf16*)(F.ws + WS_SSMA);
    bf16* y1 = (bf16*)(F.ws + WS_Y1);
    const float dsk = F.in[IN_SSMD][g * SC + (F.lane & 15)];
    float xr = 0.f, xi = 0.f;
    for (int t = 0; t < SEQ; ++t) {
        const bf16* urow = A + ((size_t)(g * 1024 + b * NCH + (t >> 5)) * KSSM + (t & 31) * SC);
        const float ul = bf2f(urow[F.lane & 15]);
        float bur = 0.f, bui = 0.f;
#pragma unroll
        for (int c = 0; c < 16; ++c) { const float uc = __shfl(ul, c); bur += bbr[c] * uc; bui += bbi[c] * uc; }
        const float nxr = ar * xr - ai * xi + bur, nxi = ar * xi + ai * xr + bui;
        xr = nxr; xi = nxi;
        float yv = 0.f;
#pragma unroll
        for (int c = 0; c < 16; ++c) { const float part = wave_sum(cr[c] * xr - ci[c] * xi); if ((F.lane & 15) == c) yv = part; }
        if (F.lane < 16) { const float val = yv + dsk * ul; y1[(size_t)(b * SEQ + t) * SW + g * SC + F.lane] = (bf16)f2bf(gelu_tanh(val)); }
    }
}

struct Args { const float* in[26]; float* out; unsigned char* ws; int ph_lo, ph_hi, li, pad; };

__global__ void __launch_bounds__(NWAVES * 64, 2) hybrid_fwd(Args args) {
    extern __shared__ __attribute__((aligned(16))) unsigned char lds[];
    Frame F;
    F.lds = (LAS unsigned char*)lds;
    F.MISC = (volatile LAS unsigned*)(F.lds + MISC_OFF);
    F.tid = threadIdx.x; F.lane = F.tid & 63; F.wave = __builtin_amdgcn_readfirstlane(F.tid >> 6);
    F.G = gridDim.x; { const int bx = blockIdx.x; F.vcu = (F.G % 8 == 0) ? (bx % 8) * (F.G / 8) + bx / 8 : bx; }
    F.ws = args.ws; F.ctl = (gu32*)(args.ws + WS_CTL); F.out = args.out;
#pragma unroll
    for (int i = 0; i < 26; ++i) F.in[i] = args.in[i];
    for (int u = F.tid; u < 64; u += NWAVES * 64) ((LAS unsigned*)(F.lds + MISC_OFF))[u] = 0u;
    __syncthreads();
    XcdBarrier bar; bar.bar = (unsigned*)(F.ctl + CW_BAR); bar.x = 0; bar.st = nullptr;
    if (MK_N_LAUNCHES == 1) bar = xcd_barrier_post((unsigned*)(F.ctl + CW_BAR), F.MISC + 8);
#define GRID_BAR() do { if (MK_N_LAUNCHES == 1) xcd_barrier(bar); } while (0)
    const int lo = args.ph_lo, hi = args.ph_hi;
#define IN(k) (lo <= (k) && (k) < hi)
#define BOTH(k) (IN(k) && IN((k) + 1))
    unsigned char* ws = args.ws;
    const float* ada = (const float*)(ws + WS_ADA);
    float* rowss = (float*)(ws + WS_ROWSS);
    const int bx = (int)blockIdx.x;

    if (IN(0)) { p0_prologue(F); if (BOTH(0)) GRID_BAR(); }
    if (IN(1)) { p1_phase(F); if (BOTH(1)) GRID_BAR(); }
    if (IN(2)) {
        pg8::Gemm g{(const bf16*)F.out, (const bf16*)(ws + WS_W1T), D, D, D, nullptr, nullptr, 0}; pg8::StaticOrder S; S.init(T, NGU, F.G, bx);
        pg8::EpiSwiGLU<false> E{(bf16*)(ws + WS_ACT), nullptr, nullptr};
        pg8::gemm_phase<pg8::EpiSwiGLU<false>, pg8::StaticOrder, true>(F.lds + RING_OFF, g, S, E);
        if (BOTH(2)) GRID_BAR();
    }
    if (IN(3)) {
        pg8::Gemm g{(const bf16*)(ws + WS_ACT), (const bf16*)(ws + WS_W2T), FF, FF, FF, nullptr, nullptr, 0}; pg8::StaticOrder S; S.init(T, D, F.G, bx);
        pg8::EpiResid<true, 0> E{F.in[IN_X], F.out, ada + 2 * D, (bf16*)(ws + WS_X1S), (const float*)(ws + WS_CS2), rowss, 0.5f};
        pg8::gemm_phase<pg8::EpiResid<true, 0>, pg8::StaticOrder, true>(F.lds + RING_OFF, g, S, E);
        if (BOTH(3)) GRID_BAR();
    }
    if (IN(4)) {
        pg8::Gemm g{(const bf16*)(ws + WS_X1S), (const bf16*)(ws + WS_WINT), D, D, D, nullptr, nullptr, 0}; pg8::StaticOrder S; S.init(T, NIN, F.G, bx);
        pg8::EpiIn E{rowss, (const float*)(ws + WS_BIAS2), (bf16*)(ws + WS_Q), (bf16*)(ws + WS_K), (bf16*)(ws + WS_V), (bf16*)(ws + WS_SSMA), (bf16*)(ws + WS_SGA), (bf16*)(ws + WS_SGS), (float*)(ws + WS_KMEANP)};
        pg8::gemm_phase<pg8::EpiIn, pg8::StaticOrder, true>(F.lds + RING_OFF, g, S, E);
        if (BOTH(4)) GRID_BAR();
    }
    if (IN(5)) { gating_phase(F); if (BOTH(5)) GRID_BAR(); }
    if (IN(6)) { ssm_simple_phase(F); attn_simple_phase(F); if (BOTH(6)) GRID_BAR(); }
    if (IN(7)) {
        pg8::Gemm g{(const bf16*)(ws + WS_Y1), (const bf16*)(ws + WS_WGLU), SW, SW, SW, nullptr, nullptr, 0}; pg8::StaticOrder S; S.init(T, SW, F.G, bx);
        pg8::EpiGlu E{(const bf16*)(ws + WS_Y1), F.in[IN_BGLU], (bf16*)(ws + WS_YSSM)};
        pg8::gemm_phase<pg8::EpiGlu, pg8::StaticOrder, true>(F.lds + RING_OFF, g, S, E);
        if (BOTH(7)) GRID_BAR();
    }
    if (IN(8)) {
        pg8::Gemm g{(const bf16*)(ws + WS_YATT), (const bf16*)(ws + WS_WBRA), AW, AW, AW, (const bf16*)(ws + WS_YSSM), (const bf16*)(ws + WS_WBRS), SW}; pg8::StaticOrder S; S.init(T, D, F.G, bx);
        pg8::EpiMerge E{(const bf16*)(ws + WS_SGA), (const bf16*)(ws + WS_SGS), (bf16*)(ws + WS_MERGED)};
        pg8::gemm_phase<pg8::EpiMerge, pg8::StaticOrder, true>(F.lds + RING_OFF, g, S, E);
        if (BOTH(8)) GRID_BAR();
    }
    if (IN(9)) {
        pg8::Gemm g{(const bf16*)(ws + WS_MERGED), (const bf16*)(ws + WS_WOUT), D, D, D, nullptr, nullptr, 0}; pg8::StaticOrder S; S.init(T, D, F.G, bx);
        pg8::EpiResid<true, 1> E{F.out, F.out, ada + 5 * D, (bf16*)(ws + WS_X2S), (const float*)(ws + WS_CS3), rowss, 1.0f};
        pg8::gemm_phase<pg8::EpiResid<true, 1>, pg8::StaticOrder, true>(F.lds + RING_OFF, g, S, E);
        if (BOTH(9)) GRID_BAR();
    }
    if (IN(10)) {
        pg8::Gemm g{(const bf16*)(ws + WS_X2S), (const bf16*)(ws + WS_W3T), D, D, D, nullptr, nullptr, 0}; pg8::StaticOrder S; S.init(T, NGU, F.G, bx);
        pg8::EpiSwiGLU<true> E{(bf16*)(ws + WS_ACT), rowss, (const float*)(ws + WS_BIAS3)};
        pg8::gemm_phase<pg8::EpiSwiGLU<true>, pg8::StaticOrder, true>(F.lds + RING_OFF, g, S, E);
        if (BOTH(10)) GRID_BAR();
    }
    if (IN(11)) {
        pg8::Gemm g{(const bf16*)(ws + WS_ACT), (const bf16*)(ws + WS_W4T), FF, FF, FF, nullptr, nullptr, 0}; pg8::StaticOrder S; S.init(T, D, F.G, bx);
        pg8::EpiResid<false, 2> E{F.out, F.out, ada + 8 * D, nullptr, nullptr, rowss, 0.5f};
        pg8::gemm_phase<pg8::EpiResid<false, 2>, pg8::StaticOrder, true>(F.lds + RING_OFF, g, S, E);
        if (BOTH(11)) GRID_BAR();
    }
    if (IN(12)) { final_norm_phase(F); }
#undef IN
#undef BOTH
}

extern "C" void kernel_launch(void* const* d_in, const int* in_sizes, int n_in, void* d_out, int out_size, void* d_ws, size_t ws_size, hipStream_t stream) {
    static int grid = 0;
    if (grid == 0) {
        if (n_in != 26 || in_sizes[0] != T * D || out_size != T * D || ws_size < WS_END) { fprintf(stderr, "kernel_launch: unexpected shapes (n_in %d, in0 %d, out %d, ws %zu < %zu); nothing launched\n", n_in, n_in > 0 ? in_sizes[0] : -1, out_size, ws_size, (size_t)WS_END); grid = -1; return; }
        int dev = 0, cus = 0;
        if (hipGetDevice(&dev) != hipSuccess || hipDeviceGetAttribute(&cus, hipDeviceAttributeMultiprocessorCount, dev) != hipSuccess) { grid = -1; return; }
        if (hipFuncSetAttribute((const void*)hybrid_fwd, hipFuncAttributeMaxDynamicSharedMemorySize, LDS_BYTES) != hipSuccess) { fprintf(stderr, "kernel_launch: hipFuncSetAttribute failed\n"); grid = -1; return; }
        (void)hipGetLastError();
        grid = cus;
    }
    if (grid < 0) return;
    if (hipMemsetAsync((char*)d_ws + WS_CTL, 0, CTL_ZERO_BYTES, stream) != hipSuccess) return;
    Args a{};
    for (int i = 0; i < 26; ++i) a.in[i] = (const float*)d_in[i];
    a.out = (float*)d_out; a.ws = (unsigned char*)d_ws;
    for (int li = 0; li < MK_N_LAUNCHES; ++li) {
        a.ph_lo = (MK_N_LAUNCHES == 1) ? 0 : li; a.ph_hi = (MK_N_LAUNCHES == 1) ? N_PHASES : li + 1; a.li = li;
        hipLaunchKernelGGL(hybrid_fwd, dim3(grid), dim3(NWAVES * 64), LDS_BYTES, stream, a);
    }
}
```

```cpp
#include <hip/hip_runtime.h>
#include <hip/hip_bf16.h>
#include <cstdio>
#include <cstdint>

#ifndef MK_N_LAUNCHES
#define MK_N_LAUNCHES 1
#endif

constexpr int BATCH = 4, SEQ = 8192, T = BATCH * SEQ, D = 1024, FF = 2816, NGU = 2 * FF, NIN = 4096, AW = 512, SW = 512, NH = 8, HD = 64;
constexpr int NBLK = 32, MBLK = 256;
constexpr int SG = 32, SC = 16, SP = 64, SL = 32, NCH = SEQ / SL, KSSM = SC * SL + 2 * SP;
constexpr int NADA = 9 * D;
constexpr float EPS = 1e-6f;
constexpr float LOG2E = 1.4426950408889634f;
constexpr float QSCALE = 0.125f * LOG2E;
constexpr int N_PHASES = 13;

constexpr size_t MiB = 1u << 20;
constexpr size_t WS_CTL = 0, CTL_ZERO_BYTES = 1 * MiB;
constexpr size_t WS_ADA = 1 * MiB;
constexpr size_t WS_CS2 = WS_ADA + 147456;
constexpr size_t WS_CS3 = WS_CS2 + 16384;
constexpr size_t WS_BIAS2 = WS_CS3 + 16384;
constexpr size_t WS_BIAS3 = WS_BIAS2 + 65536;
constexpr size_t WS_KMEANP = 1 * MiB + 512 * 1024;
constexpr size_t WS_SEL = 2 * MiB;
constexpr size_t WS_LSE = 3 * MiB;
constexpr size_t WS_ROWSS = 6 * MiB;
constexpr size_t WS_WINT = 8 * MiB, WS_WGLU = 16 * MiB, WS_WBRA = 17 * MiB, WS_WBRS = 18 * MiB, WS_WOUT = 19 * MiB;
constexpr size_t WS_W1T = 21 * MiB, WS_W2T = 32 * MiB, WS_W3T = 37 * MiB + 512 * 1024, WS_W4T = 48 * MiB + 512 * 1024;
constexpr size_t WS_BM = 54 * MiB, WS_BS = 74 * MiB;
constexpr size_t WS_ARENA = 82 * MiB;
constexpr size_t WS_SGA = WS_ARENA, WS_SGS = WS_ARENA + 64 * MiB;
constexpr size_t WS_Q = WS_ARENA + 128 * MiB, WS_K = WS_ARENA + 160 * MiB, WS_V = WS_ARENA + 192 * MiB;
constexpr size_t WS_PART = WS_ARENA + 224 * MiB;
constexpr size_t WS_Y1 = WS_ARENA + 320 * MiB;
constexpr size_t WS_SSMA = WS_ARENA + 352 * MiB;
constexpr size_t WS_YSSM = WS_ARENA + 352 * MiB, WS_YATT = WS_ARENA + 224 * MiB;
constexpr size_t WS_X1S = WS_ARENA + 224 * MiB, WS_ACT = WS_ARENA, WS_MERGED = WS_ARENA + 128 * MiB, WS_X2S = WS_ARENA + 224 * MiB;
constexpr size_t WS_END = WS_ARENA + 416 * MiB;
static_assert(WS_BIAS3 + 90112 <= WS_KMEANP && WS_W4T + (size_t)D * FF * 2 <= WS_BM && WS_BM + (size_t)SG * 512 * KSSM * 2 <= WS_BS && WS_BS + (size_t)SG * 256 * 512 * 2 <= WS_ARENA, "ws map");
static_assert((size_t)SG * 1024 * KSSM * 2 <= 40 * MiB && (size_t)T * FF * 2 <= 176 * MiB, "ws map 2");
constexpr int CW_BAR = 4096;
constexpr int CW_QUEUE = 256;

constexpr int RING_OFF = 0, RING_BYTES = 131072;
constexpr int SILU_OFF = 131072;
constexpr int LDS_BYTES = 163840;
constexpr int MISC_OFF = LDS_BYTES - 256;

#define GAS __attribute__((address_space(1)))
#define LAS __attribute__((address_space(3)))
typedef unsigned short bf16;
typedef unsigned v4u __attribute__((ext_vector_type(4)));
typedef unsigned v2u __attribute__((ext_vector_type(2)));
typedef float f32x4 __attribute__((ext_vector_type(4)));
typedef float f32x2 __attribute__((ext_vector_type(2)));
typedef short bf16x8 __attribute__((ext_vector_type(8)));
typedef GAS unsigned gu32;
#define RLX_AGENT __ATOMIC_RELAXED, __HIP_MEMORY_SCOPE_AGENT
#define LDS_WAIT() asm volatile("s_waitcnt lgkmcnt(0)" ::: "memory")
#define VM_WAIT() asm volatile("s_waitcnt vmcnt(0)" ::: "memory")
constexpr int NWAVES = 8;

__device__ __forceinline__ unsigned f2bf(float f) { unsigned u = __builtin_bit_cast(unsigned, f); return (u + 0x7fffu + ((u >> 16) & 1u)) >> 16; }
__device__ __forceinline__ unsigned pk2(float lo, float hi) { return f2bf(lo) | (f2bf(hi) << 16); }
__device__ __forceinline__ float bf2f(unsigned short h) { return __builtin_bit_cast(float, (unsigned)h << 16); }
__device__ __forceinline__ float bflo(unsigned w) { return __builtin_bit_cast(float, w << 16); }
__device__ __forceinline__ float bfhi(unsigned w) { return __builtin_bit_cast(float, w & 0xffff0000u); }
__device__ __forceinline__ float fast_exp2(float x) { return __builtin_amdgcn_exp2f(x); }
__device__ __forceinline__ float fast_rcp(float x) { return __builtin_amdgcn_rcpf(x); }
__device__ __forceinline__ float sigmoidf_(float x) { return fast_rcp(1.0f + fast_exp2(-LOG2E * x)); }
__device__ __forceinline__ float siluf_(float x) { return x * sigmoidf_(x); }
__device__ __forceinline__ float gelu_tanh(float v) { const float u = 1.5957691216057308f * (v + 0.044715f * v * v * v); return v * fast_rcp(1.0f + fast_exp2(-LOG2E * u)); }
__device__ __forceinline__ float wave_sum(float v) {
#pragma unroll
    for (int o = 1; o < 64; o <<= 1) v += __shfl_xor(v, o);
    return v;
}
__device__ __forceinline__ float wave_max(float v) {
#pragma unroll
    for (int o = 1; o < 64; o <<= 1) v = fmaxf(v, __shfl_xor(v, o));
    return v;
}

namespace pg8 {
#define PG8_LAS __attribute__((address_space(3)))
typedef unsigned short bf16_t;
typedef short bf16x8 __attribute__((ext_vector_type(8)));
typedef float f32x4 __attribute__((ext_vector_type(4)));
typedef unsigned u32x4 __attribute__((ext_vector_type(4)));
constexpr int BM = 256, BK = 64, HALF = 128, HTB = HALF * BK * 2, STAGE_BYTES = 8 * HTB, NXCD = 8, WGM = 8;

__host__ __device__ __forceinline__ int lds_byte(int r, int c) { const int st = (r >> 4) * 2 + (c >> 5), rr = r & 15, cc = c & 31, ob = rr * 64 + cc * 2; return st * 1024 + (ob ^ (((ob >> 9) & 1) << 5)); }
__host__ __device__ __forceinline__ void stage_rc(int b, int& R, int& C) { const int st = b / 1024, sb = b % 1024, swz = sb ^ (((sb >> 9) & 1) << 5); R = (st >> 1) * 16 + swz / 64; C = (st & 1) * 32 + (swz % 64) / 2; }
__host__ __device__ __forceinline__ int perm32(int rho) { const int n = rho >> 4, i = rho & 15; return 8 * (i >> 2) + 4 * n + (i & 3); }

struct Unit { int pm, pn; };
struct Gemm { const bf16_t* A; const bf16_t* Bt; int lda, ldb, K; const bf16_t* A2; const bf16_t* Bt2; int K2; };

struct StaticOrder {
    int nM, nN, nwg, G, c;
    __host__ __device__ void init(int M, int N, int G_, int c_) { nM = M / BM; nN = N / BM; nwg = nM * nN; G = G_; c = c_; }
    __host__ __device__ bool next(int i, Unit& u) const {
        const long L = (long)i * G + c; if (L >= nwg) return false;
        int wgid = (int)L; { const int q = nwg / NXCD, r = nwg % NXCD, xcd = wgid % NXCD, off = wgid / NXCD; wgid = (xcd < r ? xcd * (q + 1) : r * (q + 1) + (xcd - r) * q) + off; }
        const int nig = WGM * nN, gid = wgid / nig, fm = gid * WGM, gsz = (nM - fm) < WGM ? (nM - fm) : WGM;
        u.pm = fm + ((wgid % nig) % gsz); u.pn = (wgid % nig) / gsz; return true;
    }
};
struct BlockDiagOrder {
    int RM, RN, n, G, c, first;
    __host__ __device__ void init(int ngroups, int RM_, int RN_, int G_, int c_, int first_ = 0) { RM = RM_; RN = RN_; n = ngroups * RM_ * RN_; G = G_; c = c_; first = first_; }
    __host__ __device__ bool next(int i, Unit& u) const {
        const int L = i * G + c; if (L >= n || (first && i > 0)) return false;
        const int g = L / (RM * RN), r = L % (RM * RN); u.pm = g * RM + r / RN; u.pn = g * RN + r % RN; return true;
    }
};

__device__ __forceinline__ unsigned cvt_pk_bf16(float lo, float hi) { unsigned r; asm volatile("v_cvt_pk_bf16_f32 %0, %1, %2" : "=v"(r) : "v"(lo), "v"(hi)); return r; }

template <class Epi, class Sched, bool ALIGN_EPI = false, bool SP2 = true>
__device__ __forceinline__ void gemm_phase(PG8_LAS unsigned char* lds, const Gemm g, const Sched S, const Epi E) {
    const int tid = threadIdx.x, wid = __builtin_amdgcn_readfirstlane(tid >> 6), lane = tid & 63, wr = wid >> 2, wc = wid & 3, fr = lane & 15, fq = lane >> 4;
    const int nt1 = g.K / BK, nt = (g.K + g.K2) / BK;
    unsigned voffA[2], voffB[2];
#pragma unroll
    for (int i = 0; i < 2; ++i) { int R, C; stage_rc(tid * 16 + i * 8192, R, C); const int Rb = Epi::PERM ? ((R & ~31) + perm32(R & 31)) : R;
        voffA[i] = (unsigned)(R * g.lda + C) * 2u; voffB[i] = (unsigned)(Rb * g.ldb + C) * 2u; }
    const size_t kstep = (size_t)(BK * 2);
    const size_t hstepA = (size_t)HALF * g.lda * 2, hstepB = (size_t)HALF * g.ldb * 2;
    const size_t tstepA = 2 * hstepA, tstepB = 2 * hstepB;
    const unsigned ldsw = (unsigned)wid * 1024u;
    const int aoff = lds_byte(wr * 64 + fr, fq * 8), boff = lds_byte(wc * 32 + fr, fq * 8);
#define PG8_SA(b, h) (((b) * 2 + (h)) * HTB)
#define PG8_SB(b, h) ((4 + (b) * 2 + (h)) * HTB)
#define PG8_STAGE(bufoff, gbase, voff) do { _Pragma("unroll") for (int _i = 0; _i < 2; ++_i) \
        __builtin_amdgcn_global_load_lds((const unsigned*)((const char*)(gbase) + (voff)[_i]), (PG8_LAS unsigned*)(lds + (bufoff) + ldsw + _i * 8192), 16, 0, 0); } while (0)
#define PG8_LDA(dst, b, h) do { _Pragma("unroll") for (int m = 0; m < 4; ++m) _Pragma("unroll") for (int k = 0; k < 2; ++k) dst[m][k] = *(const PG8_LAS bf16x8*)(lds + PG8_SA(b, h) + aoff + m * 2048 + k * 1024); } while (0)
#define PG8_LDB(dst, b, h) do { _Pragma("unroll") for (int n = 0; n < 2; ++n) _Pragma("unroll") for (int k = 0; k < 2; ++k) dst[n][k] = *(const PG8_LAS bf16x8*)(lds + PG8_SB(b, h) + boff + n * 2048 + k * 1024); } while (0)
#define PG8_MMA(ai, bj, At, Bt) do { __builtin_amdgcn_s_setprio(1); _Pragma("unroll") for (int m = 0; m < 4; ++m) _Pragma("unroll") for (int n = 0; n < 2; ++n) _Pragma("unroll") for (int k = 0; k < 2; ++k) \
        acc[ai][bj][m][n] = __builtin_amdgcn_mfma_f32_16x16x32_bf16(Bt[n][k], At[m][k], acc[ai][bj][m][n], 0, 0, 0); __builtin_amdgcn_s_setprio(0); } while (0)
#define PG8_WAIT_V(n) asm volatile("s_waitcnt vmcnt(" #n ")" ::: "memory")
#define PG8_WAIT_L(n) asm volatile("s_waitcnt lgkmcnt(" #n ")" ::: "memory")
#define PG8_BAR __builtin_amdgcn_s_barrier()
#define PG8_SCHED __builtin_amdgcn_sched_barrier(0)
    Unit cur, nxt; int ui = 0;
    if (!S.next(0, cur)) return;
    f32x4 acc[2][2][4][2];
#pragma unroll
    for (int a = 0; a < 2; ++a)
#pragma unroll
        for (int b = 0; b < 2; ++b)
#pragma unroll
            for (int m = 0; m < 4; ++m)
#pragma unroll
                for (int n = 0; n < 2; ++n) acc[a][b][m][n] = (f32x4){0.f, 0.f, 0.f, 0.f};
    bf16x8 At[4][2], B0[2][2], B1[2][2];
    const char* cA = (const char*)g.A + (size_t)cur.pm * tstepA; const char* cB = (const char*)g.Bt + (size_t)cur.pn * tstepB;
    const char* cA2 = (const char*)g.A2 + (size_t)cur.pm * tstepA; const char* cB2 = (const char*)g.Bt2 + (size_t)cur.pn * tstepB;
    {
        PG8_STAGE(PG8_SB(0, 0), cB, voffB); PG8_STAGE(PG8_SB(0, 1), cB + hstepB, voffB); PG8_STAGE(PG8_SA(0, 0), cA, voffA); PG8_STAGE(PG8_SA(0, 1), cA + hstepA, voffA);
        if (wr == 1) PG8_BAR;
        PG8_WAIT_V(2); PG8_BAR;
        PG8_STAGE(PG8_SB(1, 0), cB + kstep, voffB); PG8_STAGE(PG8_SA(1, 0), cA + kstep, voffA); PG8_STAGE(PG8_SB(1, 1), cB + hstepB + kstep, voffB);
        PG8_WAIT_V(6); PG8_BAR;
    }
    for (;;) {
        const bool has_next = S.next(ui + 1, nxt);
        const char* nA = has_next ? (const char*)g.A + (size_t)nxt.pm * tstepA : cA; const char* nB = has_next ? (const char*)g.Bt + (size_t)nxt.pn * tstepB : cB;
        for (int t = 0; t < nt; t += 2) {
            const bool last = (t == nt - 2);
            if constexpr (Epi::HAS_MID) { if (t == nt1) E.mid(acc, cur, wr, wc, fr, fq); }
            const char* a0 = (t < nt1) ? cA + (size_t)t * kstep : cA2 + (size_t)(t - nt1) * kstep;
            const char* a1 = a0 + kstep;
            const char* a2 = last ? nA : ((t + 2 < nt1) ? cA + (size_t)(t + 2) * kstep : cA2 + (size_t)(t + 2 - nt1) * kstep);
            const char* b2 = last ? nB : ((t + 2 < nt1) ? cB + (size_t)(t + 2) * kstep : cB2 + (size_t)(t + 2 - nt1) * kstep);
            const char* a3 = a2 + kstep; const char* b3 = b2 + kstep;
            PG8_LDB(B0, 0, 0); PG8_LDB(B1, 0, 1); PG8_SCHED; PG8_LDA(At, 0, 0); PG8_STAGE(PG8_SA(1, 1), a1 + hstepA, voffA);
            PG8_WAIT_V(8); PG8_WAIT_L(0); PG8_BAR; PG8_MMA(0, 0, At, B0); PG8_MMA(0, 1, At, B1); PG8_BAR; PG8_SCHED;
            PG8_LDA(At, 0, 1); PG8_STAGE(PG8_SB(0, 0), b2, voffB); PG8_STAGE(PG8_SB(0, 1), b2 + hstepB, voffB); PG8_STAGE(PG8_SA(0, 0), a2, voffA);
            PG8_WAIT_V(8); PG8_WAIT_L(0); PG8_BAR; PG8_MMA(1, 0, At, B0); PG8_MMA(1, 1, At, B1); PG8_BAR; PG8_SCHED;
            PG8_LDB(B0, 1, 0); PG8_LDB(B1, 1, 1); PG8_SCHED; PG8_LDA(At, 1, 0); PG8_STAGE(PG8_SA(0, 1), a2 + hstepA, voffA);
            PG8_WAIT_V(8); PG8_WAIT_L(0); PG8_BAR; PG8_MMA(0, 0, At, B0); PG8_MMA(0, 1, At, B1); PG8_BAR; PG8_SCHED;
            PG8_LDA(At, 1, 1); PG8_STAGE(PG8_SB(1, 0), b3, voffB); PG8_STAGE(PG8_SB(1, 1), b3 + hstepB, voffB); PG8_STAGE(PG8_SA(1, 0), a3, voffA);
            PG8_WAIT_V(8); PG8_WAIT_L(0); PG8_BAR; PG8_MMA(1, 0, At, B0); PG8_MMA(1, 1, At, B1); PG8_BAR; PG8_SCHED;
        }
        if constexpr (ALIGN_EPI) { if (wr == 0) PG8_BAR; }
        if constexpr (!Epi::AFTER_DRAIN) { E(acc, cur, wr, wc, fr, fq); }
        if (!has_next) break;
#pragma unroll
        for (int a = 0; a < 2; ++a)
#pragma unroll
            for (int b = 0; b < 2; ++b)
#pragma unroll
                for (int m = 0; m < 4; ++m)
#pragma unroll
                    for (int n = 0; n < 2; ++n) acc[a][b][m][n] = (f32x4){0.f, 0.f, 0.f, 0.f};
        cur = nxt; cA = nA; cB = nB; ++ui;
        cA2 = (const char*)g.A2 + (size_t)cur.pm * tstepA; cB2 = (const char*)g.Bt2 + (size_t)cur.pn * tstepB;
        if constexpr (ALIGN_EPI) { if (wr == 1) PG8_BAR; }
    }
    PG8_WAIT_V(0);
    if constexpr (!ALIGN_EPI) { if (wr == 0) PG8_BAR; }
    PG8_BAR;
    if constexpr (Epi::AFTER_DRAIN) { E.fused(acc, cur, wr, wc, fr, fq, lds, wid, lane); }
#undef PG8_SA
#undef PG8_SB
#undef PG8_STAGE
#undef PG8_LDA
#undef PG8_LDB
#undef PG8_MMA
#undef PG8_WAIT_V
#undef PG8_WAIT_L
#undef PG8_BAR
#undef PG8_SCHED
}

__device__ __forceinline__ float row_rnorm(const float* rowss, int row) {
    const f32x4* p = (const f32x4*)(rowss + (size_t)row * 16);
    const f32x4 a = p[0], b = p[1], c = p[2], d = p[3];
    const float s = ((a[0] + a[1]) + (a[2] + a[3])) + ((b[0] + b[1]) + (b[2] + b[3])) + ((c[0] + c[1]) + (c[2] + c[3])) + ((d[0] + d[1]) + (d[2] + d[3]));
    return __builtin_amdgcn_rsqf(s * (1.0f / 1024.0f) + EPS);
}

template <bool NORM> struct EpiSwiGLU {
    static constexpr bool PERM = true, AFTER_DRAIN = false, HAS_MID = false;
    bf16_t* O; const float* rowss; const float* bias;
    __device__ __forceinline__ void operator()(const f32x4 (&acc)[2][2][4][2], const Unit& u, int wr, int wc, int fr, int fq) const {
        const int row0 = u.pm * BM + wr * 64 + fr, b = u.pm >> 5;
        const int colB0 = u.pn * BM + wc * 32 + 8 * fq, ocol0 = u.pn * 128 + wc * 32 + 8 * fq;
        f32x4 bg[2], bu[2];
#pragma unroll
        for (int n = 0; n < 2; ++n) { bg[n] = NORM ? *(const f32x4*)(bias + (size_t)b * NGU + colB0 + 4 * n) : (f32x4){0.f, 0.f, 0.f, 0.f}; bu[n] = NORM ? *(const f32x4*)(bias + (size_t)b * NGU + colB0 + 128 + 4 * n) : (f32x4){0.f, 0.f, 0.f, 0.f}; }
#pragma unroll
        for (int ai = 0; ai < 2; ++ai)
#pragma unroll
            for (int m = 0; m < 4; ++m) {
                const int row = row0 + ai * HALF + m * 16;
                const float r = NORM ? row_rnorm(rowss, row) : 1.0f;
                float o[8];
#pragma unroll
                for (int n = 0; n < 2; ++n) {
                    f32x4 gv = acc[ai][0][m][n], uv = acc[ai][1][m][n];
                    if (NORM) { gv = gv * r + bg[n]; uv = uv * r + bu[n]; }
#pragma unroll
                    for (int j = 0; j < 4; ++j) o[4 * n + j] = siluf_(gv[j]) * uv[j];
                }
                u32x4 w; w.x = cvt_pk_bf16(o[0], o[1]); w.y = cvt_pk_bf16(o[2], o[3]); w.z = cvt_pk_bf16(o[4], o[5]); w.w = cvt_pk_bf16(o[6], o[7]);
                *(u32x4*)(O + (size_t)row * FF + ocol0) = w;
            }
    }
};

template <bool XS, int TAG> struct EpiResid {
    static constexpr bool PERM = false, AFTER_DRAIN = false, HAS_MID = false;
    const float* xin; float* xout; const float* gate; bf16_t* xs; const float* cs; float* rowss; float gscale;
    __device__ __forceinline__ void operator()(const f32x4 (&acc)[2][2][4][2], const Unit& u, int wr, int wc, int fr, int fq) const {
        const int row0 = u.pm * BM + wr * 64 + fr, b = u.pm >> 5, col0 = u.pn * BM + wc * 32 + 4 * fq;
        f32x4 gv[2][2], cv[2][2];
#pragma unroll
        for (int bj = 0; bj < 2; ++bj)
#pragma unroll
            for (int n = 0; n < 2; ++n) { const f32x4 g_ = *(const f32x4*)(gate + (size_t)b * NADA + col0 + bj * HALF + n * 16); const float gsc = gscale;
                gv[bj][n] = (f32x4){g_[0] * gsc, g_[1] * gsc, g_[2] * gsc, g_[3] * gsc};
                cv[bj][n] = XS ? *(const f32x4*)(cs + (size_t)b * D + col0 + bj * HALF + n * 16) : (f32x4){0.f, 0.f, 0.f, 0.f}; }
#pragma unroll
        for (int ai = 0; ai < 2; ++ai)
#pragma unroll
            for (int m = 0; m < 4; ++m) {
                const int row = row0 + ai * HALF + m * 16; const size_t off = (size_t)row * D + col0;
                float ss = 0.f;
#pragma unroll
                for (int bj = 0; bj < 2; ++bj)
#pragma unroll
                    for (int n = 0; n < 2; ++n) {
                        const f32x4 xv = *(const f32x4*)(xin + off + bj * HALF + n * 16);
                        const f32x4 v = xv + gv[bj][n] * acc[ai][bj][m][n];
                        *(f32x4*)(xout + off + bj * HALF + n * 16) = v;
                        ss += (v[0] * v[0] + v[1] * v[1]) + (v[2] * v[2] + v[3] * v[3]);
                        if (XS) { const f32x4 s = v * cv[bj][n]; v2u w; w.x = cvt_pk_bf16(s[0], s[1]); w.y = cvt_pk_bf16(s[2], s[3]); *(v2u*)(xs + off + bj * HALF + n * 16) = w; }
                    }
                ss += __shfl_xor(ss, 16); ss += __shfl_xor(ss, 32);
                if (fq == 0) rowss[(size_t)row * 16 + u.pn * 4 + wc] = ss;
            }
    }
};

struct EpiIn {
    static constexpr bool PERM = true, AFTER_DRAIN = false, HAS_MID = false;
    const float* rowss; const float* bias; bf16_t* q; bf16_t* k; bf16_t* v; bf16_t* ssmA; bf16_t* sga; bf16_t* sgs; float* kmeanp;
    __device__ __forceinline__ void operator()(const f32x4 (&acc)[2][2][4][2], const Unit& u, int wr, int wc, int fr, int fq) const {
        const int row0 = u.pm * BM + wr * 64 + fr, b = u.pm >> 5, nb = u.pm & 31;
        const int c0 = u.pn * BM + wc * 32 + 8 * fq;
        const int region = u.pn >> 1;
        f32x4 bv[2][2];
#pragma unroll
        for (int bj = 0; bj < 2; ++bj)
#pragma unroll
            for (int n = 0; n < 2; ++n) bv[bj][n] = *(const f32x4*)(bias + (size_t)b * NIN + c0 + bj * HALF + 4 * n);
        float cs[2][8];
#pragma unroll
        for (int bj = 0; bj < 2; ++bj)
#pragma unroll
            for (int j = 0; j < 8; ++j) cs[bj][j] = 0.f;
#pragma unroll
        for (int ai = 0; ai < 2; ++ai)
#pragma unroll
            for (int m = 0; m < 4; ++m) {
                const int row = row0 + ai * HALF + m * 16;
                const float r = row_rnorm(rowss, row);
#pragma unroll
                for (int bj = 0; bj < 2; ++bj) {
                    const f32x4 v0 = acc[ai][bj][m][0] * r + bv[bj][0], v1 = acc[ai][bj][m][1] * r + bv[bj][1];
                    float o[8] = {v0[0], v0[1], v0[2], v0[3], v1[0], v1[1], v1[2], v1[3]};
                    const int c = c0 + bj * HALF;
                    bf16_t* dst;
                    if (region == 0) {
#pragma unroll
                        for (int j = 0; j < 8; ++j) o[j] *= QSCALE;
                        dst = q + (size_t)row * AW + c;
                    } else if (region == 1) {
#pragma unroll
                        for (int j = 0; j < 8; ++j) cs[bj][j] += o[j];
                        dst = k + (size_t)row * AW + (c - 512);
                    } else if (region == 2) {
                        dst = v + (size_t)row * AW + (c - 1024);
                    } else if (region == 3) {
                        const int cc = c - 1536, gidx = cc >> 4, ch = cc & 15, t = row & (SEQ - 1);
                        dst = ssmA + ((size_t)(gidx * 1024 + b * NCH + (t >> 5)) * KSSM + (t & 31) * SC + ch);
                    } else if (region < 6) {
#pragma unroll
                        for (int j = 0; j < 8; ++j) o[j] = sigmoidf_(o[j]);
                        dst = sga + (size_t)row * D + (c - 2048);
                    } else {
#pragma unroll
                        for (int j = 0; j < 8; ++j) o[j] = fmaxf(sigmoidf_(o[j]), 1e-30f);
                        dst = sgs + (size_t)row * D + (c - 3072);
                    }
                    u32x4 w; w.x = cvt_pk_bf16(o[0], o[1]); w.y = cvt_pk_bf16(o[2], o[3]); w.z = cvt_pk_bf16(o[4], o[5]); w.w = cvt_pk_bf16(o[6], o[7]);
                    *(u32x4*)dst = w;
                }
            }
        if (region == 1) {
#pragma unroll
            for (int bj = 0; bj < 2; ++bj)
#pragma unroll
                for (int j = 0; j < 8; ++j) { float s = cs[bj][j]; s += __shfl_xor(s, 1); s += __shfl_xor(s, 2); s += __shfl_xor(s, 4); s += __shfl_xor(s, 8); cs[bj][j] = s; }
            if (fr == 0) {
#pragma unroll
                for (int bj = 0; bj < 2; ++bj) {
                    float* dstp = kmeanp + ((size_t)((b * NBLK + nb) * 2 + wr) * AW + (c0 + bj * HALF - 512));
                    *(f32x4*)dstp = (f32x4){cs[bj][0], cs[bj][1], cs[bj][2], cs[bj][3]}; *(f32x4*)(dstp + 4) = (f32x4){cs[bj][4], cs[bj][5], cs[bj][6], cs[bj][7]};
                }
            }
        }
    }
};

struct EpiGlu {
    static constexpr bool PERM = true, AFTER_DRAIN = false, HAS_MID = false;
    const bf16_t* y1; const float* bglu; bf16_t* yssm;
    __device__ __forceinline__ void operator()(const f32x4 (&acc)[2][2][4][2], const Unit& u, int wr, int wc, int fr, int fq) const {
        const int row0 = u.pm * BM + wr * 64 + fr, c0 = u.pn * BM + wc * 32 + 8 * fq;
        f32x4 bv[2][2];
#pragma unroll
        for (int bj = 0; bj < 2; ++bj)
#pragma unroll
            for (int n = 0; n < 2; ++n) bv[bj][n] = *(const f32x4*)(bglu + c0 + bj * HALF + 4 * n);
#pragma unroll
        for (int ai = 0; ai < 2; ++ai)
#pragma unroll
            for (int m = 0; m < 4; ++m) {
                const int row = row0 + ai * HALF + m * 16;
#pragma unroll
                for (int bj = 0; bj < 2; ++bj) {
                    const size_t off = (size_t)row * SW + c0 + bj * HALF;
                    const u32x4 yv = *(const u32x4*)(y1 + off);
                    const f32x4 z0 = acc[ai][bj][m][0] + bv[bj][0], z1 = acc[ai][bj][m][1] + bv[bj][1];
                    float o[8];
                    o[0] = bflo(yv.x) * sigmoidf_(z0[0]); o[1] = bfhi(yv.x) * sigmoidf_(z0[1]); o[2] = bflo(yv.y) * sigmoidf_(z0[2]); o[3] = bfhi(yv.y) * sigmoidf_(z0[3]);
                    o[4] = bflo(yv.z) * sigmoidf_(z1[0]); o[5] = bfhi(yv.z) * sigmoidf_(z1[1]); o[6] = bflo(yv.w) * sigmoidf_(z1[2]); o[7] = bfhi(yv.w) * sigmoidf_(z1[3]);
                    u32x4 w; w.x = cvt_pk_bf16(o[0], o[1]); w.y = cvt_pk_bf16(o[2], o[3]); w.z = cvt_pk_bf16(o[4], o[5]); w.w = cvt_pk_bf16(o[6], o[7]);
                    *(u32x4*)(yssm + off) = w;
                }
            }
    }
};

struct EpiMerge {
    static constexpr bool PERM = true, AFTER_DRAIN = false, HAS_MID = true;
    const bf16_t* sga; const bf16_t* sgs; bf16_t* merged;
    __device__ __forceinline__ void mid(f32x4 (&acc)[2][2][4][2], const Unit& u, int wr, int wc, int fr, int fq) const {
        int row0 = u.pm * BM + wr * 64 + fr, c0 = u.pn * BM + wc * 32 + 8 * fq;
        asm volatile("" : "+v"(row0), "+v"(c0));
#pragma unroll
        for (int ai = 0; ai < 2; ++ai)
#pragma unroll
            for (int m = 0; m < 4; ++m)
#pragma unroll
                for (int bj = 0; bj < 2; ++bj) {
                    const size_t off = (size_t)(row0 + ai * HALF + m * 16) * D + c0 + bj * HALF;
                    const u32x4 a = *(const u32x4*)(sga + off), s = *(const u32x4*)(sgs + off);
                    f32x4 r0, r1;
                    r0[0] = bflo(a.x) * fast_rcp(bflo(s.x)); r0[1] = bfhi(a.x) * fast_rcp(bfhi(s.x)); r0[2] = bflo(a.y) * fast_rcp(bflo(s.y)); r0[3] = bfhi(a.y) * fast_rcp(bfhi(s.y));
                    r1[0] = bflo(a.z) * fast_rcp(bflo(s.z)); r1[1] = bfhi(a.z) * fast_rcp(bfhi(s.z)); r1[2] = bflo(a.w) * fast_rcp(bflo(s.w)); r1[3] = bfhi(a.w) * fast_rcp(bfhi(s.w));
                    acc[ai][bj][m][0] *= r0; acc[ai][bj][m][1] *= r1;
                    if (bj == 1) asm volatile("" ::: "memory");
                }
    }
    __device__ __forceinline__ void operator()(const f32x4 (&acc)[2][2][4][2], const Unit& u, int wr, int wc, int fr, int fq) const {
        const int row0 = u.pm * BM + wr * 64 + fr, c0 = u.pn * BM + wc * 32 + 8 * fq;
#pragma unroll
        for (int ai = 0; ai < 2; ++ai)
#pragma unroll
            for (int m = 0; m < 4; ++m)
#pragma unroll
                for (int bj = 0; bj < 2; ++bj) {
                    const size_t off = (size_t)(row0 + ai * HALF + m * 16) * D + c0 + bj * HALF;
                    const u32x4 s = *(const u32x4*)(sgs + off);
                    const f32x4 v0 = acc[ai][bj][m][0], v1 = acc[ai][bj][m][1];
                    u32x4 w; w.x = cvt_pk_bf16(v0[0] * bflo(s.x), v0[1] * bfhi(s.x)); w.y = cvt_pk_bf16(v0[2] * bflo(s.y), v0[3] * bfhi(s.y));
                    w.z = cvt_pk_bf16(v1[0] * bflo(s.z), v1[1] * bfhi(s.z)); w.w = cvt_pk_bf16(v1[2] * bflo(s.w), v1[3] * bfhi(s.w));
                    *(u32x4*)(merged + off) = w;
                    if (bj == 1) asm volatile("" ::: "memory");
                }
    }
};

struct EpiSsmState {
    static constexpr bool PERM = false, AFTER_DRAIN = true, HAS_MID = false;
    bf16_t* ssmA; const float* lam_re; const float* lam_im; const float* log_dt;
    __device__ __forceinline__ void fused(f32x4 (&acc)[2][2][4][2], const Unit& u, int wr, int wc, int fr, int fq, PG8_LAS unsigned char* lds, int wid, int lane) const {
        PG8_LAS float* X = (PG8_LAS float*)lds;
        PG8_LAS float* Eb = (PG8_LAS float*)(lds + 135168);
#pragma unroll
        for (int ai = 0; ai < 2; ++ai)
#pragma unroll
            for (int m = 0; m < 4; ++m)
#pragma unroll
                for (int n = 0; n < 2; ++n) *(PG8_LAS f32x4*)(X + (ai * HALF + wr * 64 + m * 16 + fr) * 132 + wc * 32 + n * 16 + 4 * fq) = acc[ai][0][m][n];
        asm volatile("s_waitcnt lgkmcnt(0)" ::: "memory"); __builtin_amdgcn_s_barrier(); asm volatile("" ::: "memory");
        const int g = u.pn, p = lane, seg = wid;
        const float lr = lam_re[g * SP + p], li = lam_im[g * SP + p], dt = __expf(log_dt[g]);
        float ar, ai_; { float sn, cs; __sincosf(li * dt, &sn, &cs); const float mg = __expf(lr * dt); ar = mg * cs; ai_ = mg * sn; }
        float sr = ar, si = ai_;
#pragma unroll
        for (int q = 0; q < 5; ++q) { const float t0 = sr * sr - si * si, t1 = 2.f * sr * si; sr = t0; si = t1; }
        const float aLr = sr, aLi = si;
#pragma unroll
        for (int q = 0; q < 5; ++q) { const float t0 = sr * sr - si * si, t1 = 2.f * sr * si; sr = t0; si = t1; }
        const float aSr = sr, aSi = si;
        const PG8_LAS float* Xs = X + (seg * 32) * 132 + p;
        float er = 0.f, ei = 0.f;
#pragma unroll 8
        for (int r = 0; r < 32; ++r) { const float xr = Xs[r * 132], xi = Xs[r * 132 + 64]; const float nr = aLr * er - aLi * ei + xr, ni = aLr * ei + aLi * er + xi; er = nr; ei = ni; }
        Eb[(seg * 64 + p) * 2] = er; Eb[(seg * 64 + p) * 2 + 1] = ei;
        asm volatile("s_waitcnt lgkmcnt(0)" ::: "memory"); __builtin_amdgcn_s_barrier(); asm volatile("" ::: "memory");
        float cr = 0.f, ci = 0.f;
        for (int s2 = 0; s2 < seg; ++s2) { const float xr = Eb[(s2 * 64 + p) * 2], xi = Eb[(s2 * 64 + p) * 2 + 1]; const float nr = aSr * cr - aSi * ci + xr, ni = aSr * ci + aSi * cr + xi; cr = nr; ci = ni; }
        bf16_t* dst = ssmA + ((size_t)(u.pm * BM + seg * 32) * KSSM + 512 + p);
#pragma unroll 8
        for (int r = 0; r < 32; ++r) {
            dst[(size_t)r * KSSM] = (bf16_t)f2bf(cr); dst[(size_t)r * KSSM + 64] = (bf16_t)f2bf(ci);
            const float xr = Xs[r * 132], xi = Xs[r * 132 + 64]; const float nr = aLr * cr - aLi * ci + xr, ni = aLr * ci + aLi * cr + xi; cr = nr; ci = ni;
        }
        asm volatile("s_waitcnt lgkmcnt(0)" ::: "memory"); __builtin_amdgcn_s_barrier(); asm volatile("" ::: "memory");
    }
};

struct EpiSsmMain {
    static constexpr bool PERM = true, AFTER_DRAIN = false, HAS_MID = false;
    const bf16_t* ssmA; const float* dsk; bf16_t* y1;
    __device__ __forceinline__ void operator()(const f32x4 (&acc)[2][2][4][2], const Unit& u, int wr, int wc, int fr, int fq) const {
        const int g = u.pn >> 1, b = u.pm & 3, cbase = (u.pn & 1) * BM + wc * 32 + 8 * fq;
        const int rloc0 = wr * 64 + fr;
#pragma unroll
        for (int bj = 0; bj < 2; ++bj) {
            const int c = cbase + bj * HALF, s = c >> 4, ch0 = c & 15;
            const f32x4 d0 = *(const f32x4*)(dsk + g * SC + ch0), d1 = *(const f32x4*)(dsk + g * SC + ch0 + 4);
#pragma unroll
            for (int ai = 0; ai < 2; ++ai)
#pragma unroll
                for (int m = 0; m < 4; ++m) {
                    const int rloc = rloc0 + ai * HALF + m * 16;
                    const u32x4 uv = *(const u32x4*)(ssmA + (size_t)(u.pm * BM + rloc) * KSSM + c);
                    const f32x4 v0 = acc[ai][bj][m][0], v1 = acc[ai][bj][m][1];
                    float o[8];
                    o[0] = v0[0] + d0[0] * bflo(uv.x); o[1] = v0[1] + d0[1] * bfhi(uv.x); o[2] = v0[2] + d0[2] * bflo(uv.y); o[3] = v0[3] + d0[3] * bfhi(uv.y);
                    o[4] = v1[0] + d1[0] * bflo(uv.z); o[5] = v1[1] + d1[1] * bfhi(uv.z); o[6] = v1[2] + d1[2] * bflo(uv.w); o[7] = v1[3] + d1[3] * bfhi(uv.w);
#pragma unroll
                    for (int j = 0; j < 8; ++j) o[j] = gelu_tanh(o[j]);
                    u32x4 w; w.x = cvt_pk_bf16(o[0], o[1]); w.y = cvt_pk_bf16(o[2], o[3]); w.z = cvt_pk_bf16(o[4], o[5]); w.w = cvt_pk_bf16(o[6], o[7]);
                    *(u32x4*)(y1 + (size_t)(b * SEQ + rloc * SL + s) * SW + g * SC + ch0) = w;
                }
        }
    }
};
}


#define XB_TMO      128
#define XB_XCNT(j)  (256  + 64 * (j))
#define XB_XSUB(j)  (1280 + 64 * (j))
#define XB_XGEN(j)  (2304 + 64 * (j))
#define XB_TOP      3328
#define XB_TOPGEN   3392
#define XCD_BAR_WORDS 3456
#define XB_SPIN_CAP (1u << 20)

__device__ __forceinline__ unsigned xb_ld(unsigned* p)              { return __hip_atomic_load(p, __ATOMIC_RELAXED, __HIP_MEMORY_SCOPE_AGENT); }
__device__ __forceinline__ unsigned xb_add(unsigned* p, unsigned v) { return __hip_atomic_fetch_add(p, v, __ATOMIC_RELAXED, __HIP_MEMORY_SCOPE_AGENT); }
__device__ __forceinline__ unsigned xb_xcc_id() { return (unsigned)__builtin_amdgcn_s_getreg((3 << 11) | 20) & 0xFu; }
#define XB_SPIN(cond, bar) do { unsigned _sp = 0; while (cond) { __builtin_amdgcn_s_sleep(1); \
    if ((++_sp & 255u) == 0u) { if (xb_ld(&(bar)[XB_TMO])) break; if (_sp > XB_SPIN_CAP) { atomicAdd(&(bar)[XB_TMO], 1u); break; } } } } while (0)

struct XcdBarrier { unsigned* bar; unsigned x; volatile LAS unsigned* st; };
__device__ __forceinline__ XcdBarrier xcd_barrier_post(unsigned* bar, volatile LAS unsigned* st) {
    XcdBarrier b; b.bar = bar; b.x = xb_xcc_id(); b.st = st;
    if (threadIdx.x == 0) (void)xb_add(&bar[XB_XCNT(b.x)], 1u);
    return b;
}
__device__ __forceinline__ void xcd_barrier_complete(unsigned* bar, unsigned x, unsigned& nloc, unsigned& nx) {
    const unsigned G = gridDim.x * gridDim.y * gridDim.z;
    unsigned sum, cnt, mine, sp = 0u;
    for (;;) {
        sum = 0u; cnt = 0u; mine = 0u;
#pragma unroll
        for (unsigned j = 0; j < 16; ++j) { const unsigned c = xb_ld(&bar[XB_XCNT(j)]); sum += c; cnt += (c > 0u) ? 1u : 0u; mine = (j == x) ? c : mine; }
        if (sum == G) break;
        __builtin_amdgcn_s_sleep(1);
        if ((++sp & 255u) == 0u) { if (xb_ld(&bar[XB_TMO])) break; if (sp > XB_SPIN_CAP) { atomicAdd(&bar[XB_TMO], 1u); break; } }
    }
    nloc = mine > 0u ? mine : 1u; nx = cnt > 0u ? cnt : 1u;
}
__device__ __forceinline__ void xcd_barrier(const XcdBarrier& b) {
    asm volatile("s_waitcnt vmcnt(0)" ::: "memory");
    __syncthreads();
    if (threadIdx.x == 0) {
        unsigned* bar = b.bar;
        __builtin_amdgcn_s_waitcnt(0);
        unsigned nloc = b.st[0], nx = b.st[1];
        if (nloc == 0u) { xcd_barrier_complete(bar, b.x, nloc, nx); b.st[0] = nloc; b.st[1] = nx; }
        const unsigned old = xb_add(&bar[XB_XSUB(b.x)], 1u);
        const unsigned gen = old / nloc;
        if (old + 1u == (gen + 1u) * nloc) {
            __builtin_amdgcn_fence(__ATOMIC_RELEASE, "agent");
            asm volatile("s_waitcnt vmcnt(0)" ::: "memory");
            const unsigned og = xb_add(&bar[XB_TOP], 1u);
            const unsigned tg = og / nx;
            if (og + 1u == (tg + 1u) * nx) xb_add(&bar[XB_TOPGEN], 1u);
            else XB_SPIN(xb_ld(&bar[XB_TOPGEN]) == tg, bar);
            __builtin_amdgcn_fence(__ATOMIC_ACQUIRE, "agent");
            xb_add(&bar[XB_XGEN(b.x)], 1u);
            asm volatile("s_waitcnt vmcnt(0)" ::: "memory");
        } else {
            XB_SPIN(xb_ld(&bar[XB_XGEN(b.x)]) == gen, bar);
            __builtin_amdgcn_fence(__ATOMIC_ACQUIRE, "agent");
            asm volatile("s_waitcnt vmcnt(0)" ::: "memory");
        }
    }
    __syncthreads();
}

struct Frame {
    LAS unsigned char* lds;
    volatile LAS unsigned* MISC;
    gu32* ctl;
    int tid, lane, wave, vcu, G;
    unsigned char* ws;
    const float* in[26];
    float* out;
};
enum { IN_X = 0, IN_C, IN_WADA, IN_BADA, IN_NFFN1, IN_WFFN1IN, IN_WFFN1OUT, IN_NMIX, IN_WIN, IN_LAMRE, IN_LAMIM, IN_LOGDT, IN_BRE, IN_BIM, IN_CRE, IN_CIM, IN_SSMD,
       IN_WGLU, IN_BGLU, IN_WBRATT, IN_WBRSSM, IN_WOUT, IN_NFFN2, IN_WFFN2IN, IN_WFFN2OUT, IN_NFINAL };

__device__ __forceinline__ int gu_row(int n) { return n < FF ? ((n >> 7) << 8) + (n & 127) : (((n - FF) >> 7) << 8) + 128 + ((n - FF) & 127); }
__device__ __forceinline__ void p0_transpose_item(const float* W, int K, int N, bf16* WT, int mode, LAS float* scr, int item, int lane) {
    const int nblk = N / 32, kb = item / nblk, nb = item % nblk, k0 = 64 * kb, n0 = 32 * nb;
    const int r0 = mode ? gu_row(n0) : n0;
#pragma unroll 8
    for (int i = 0; i < 32; ++i) { const int kk = 2 * i + (lane >> 5); scr[kk * 33 + (lane & 31)] = W[(size_t)(k0 + kk) * N + n0 + (lane & 31)]; }
    LDS_WAIT(); asm volatile("" ::: "memory");
    const int c = lane & 7;
#pragma unroll
    for (int j = 0; j < 4; ++j) { const int n = (lane >> 3) + 8 * j; const LAS float* s = scr + (8 * c) * 33 + n;
        v4u o; o.x = pk2(s[0 * 33], s[1 * 33]); o.y = pk2(s[2 * 33], s[3 * 33]); o.z = pk2(s[4 * 33], s[5 * 33]); o.w = pk2(s[6 * 33], s[7 * 33]);
        *(GAS v4u*)(WT + (size_t)(r0 + n) * K + k0 + 8 * c) = o; }
    LDS_WAIT(); asm volatile("" ::: "memory");
}

__device__ __forceinline__ void ssm_lane_params(const Frame& F, int g, int p, float& lr_dt, float& li_dt, float& fr, float& fi) {
    const float lr = F.in[IN_LAMRE][g * SP + p], li = F.in[IN_LAMIM][g * SP + p], dt = __expf(F.in[IN_LOGDT][g]);
    lr_dt = lr * dt; li_dt = li * dt;
    float sn, cs; __sincosf(li_dt, &sn, &cs); const float mg = __expf(lr_dt);
    const float nr = mg * cs - 1.0f, ni = mg * sn, den = lr * lr + li * li;
    fr = (nr * lr + ni * li) / den; fi = (ni * lr - nr * li) / den;
}
__device__ __forceinline__ void cpow(float lr_dt, float li_dt, float n, float& pr, float& pi) { float sn, cs; __sincosf(li_dt * n, &sn, &cs); const float mg = __expf(lr_dt * n); pr = mg * cs; pi = mg * sn; }

__device__ __forceinline__ void p0_ssm_kmat_item(const Frame& F, int item, LAS float* scr) {
    const int g = item / 63, lag = item % 63 - 31, lane = F.lane;
    bf16* Bm = (bf16*)(F.ws + WS_BM) + (size_t)g * 512 * KSSM;
    const int co = lane >> 2, ci0 = (lane & 3) * 4;
    float k0 = 0.f, k1 = 0.f, k2 = 0.f, k3 = 0.f;
    if (lag >= 0) {
        LAS float* Dre = scr; LAS float* Dim = scr + 1024; LAS float* Cre = scr + 2048; LAS float* Cim = scr + 3072;
        float lr_dt, li_dt, fr, fi; ssm_lane_params(F, g, lane, lr_dt, li_dt, fr, fi);
        float pr, pi; cpow(lr_dt, li_dt, (float)lag, pr, pi);
#pragma unroll
        for (int c = 0; c < 16; c += 4) {
            f32x4 dr, di, cr4, ci4;
#pragma unroll
            for (int e = 0; e < 4; ++e) {
                const float br = F.in[IN_BRE][(g * SP + lane) * SC + c + e], bi = F.in[IN_BIM][(g * SP + lane) * SC + c + e];
                const float bbr = fr * br - fi * bi, bbi = fr * bi + fi * br;
                dr[e] = pr * bbr - pi * bbi; di[e] = pr * bbi + pi * bbr;
                cr4[e] = F.in[IN_CRE][(g * SC + c + e) * SP + lane]; ci4[e] = F.in[IN_CIM][(g * SC + c + e) * SP + lane];
            }
            *(LAS f32x4*)(Dre + lane * 16 + c) = dr; *(LAS f32x4*)(Dim + lane * 16 + c) = di; *(LAS f32x4*)(Cre + lane * 16 + c) = cr4; *(LAS f32x4*)(Cim + lane * 16 + c) = ci4;
        }
        LDS_WAIT(); asm volatile("" ::: "memory");
#pragma unroll 4
        for (int p = 0; p < 64; ++p) {
            const float cr = Cre[p * 16 + co], cim = Cim[p * 16 + co];
            const f32x4 dr = *(const LAS f32x4*)(Dre + p * 16 + ci0), di = *(const LAS f32x4*)(Dim + p * 16 + ci0);
            k0 += cr * dr[0] - cim * di[0]; k1 += cr * dr[1] - cim * di[1]; k2 += cr * dr[2] - cim * di[2]; k3 += cr * dr[3] - cim * di[3];
        }
        LDS_WAIT(); asm volatile("" ::: "memory");
    }
    const unsigned long long w = (unsigned long long)pk2(k0, k1) | ((unsigned long long)pk2(k2, k3) << 32);
    const int alag = lag < 0 ? -lag : lag;
    for (int i = 0; i < 32 - alag; ++i) { const int sI = lag >= 0 ? i + lag : i, tI = lag >= 0 ? i : i + alag;
        *(GAS unsigned long long*)(Bm + (size_t)(sI * 16 + co) * KSSM + tI * 16 + ci0) = w; }
}
__device__ __forceinline__ void p0_ssm_vs_item(const Frame& F, int item) {
    const int g = item >> 5, s = item & 31, p = F.lane;
    float lr_dt, li_dt, fr, fi; ssm_lane_params(F, g, p, lr_dt, li_dt, fr, fi);
    {
        float pr, pi; cpow(lr_dt, li_dt, (float)(s + 1), pr, pi);
        bf16* Bm = (bf16*)(F.ws + WS_BM) + (size_t)g * 512 * KSSM;
#pragma unroll
        for (int co = 0; co < 16; ++co) {
            const float cr = F.in[IN_CRE][(g * SC + co) * SP + p], ci = F.in[IN_CIM][(g * SC + co) * SP + p];
            bf16* row = Bm + (size_t)(s * 16 + co) * KSSM + 512;
            row[p] = (bf16)f2bf(cr * pr - ci * pi); row[64 + p] = (bf16)f2bf(-(cr * pi + ci * pr));
        }
    }
    {
        float pr, pi; cpow(lr_dt, li_dt, (float)(31 - s), pr, pi);
        bf16* Bs = (bf16*)(F.ws + WS_BS) + (size_t)g * 256 * 512;
        unsigned wr_[8], wi_[8];
#pragma unroll
        for (int c = 0; c < 16; c += 2) {
            float vr[2], vi[2];
#pragma unroll
            for (int e = 0; e < 2; ++e) { const float br = F.in[IN_BRE][(g * SP + p) * SC + c + e], bi = F.in[IN_BIM][(g * SP + p) * SC + c + e];
                const float bbr = fr * br - fi * bi, bbi = fr * bi + fi * br; vr[e] = pr * bbr - pi * bbi; vi[e] = pr * bbi + pi * bbr; }
            wr_[c >> 1] = pk2(vr[0], vr[1]); wi_[c >> 1] = pk2(vi[0], vi[1]);
        }
        GAS v4u* d0 = (GAS v4u*)(Bs + (size_t)p * 512 + s * 16); GAS v4u* d1 = (GAS v4u*)(Bs + (size_t)(64 + p) * 512 + s * 16);
        GAS v4u* z0 = (GAS v4u*)(Bs + (size_t)(128 + p) * 512 + s * 16); GAS v4u* z1 = (GAS v4u*)(Bs + (size_t)(192 + p) * 512 + s * 16);
        d0[0] = (v4u){wr_[0], wr_[1], wr_[2], wr_[3]}; d0[1] = (v4u){wr_[4], wr_[5], wr_[6], wr_[7]};
        d1[0] = (v4u){wi_[0], wi_[1], wi_[2], wi_[3]}; d1[1] = (v4u){wi_[4], wi_[5], wi_[6], wi_[7]};
        z0[0] = (v4u){0u, 0u, 0u, 0u}; z0[1] = (v4u){0u, 0u, 0u, 0u}; z1[0] = (v4u){0u, 0u, 0u, 0u}; z1[1] = (v4u){0u, 0u, 0u, 0u};
    }
}

__device__ __forceinline__ void p0_prologue(Frame& F) {
    LAS float* sl = (LAS float*)(F.lds + SILU_OFF);
    for (int i = F.tid; i < BATCH * D; i += NWAVES * 64) sl[i] = siluf_(F.in[IN_C][i]);
    __syncthreads();
    LAS float* scr = (LAS float*)(F.lds + RING_OFF + F.wave * 16384);
    const int gw = F.vcu * NWAVES + F.wave, NGW = F.G * NWAVES;
    bf16* ws16 = (bf16*)F.ws;
    constexpr int I_ADA = NADA / 64;
    constexpr int I_UP = (D / 64) * (NGU / 32), I_DN = (FF / 64) * (D / 32), I_IN = (D / 64) * (NIN / 32), I_GLU = (SW / 64) * (SW / 32), I_BR = (AW / 64) * (D / 32), I_OUT = (D / 64) * (D / 32);
    constexpr int I_KM = SG * 63, I_VS = SG * 32;
    constexpr int NITEMS = I_ADA + I_KM + I_VS + 2 * I_UP + 2 * I_DN + I_IN + I_GLU + 2 * I_BR + I_OUT;
    for (int it = gw; it < NITEMS; it += NGW) {
        int r = it;
        if (r < I_ADA) {
            const int n = r * 64 + F.lane; const float* W = F.in[IN_WADA] + n;
            float a0 = 0.f, a1 = 0.f, a2 = 0.f, a3 = 0.f;
#pragma unroll 2
            for (int k = 0; k < D; k += 4) {
                const f32x4 s0 = *(const LAS f32x4*)(sl + k), s1 = *(const LAS f32x4*)(sl + D + k), s2 = *(const LAS f32x4*)(sl + 2 * D + k), s3 = *(const LAS f32x4*)(sl + 3 * D + k);
#pragma unroll
                for (int i = 0; i < 4; ++i) { const float w = W[(size_t)(k + i) * NADA]; a0 += s0[i] * w; a1 += s1[i] * w; a2 += s2[i] * w; a3 += s3[i] * w; }
            }
            float* ada = (float*)(F.ws + WS_ADA); const float bb = F.in[IN_BADA][n];
            ada[n] = a0 + bb; ada[NADA + n] = a1 + bb; ada[2 * NADA + n] = a2 + bb; ada[3 * NADA + n] = a3 + bb;
            continue;
        }
        r -= I_ADA;
        if (r < I_KM) { p0_ssm_kmat_item(F, r, scr); continue; } r -= I_KM;
        if (r < I_VS) { p0_ssm_vs_item(F, r); continue; } r -= I_VS;
        if (r < I_UP) { p0_transpose_item(F.in[IN_WFFN1IN], D, NGU, ws16 + WS_W1T / 2, 1, scr, r, F.lane); continue; } r -= I_UP;
        if (r < I_UP) { p0_transpose_item(F.in[IN_WFFN2IN], D, NGU, ws16 + WS_W3T / 2, 1, scr, r, F.lane); continue; } r -= I_UP;
        if (r < I_DN) { p0_transpose_item(F.in[IN_WFFN1OUT], FF, D, ws16 + WS_W2T / 2, 0, scr, r, F.lane); continue; } r -= I_DN;
        if (r < I_DN) { p0_transpose_item(F.in[IN_WFFN2OUT], FF, D, ws16 + WS_W4T / 2, 0, scr, r, F.lane); continue; } r -= I_DN;
        if (r < I_IN) { p0_transpose_item(F.in[IN_WIN], D, NIN, ws16 + WS_WINT / 2, 0, scr, r, F.lane); continue; } r -= I_IN;
        if (r < I_GLU) { p0_transpose_item(F.in[IN_WGLU], SW, SW, ws16 + WS_WGLU / 2, 0, scr, r, F.lane); continue; } r -= I_GLU;
        if (r < I_BR) { p0_transpose_item(F.in[IN_WBRATT], AW, D, ws16 + WS_WBRA / 2, 0, scr, r, F.lane); continue; } r -= I_BR;
        if (r < I_BR) { p0_transpose_item(F.in[IN_WBRSSM], SW, D, ws16 + WS_WBRS / 2, 0, scr, r, F.lane); continue; } r -= I_BR;
        p0_transpose_item(F.in[IN_WOUT], D, D, ws16 + WS_WOUT / 2, 0, scr, r, F.lane);
    }
}

__device__ __forceinline__ void p1_phase(Frame& F) {
    const int gw = F.vcu * NWAVES + F.wave, NGW = F.G * NWAVES;
    const float* ada = (const float*)(F.ws + WS_ADA);
    for (int i = gw * 64 + F.lane; i < 2 * BATCH * D; i += NGW * 64) {
        const int which = i / (BATCH * D), r = i % (BATCH * D), b = r / D, c = r % D;
        const float gwt = which ? F.in[IN_NFFN2][c] : F.in[IN_NMIX][c];
        const float sc = ada[b * NADA + (which ? 7 : 4) * D + c];
        ((float*)(F.ws + (which ? WS_CS3 : WS_CS2)))[r] = gwt * (1.0f + sc);
    }
    for (int it = gw; it < NIN + NGU; it += NGW) {
        const bool second = it >= NIN; const int n = second ? it - NIN : it;
        const bf16* wrow = (const bf16*)(F.ws + (second ? WS_W3T : WS_WINT)) + (size_t)n * D;
        const float* sh = ada + (second ? 6 : 3) * D;
        float a[4] = {0.f, 0.f, 0.f, 0.f};
#pragma unroll
        for (int j = 0; j < 2; ++j) {
            const int k = 8 * F.lane + 512 * j;
            const v4u w = *(const GAS v4u*)(wrow + k);
            const float wf[8] = {bflo(w.x), bfhi(w.x), bflo(w.y), bfhi(w.y), bflo(w.z), bfhi(w.z), bflo(w.w), bfhi(w.w)};
#pragma unroll
            for (int b = 0; b < 4; ++b) { const f32x4 s0 = *(const f32x4*)(sh + b * NADA + k), s1 = *(const f32x4*)(sh + b * NADA + k + 4);
                a[b] += wf[0] * s0[0] + wf[1] * s0[1] + wf[2] * s0[2] + wf[3] * s0[3] + wf[4] * s1[0] + wf[5] * s1[1] + wf[6] * s1[2] + wf[7] * s1[3]; }
        }
#pragma unroll
        for (int b = 0; b < 4; ++b) a[b] = wave_sum(a[b]);
        if (F.lane == 0) { float* dst = (float*)(F.ws + (second ? WS_BIAS3 : WS_BIAS2)); const int N = second ? NGU : NIN;
#pragma unroll
            for (int b = 0; b < 4; ++b) dst[b * N + n] = a[b]; }
    }
    bf16* h1 = (bf16*)F.out;
    for (int m = gw; m < T; m += NGW) {
        const int b = m / SEQ;
        const GAS f32x4* xr = (const GAS f32x4*)(F.in[IN_X] + (size_t)m * D) + F.lane;
        f32x4 v[4]; float s = 0.f;
#pragma unroll
        for (int j = 0; j < 4; ++j) { v[j] = xr[64 * j]; s += (v[j].x * v[j].x + v[j].y * v[j].y) + (v[j].z * v[j].z + v[j].w * v[j].w); }
        const float rstd = __builtin_amdgcn_rsqf(wave_sum(s) * (1.f / D) + EPS);
        GAS unsigned long long* o8 = (GAS unsigned long long*)(h1 + (size_t)m * D) + F.lane;
#pragma unroll
        for (int j = 0; j < 4; ++j) {
            const int c = 4 * F.lane + 256 * j;
            const f32x4 g = *(const f32x4*)(F.in[IN_NFFN1] + c), sh = *(const f32x4*)(ada + b * NADA + c), sc = *(const f32x4*)(ada + b * NADA + D + c);
            const f32x4 h = v[j] * rstd * g * (sc + 1.0f) + sh;
            o8[64 * j] = (unsigned long long)pk2(h.x, h.y) | ((unsigned long long)pk2(h.z, h.w) << 32);
        }
    }
}

__device__ __forceinline__ void final_norm_phase(Frame& F) {
    const int gw = F.vcu * NWAVES + F.wave, NGW = F.G * NWAVES;
    const float* rowss = (const float*)(F.ws + WS_ROWSS);
    for (int m = gw; m < T; m += NGW) {
        const float r = pg8::row_rnorm(rowss, m);
        GAS f32x4* xr = (GAS f32x4*)(F.out + (size_t)m * D) + F.lane;
#pragma unroll
        for (int j = 0; j < 4; ++j) { const f32x4 g = *(const f32x4*)(F.in[IN_NFINAL] + 4 * F.lane + 256 * j); xr[64 * j] = xr[64 * j] * r * g; }
    }
}

__device__ __forceinline__ void gating_phase(Frame& F) {
    LAS float* km = (LAS float*)(F.lds + RING_OFF);
    const float* kmeanp = (const float*)(F.ws + WS_KMEANP);
    const bf16* q = (const bf16*)(F.ws + WS_Q);
    unsigned* sel = (unsigned*)(F.ws + WS_SEL);
    constexpr int NITEM = BATCH * NH * NBLK;
    for (int it = F.vcu; it < NITEM; it += F.G) {
        const int i = it & 31, h = (it >> 5) & 7, b = it >> 8;
        __syncthreads();
        for (int e = F.tid; e < i * 64; e += NWAVES * 64) { const int n = e >> 6, d = e & 63;
            km[e] = (kmeanp[(size_t)((b * NBLK + n) * 2 + 0) * AW + h * HD + d] + kmeanp[(size_t)((b * NBLK + n) * 2 + 1) * AW + h * HD + d]) * (1.0f / 256.0f); }
        __syncthreads();
        const int ql = F.lane & 31, half = F.lane >> 5, t = i * MBLK + F.wave * 32 + ql;
        const bf16* qrow = q + (size_t)(b * SEQ + t) * AW + h * HD;
        float qf[64];
#pragma unroll
        for (int c = 0; c < 8; ++c) { const v4u w = *(const GAS v4u*)(qrow + 8 * c);
            qf[8 * c + 0] = bflo(w.x); qf[8 * c + 1] = bfhi(w.x); qf[8 * c + 2] = bflo(w.y); qf[8 * c + 3] = bfhi(w.y); qf[8 * c + 4] = bflo(w.z); qf[8 * c + 5] = bfhi(w.z); qf[8 * c + 6] = bflo(w.w); qf[8 * c + 7] = bfhi(w.w); }
        float v0 = -3e38f, v1 = -3e38f, v2 = -3e38f; int i0 = 255, i1 = 255, i2 = 255;
        for (int n = half; n < i; n += 2) {
            const LAS f32x4* kr = (const LAS f32x4*)(km + n * 64);
            float dot = 0.f;
#pragma unroll
            for (int c = 0; c < 16; ++c) { const f32x4 kv = kr[c]; dot += qf[4 * c] * kv[0] + qf[4 * c + 1] * kv[1] + qf[4 * c + 2] * kv[2] + qf[4 * c + 3] * kv[3]; }
            if (dot > v0) { v2 = v1; i2 = i1; v1 = v0; i1 = i0; v0 = dot; i0 = n; }
            else if (dot > v1) { v2 = v1; i2 = i1; v1 = dot; i1 = n; }
            else if (dot > v2) { v2 = dot; i2 = n; }
        }
        const float ov[3] = {__shfl_xor(v0, 32), __shfl_xor(v1, 32), __shfl_xor(v2, 32)};
        const int oi[3] = {__shfl_xor(i0, 32), __shfl_xor(i1, 32), __shfl_xor(i2, 32)};
#pragma unroll
        for (int k = 0; k < 3; ++k) {
            const float d = ov[k]; const int n = oi[k];
            if (d > v0 || (d == v0 && n < i0)) { v2 = v1; i2 = i1; v1 = v0; i1 = i0; v0 = d; i0 = n; }
            else if (d > v1 || (d == v1 && n < i1)) { v2 = v1; i2 = i1; v1 = d; i1 = n; }
            else if (d > v2 || (d == v2 && n < i2)) { v2 = d; i2 = n; }
        }
        if (half == 0) sel[(size_t)(b * NH + h) * SEQ + t] = (unsigned)i0 | ((unsigned)i1 << 8) | ((unsigned)i2 << 16);
    }
}

__device__ __forceinline__ void attn_simple_phase(Frame& F) {
    LAS float* qs = (LAS float*)(F.lds + RING_OFF + F.wave * 8192);
    LAS float* pb = qs + 64;
    const bf16* q = (const bf16*)(F.ws + WS_Q); const bf16* k = (const bf16*)(F.ws + WS_K); const bf16* v = (const bf16*)(F.ws + WS_V);
    const unsigned* sel = (const unsigned*)(F.ws + WS_SEL);
    bf16* yatt = (bf16*)(F.ws + WS_YATT);
    const int gw = F.vcu * NWAVES + F.wave, NGW = F.G * NWAVES;
    for (int id = gw; id < BATCH * NH * SEQ; id += NGW) {
        const int t = id & (SEQ - 1), h = (id >> 13) & 7, b = id >> 16;
        const int own = t >> 8, nvalid = own < 3 ? own : 3;
        const float slope2 = exp2f(-(float)(h + 1)) * LOG2E;
        const size_t rowq = (size_t)(b * SEQ + t) * AW + h * HD;
        qs[F.lane] = bf2f(q[rowq + F.lane]);
        LDS_WAIT(); asm volatile("" ::: "memory");
        float qf[64];
#pragma unroll
        for (int c = 0; c < 16; ++c) { const f32x4 x = *(const LAS f32x4*)(qs + 4 * c); qf[4 * c] = x[0]; qf[4 * c + 1] = x[1]; qf[4 * c + 2] = x[2]; qf[4 * c + 3] = x[3]; }
        const unsigned sw = sel[(size_t)(b * NH + h) * SEQ + t];
        int blk[4]; blk[0] = sw & 255; blk[1] = (sw >> 8) & 255; blk[2] = (sw >> 16) & 255; blk[3] = own;
        float sc[16]; float mx = -1e30f;
#pragma unroll
        for (int s = 0; s < 4; ++s) {
            const bool valid = (s == 3) || (s < nvalid);
#pragma unroll
            for (int kk = 0; kk < 4; ++kk) {
                float val = -1e30f;
                if (valid) {
                    const int kpos = blk[s] * MBLK + kk * 64 + F.lane;
                    if (s < 3 || kpos <= t) {
                        const bf16* kr = k + (size_t)(b * SEQ + kpos) * AW + h * HD;
                        float dot = 0.f;
#pragma unroll
                        for (int c = 0; c < 8; ++c) { const v4u w = *(const GAS v4u*)(kr + 8 * c);
                            dot += qf[8 * c] * bflo(w.x) + qf[8 * c + 1] * bfhi(w.x) + qf[8 * c + 2] * bflo(w.y) + qf[8 * c + 3] * bfhi(w.y) + qf[8 * c + 4] * bflo(w.z) + qf[8 * c + 5] * bfhi(w.z) + qf[8 * c + 6] * bflo(w.w) + qf[8 * c + 7] * bfhi(w.w); }
                        val = dot + slope2 * (float)(kpos - t);
                    }
                }
                sc[s * 4 + kk] = val; mx = fmaxf(mx, val);
            }
        }
        mx = wave_max(mx);
        float l = 0.f;
#pragma unroll
        for (int i = 0; i < 16; ++i) { const float p = fast_exp2(sc[i] - mx); l += p; pb[i * 64 + F.lane] = p; }
        l = wave_sum(l);
        LDS_WAIT(); asm volatile("" ::: "memory");
        float o = 0.f;
#pragma unroll
        for (int s = 0; s < 4; ++s) {
            const bool valid = (s == 3) || (s < nvalid);
            if (!valid) continue;
            const int nk = (s == 3) ? (t & 255) + 1 : 256;
            const bf16* vb = v + (size_t)(b * SEQ + blk[s] * MBLK) * AW + h * HD + F.lane;
            const LAS float* pp = pb + s * 256;
#pragma unroll 8
            for (int j = 0; j < nk; ++j) o += pp[j] * bf2f(vb[(size_t)j * AW]);
        }
        yatt[rowq + F.lane] = (bf16)f2bf(o / l);
        LDS_WAIT(); asm volatile("" ::: "memory");
    }
}

__device__ __forceinline__ void ssm_simple_phase(Frame& F) {
    const int gw = F.vcu * NWAVES + F.wave;
    if (gw >= BATCH * SG) return;
    const int g = gw % SG, b = gw / SG, p = F.lane;
    const float lr = F.in[IN_LAMRE][g * SP + p], li = F.in[IN_LAMIM][g * SP + p], dt = expf(F.in[IN_LOGDT][g]);
    const float mag = expf(lr * dt), ang = li * dt;
    float sn_, cs_; sincosf(ang, &sn_, &cs_);
    const float ar = mag * cs_, ai = mag * sn_;
    const float nr = ar - 1.0f, ni = ai, den = lr * lr + li * li;
    const float fr = (nr * lr + ni * li) / den, fi = (ni * lr - nr * li) / den;
    float bbr[16], bbi[16], cr[16], ci[16];
#pragma unroll
    for (int c = 0; c < 16; ++c) {
        const float br = F.in[IN_BRE][(g * SP + p) * SC + c], bi = F.in[IN_BIM][(g * SP + p) * SC + c];
        bbr[c] = fr * br - fi * bi; bbi[c] = fr * bi + fi * br;
        cr[c] = F.in[IN_CRE][(g * SC + c) * SP + p]; ci[c] = F.in[IN_CIM][(g * SC + c) * SP + p];
    }
    const bf16* A = (const bf16*)(F.ws + WS_SSMA);
    bf16* y1 = (bf16*)(F.ws + WS_Y1);
    const float dsk = F.in[IN_SSMD][g * SC + (F.lane & 15)];
    float xr = 0.f, xi = 0.f;
    for (int t = 0; t < SEQ; ++t) {
        const bf16* urow = A + ((size_t)(g * 1024 + b * NCH + (t >> 5)) * KSSM + (t & 31) * SC);
        const float ul = bf2f(urow[F.lane & 15]);
        float bur = 0.f, bui = 0.f;
#pragma unroll
        for (int c = 0; c < 16; ++c) { const float uc = __shfl(ul, c); bur += bbr[c] * uc; bui += bbi[c] * uc; }
        const float nxr = ar * xr - ai * xi + bur, nxi = ar * xi + ai * xr + bui;
        xr = nxr; xi = nxi;
        float yv = 0.f;
#pragma unroll
        for (int c = 0; c < 16; ++c) { const float part = wave_sum(cr[c] * xr - ci[c] * xi); if ((F.lane & 15) == c) yv = part; }
        if (F.lane < 16) { const float val = yv + dsk * ul; y1[(size_t)(b * SEQ + t) * SW + g * SC + F.lane] = (bf16)f2bf(gelu_tanh(val)); }
    }
}

struct Args { const float* in[26]; float* out; unsigned char* ws; int ph_lo, ph_hi, li, pad; };

__global__ void __launch_bounds__(NWAVES * 64, 2) hybrid_fwd(Args args) {
    extern __shared__ __attribute__((aligned(16))) unsigned char lds[];
    Frame F;
    F.lds = (LAS unsigned char*)lds;
    F.MISC = (volatile LAS unsigned*)(F.lds + MISC_OFF);
    F.tid = threadIdx.x; F.lane = F.tid & 63; F.wave = __builtin_amdgcn_readfirstlane(F.tid >> 6);
    F.G = gridDim.x; { const int bx = blockIdx.x; F.vcu = (F.G % 8 == 0) ? (bx % 8) * (F.G / 8) + bx / 8 : bx; }
    F.ws = args.ws; F.ctl = (gu32*)(args.ws + WS_CTL); F.out = args.out;
#pragma unroll
    for (int i = 0; i < 26; ++i) F.in[i] = args.in[i];
    for (int u = F.tid; u < 64; u += NWAVES * 64) ((LAS unsigned*)(F.lds + MISC_OFF))[u] = 0u;
    __syncthreads();
    XcdBarrier bar; bar.bar = (unsigned*)(F.ctl + CW_BAR); bar.x = 0; bar.st = nullptr;
    if (MK_N_LAUNCHES == 1) bar = xcd_barrier_post((unsigned*)(F.ctl + CW_BAR), F.MISC + 8);
#define GRID_BAR() do { if (MK_N_LAUNCHES == 1) xcd_barrier(bar); } while (0)
    const int lo = args.ph_lo, hi = args.ph_hi;
#define IN(k) (lo <= (k) && (k) < hi)
#define BOTH(k) (IN(k) && IN((k) + 1))
    unsigned char* ws = args.ws;
    const float* ada = (const float*)(ws + WS_ADA);
    float* rowss = (float*)(ws + WS_ROWSS);
    const int bx = (int)blockIdx.x;

    if (IN(0)) { p0_prologue(F); if (BOTH(0)) GRID_BAR(); }
    if (IN(1)) { p1_phase(F); if (BOTH(1)) GRID_BAR(); }
    if (IN(2)) {
        pg8::Gemm g{(const bf16*)F.out, (const bf16*)(ws + WS_W1T), D, D, D, nullptr, nullptr, 0}; pg8::StaticOrder S; S.init(T, NGU, F.G, bx);
        pg8::EpiSwiGLU<false> E{(bf16*)(ws + WS_ACT), nullptr, nullptr};
        pg8::gemm_phase<pg8::EpiSwiGLU<false>, pg8::StaticOrder, true>(F.lds + RING_OFF, g, S, E);
        if (BOTH(2)) GRID_BAR();
    }
    if (IN(3)) {
        pg8::Gemm g{(const bf16*)(ws + WS_ACT), (const bf16*)(ws + WS_W2T), FF, FF, FF, nullptr, nullptr, 0}; pg8::StaticOrder S; S.init(T, D, F.G, bx);
        pg8::EpiResid<true, 0> E{F.in[IN_X], F.out, ada + 2 * D, (bf16*)(ws + WS_X1S), (const float*)(ws + WS_CS2), rowss, 0.5f};
        pg8::gemm_phase<pg8::EpiResid<true, 0>, pg8::StaticOrder, true>(F.lds + RING_OFF, g, S, E);
        if (BOTH(3)) GRID_BAR();
    }
    if (IN(4)) {
        pg8::Gemm g{(const bf16*)(ws + WS_X1S), (const bf16*)(ws + WS_WINT), D, D, D, nullptr, nullptr, 0}; pg8::StaticOrder S; S.init(T, NIN, F.G, bx);
        pg8::EpiIn E{rowss, (const float*)(ws + WS_BIAS2), (bf16*)(ws + WS_Q), (bf16*)(ws + WS_K), (bf16*)(ws + WS_V), (bf16*)(ws + WS_SSMA), (bf16*)(ws + WS_SGA), (bf16*)(ws + WS_SGS), (float*)(ws + WS_KMEANP)};
        pg8::gemm_phase<pg8::EpiIn, pg8::StaticOrder, true>(F.lds + RING_OFF, g, S, E);
        if (BOTH(4)) GRID_BAR();
    }
    if (IN(5)) {
        {
            pg8::Gemm g{(const bf16*)(ws + WS_SSMA), (const bf16*)(ws + WS_BS), KSSM, 512, 512, nullptr, nullptr, 0}; pg8::BlockDiagOrder S; S.init(SG, 4, 1, F.G, bx);
            pg8::EpiSsmState E{(bf16*)(ws + WS_SSMA), F.in[IN_LAMRE], F.in[IN_LAMIM], F.in[IN_LOGDT]};
            pg8::gemm_phase<pg8::EpiSsmState, pg8::BlockDiagOrder, false>(F.lds + RING_OFF, g, S, E);
        }
        gating_phase(F); if (BOTH(5)) GRID_BAR();
    }
    if (IN(6)) {
        {
            pg8::Gemm g{(const bf16*)(ws + WS_SSMA), (const bf16*)(ws + WS_BM), KSSM, KSSM, KSSM, nullptr, nullptr, 0}; pg8::BlockDiagOrder S; S.init(SG, 4, 2, F.G, bx);
            pg8::EpiSsmMain E{(const bf16*)(ws + WS_SSMA), F.in[IN_SSMD], (bf16*)(ws + WS_Y1)};
            pg8::gemm_phase<pg8::EpiSsmMain, pg8::BlockDiagOrder, true>(F.lds + RING_OFF, g, S, E);
        }
        attn_simple_phase(F); if (BOTH(6)) GRID_BAR(); }
    if (IN(7)) {
        pg8::Gemm g{(const bf16*)(ws + WS_Y1), (const bf16*)(ws + WS_WGLU), SW, SW, SW, nullptr, nullptr, 0}; pg8::StaticOrder S; S.init(T, SW, F.G, bx);
        pg8::EpiGlu E{(const bf16*)(ws + WS_Y1), F.in[IN_BGLU], (bf16*)(ws + WS_YSSM)};
        pg8::gemm_phase<pg8::EpiGlu, pg8::StaticOrder, true>(F.lds + RING_OFF, g, S, E);
        if (BOTH(7)) GRID_BAR();
    }
    if (IN(8)) {
        pg8::Gemm g{(const bf16*)(ws + WS_YATT), (const bf16*)(ws + WS_WBRA), AW, AW, AW, (const bf16*)(ws + WS_YSSM), (const bf16*)(ws + WS_WBRS), SW}; pg8::StaticOrder S; S.init(T, D, F.G, bx);
        pg8::EpiMerge E{(const bf16*)(ws + WS_SGA), (const bf16*)(ws + WS_SGS), (bf16*)(ws + WS_MERGED)};
        pg8::gemm_phase<pg8::EpiMerge, pg8::StaticOrder, true>(F.lds + RING_OFF, g, S, E);
        if (BOTH(8)) GRID_BAR();
    }
    if (IN(9)) {
        pg8::Gemm g{(const bf16*)(ws + WS_MERGED), (const bf16*)(ws + WS_WOUT), D, D, D, nullptr, nullptr, 0}; pg8::StaticOrder S; S.init(T, D, F.G, bx);
        pg8::EpiResid<true, 1> E{F.out, F.out, ada + 5 * D, (bf16*)(ws + WS_X2S), (const float*)(ws + WS_CS3), rowss, 1.0f};
        pg8::gemm_phase<pg8::EpiResid<true, 1>, pg8::StaticOrder, true>(F.lds + RING_OFF, g, S, E);
        if (BOTH(9)) GRID_BAR();
    }
    if (IN(10)) {
        pg8::Gemm g{(const bf16*)(ws + WS_X2S), (const bf16*)(ws + WS_W3T), D, D, D, nullptr, nullptr, 0}; pg8::StaticOrder S; S.init(T, NGU, F.G, bx);
        pg8::EpiSwiGLU<true> E{(bf16*)(ws + WS_ACT), rowss, (const float*)(ws + WS_BIAS3)};
        pg8::gemm_phase<pg8::EpiSwiGLU<true>, pg8::StaticOrder, true>(F.lds + RING_OFF, g, S, E);
        if (BOTH(10)) GRID_BAR();
    }
    if (IN(11)) {
        pg8::Gemm g{(const bf16*)(ws + WS_ACT), (const bf16*)(ws + WS_W4T), FF, FF, FF, nullptr, nullptr, 0}; pg8::StaticOrder S; S.init(T, D, F.G, bx);
        pg8::EpiResid<false, 2> E{F.out, F.out, ada + 8 * D, nullptr, nullptr, rowss, 0.5f};
        pg8::gemm_phase<pg8::EpiResid<false, 2>, pg8::StaticOrder, true>(F.lds + RING_OFF, g, S, E);
        if (BOTH(11)) GRID_BAR();
    }
    if (IN(12)) { final_norm_phase(F); }
#undef IN
#undef BOTH
}

extern "C" void kernel_launch(void* const* d_in, const int* in_sizes, int n_in, void* d_out, int out_size, void* d_ws, size_t ws_size, hipStream_t stream) {
    static int grid = 0;
    if (grid == 0) {
        if (n_in != 26 || in_sizes[0] != T * D || out_size != T * D || ws_size < WS_END) { fprintf(stderr, "kernel_launch: unexpected shapes (n_in %d, in0 %d, out %d, ws %zu < %zu); nothing launched\n", n_in, n_in > 0 ? in_sizes[0] : -1, out_size, ws_size, (size_t)WS_END); grid = -1; return; }
        int dev = 0, cus = 0;
        if (hipGetDevice(&dev) != hipSuccess || hipDeviceGetAttribute(&cus, hipDeviceAttributeMultiprocessorCount, dev) != hipSuccess) { grid = -1; return; }
        if (hipFuncSetAttribute((const void*)hybrid_fwd, hipFuncAttributeMaxDynamicSharedMemorySize, LDS_BYTES) != hipSuccess) { fprintf(stderr, "kernel_launch: hipFuncSetAttribute failed\n"); grid = -1; return; }
        (void)hipGetLastError();
        grid = cus;
    }
    if (grid < 0) return;
    if (hipMemsetAsync((char*)d_ws + WS_CTL, 0, CTL_ZERO_BYTES, stream) != hipSuccess) return;
    Args a{};
    for (int i = 0; i < 26; ++i) a.in[i] = (const float*)d_in[i];
    a.out = (float*)d_out; a.ws = (unsigned char*)d_ws;
    for (int li = 0; li < MK_N_LAUNCHES; ++li) {
        a.ph_lo = (MK_N_LAUNCHES == 1) ? 0 : li; a.ph_hi = (MK_N_LAUNCHES == 1) ? N_PHASES : li + 1; a.li = li;
        hipLaunchKernelGGL(hybrid_fwd, dim3(grid), dim3(NWAVES * 64), LDS_BYTES, stream, a);
    }
}
```

```cpp
#include <hip/hip_runtime.h>
#include <hip/hip_bf16.h>
#include <cstdio>
#include <cstdint>

#ifndef MK_N_LAUNCHES
#define MK_N_LAUNCHES 1
#endif

constexpr int BATCH = 4, SEQ = 8192, T = BATCH * SEQ, D = 1024, FF = 2816, NGU = 2 * FF, NIN = 4096, AW = 512, SW = 512, NH = 8, HD = 64;
constexpr int NBLK = 32, MBLK = 256;
constexpr int SG = 32, SC = 16, SP = 64, SL = 32, NCH = SEQ / SL, KSSM = SC * SL + 2 * SP;
constexpr int NADA = 9 * D;
constexpr float EPS = 1e-6f;
constexpr float LOG2E = 1.4426950408889634f;
constexpr float QSCALE = 0.125f * LOG2E;
constexpr int N_PHASES = 13;

constexpr size_t MiB = 1u << 20;
constexpr size_t WS_CTL = 0, CTL_ZERO_BYTES = 1 * MiB;
constexpr size_t WS_ADA = 1 * MiB;
constexpr size_t WS_CS2 = WS_ADA + 147456;
constexpr size_t WS_CS3 = WS_CS2 + 16384;
constexpr size_t WS_BIAS2 = WS_CS3 + 16384;
constexpr size_t WS_BIAS3 = WS_BIAS2 + 65536;
constexpr size_t WS_KMEANP = 1 * MiB + 512 * 1024;
constexpr size_t WS_SEL = 2 * MiB;
constexpr size_t WS_LSE = 3 * MiB;
constexpr size_t WS_ROWSS = 6 * MiB;
constexpr size_t WS_WINT = 8 * MiB, WS_WGLU = 16 * MiB, WS_WBRA = 17 * MiB, WS_WBRS = 18 * MiB, WS_WOUT = 19 * MiB;
constexpr size_t WS_W1T = 21 * MiB, WS_W2T = 32 * MiB, WS_W3T = 37 * MiB + 512 * 1024, WS_W4T = 48 * MiB + 512 * 1024;
constexpr size_t WS_BM = 54 * MiB, WS_BS = 74 * MiB;
constexpr size_t WS_ARENA = 82 * MiB;
constexpr size_t WS_SGA = WS_ARENA, WS_SGS = WS_ARENA + 64 * MiB;
constexpr size_t WS_Q = WS_ARENA + 128 * MiB, WS_K = WS_ARENA + 160 * MiB, WS_V = WS_ARENA + 192 * MiB;
constexpr size_t WS_PART = WS_ARENA + 224 * MiB;
constexpr size_t WS_Y1 = WS_ARENA + 320 * MiB;
constexpr size_t WS_SSMA = WS_ARENA + 352 * MiB;
constexpr size_t WS_YSSM = WS_ARENA + 352 * MiB, WS_YATT = WS_ARENA + 384 * MiB;
constexpr size_t WS_X1S = WS_ARENA + 224 * MiB, WS_ACT = WS_ARENA, WS_MERGED = WS_ARENA + 128 * MiB, WS_X2S = WS_ARENA + 224 * MiB;
constexpr size_t WS_END = WS_ARENA + 416 * MiB;
static_assert(WS_BIAS3 + 90112 <= WS_KMEANP && WS_W4T + (size_t)D * FF * 2 <= WS_BM && WS_BM + (size_t)SG * 512 * KSSM * 2 <= WS_BS && WS_BS + (size_t)SG * 256 * 512 * 2 <= WS_ARENA, "ws map");
static_assert((size_t)SG * 1024 * KSSM * 2 <= 40 * MiB && (size_t)T * FF * 2 <= 176 * MiB, "ws map 2");
constexpr int CW_BAR = 4096;
constexpr int CW_QUEUE = 256;

constexpr int RING_OFF = 0, RING_BYTES = 131072;
constexpr int SILU_OFF = 131072;
constexpr int LDS_BYTES = 163840;
constexpr int MISC_OFF = LDS_BYTES - 256;

#define GAS __attribute__((address_space(1)))
#define LAS __attribute__((address_space(3)))
typedef unsigned short bf16;
typedef unsigned v4u __attribute__((ext_vector_type(4)));
typedef unsigned v2u __attribute__((ext_vector_type(2)));
typedef float f32x4 __attribute__((ext_vector_type(4)));
typedef float f32x2 __attribute__((ext_vector_type(2)));
typedef short bf16x8 __attribute__((ext_vector_type(8)));
typedef GAS unsigned gu32;
#define RLX_AGENT __ATOMIC_RELAXED, __HIP_MEMORY_SCOPE_AGENT
#define LDS_WAIT() asm volatile("s_waitcnt lgkmcnt(0)" ::: "memory")
#define VM_WAIT() asm volatile("s_waitcnt vmcnt(0)" ::: "memory")
constexpr int NWAVES = 8;

__device__ __forceinline__ unsigned f2bf(float f) { unsigned u = __builtin_bit_cast(unsigned, f); return (u + 0x7fffu + ((u >> 16) & 1u)) >> 16; }
__device__ __forceinline__ unsigned pk2(float lo, float hi) { return f2bf(lo) | (f2bf(hi) << 16); }
__device__ __forceinline__ float bf2f(unsigned short h) { return __builtin_bit_cast(float, (unsigned)h << 16); }
__device__ __forceinline__ float bflo(unsigned w) { return __builtin_bit_cast(float, w << 16); }
__device__ __forceinline__ float bfhi(unsigned w) { return __builtin_bit_cast(float, w & 0xffff0000u); }
__device__ __forceinline__ float fast_exp2(float x) { return __builtin_amdgcn_exp2f(x); }
__device__ __forceinline__ float fast_rcp(float x) { return __builtin_amdgcn_rcpf(x); }
__device__ __forceinline__ float sigmoidf_(float x) { return fast_rcp(1.0f + fast_exp2(-LOG2E * x)); }
__device__ __forceinline__ float siluf_(float x) { return x * sigmoidf_(x); }
__device__ __forceinline__ float gelu_tanh(float v) { const float u = 1.5957691216057308f * (v + 0.044715f * v * v * v); return v * fast_rcp(1.0f + fast_exp2(-LOG2E * u)); }
__device__ __forceinline__ float wave_sum(float v) {
#pragma unroll
    for (int o = 1; o < 64; o <<= 1) v += __shfl_xor(v, o);
    return v;
}
__device__ __forceinline__ float wave_max(float v) {
#pragma unroll
    for (int o = 1; o < 64; o <<= 1) v = fmaxf(v, __shfl_xor(v, o));
    return v;
}

namespace pg8 {
#define PG8_LAS __attribute__((address_space(3)))
typedef unsigned short bf16_t;
typedef short bf16x8 __attribute__((ext_vector_type(8)));
typedef float f32x4 __attribute__((ext_vector_type(4)));
typedef unsigned u32x4 __attribute__((ext_vector_type(4)));
constexpr int BM = 256, BK = 64, HALF = 128, HTB = HALF * BK * 2, STAGE_BYTES = 8 * HTB, NXCD = 8, WGM = 8;

__host__ __device__ __forceinline__ int lds_byte(int r, int c) { const int st = (r >> 4) * 2 + (c >> 5), rr = r & 15, cc = c & 31, ob = rr * 64 + cc * 2; return st * 1024 + (ob ^ (((ob >> 9) & 1) << 5)); }
__host__ __device__ __forceinline__ void stage_rc(int b, int& R, int& C) { const int st = b / 1024, sb = b % 1024, swz = sb ^ (((sb >> 9) & 1) << 5); R = (st >> 1) * 16 + swz / 64; C = (st & 1) * 32 + (swz % 64) / 2; }
__host__ __device__ __forceinline__ int perm32(int rho) { const int n = rho >> 4, i = rho & 15; return 8 * (i >> 2) + 4 * n + (i & 3); }

struct Unit { int pm, pn; };
struct Gemm { const bf16_t* A; const bf16_t* Bt; int lda, ldb, K; const bf16_t* A2; const bf16_t* Bt2; int K2; };

struct StaticOrder {
    int nM, nN, nwg, G, c;
    __host__ __device__ void init(int M, int N, int G_, int c_) { nM = M / BM; nN = N / BM; nwg = nM * nN; G = G_; c = c_; }
    __host__ __device__ bool next(int i, Unit& u) const {
        const long L = (long)i * G + c; if (L >= nwg) return false;
        int wgid = (int)L; { const int q = nwg / NXCD, r = nwg % NXCD, xcd = wgid % NXCD, off = wgid / NXCD; wgid = (xcd < r ? xcd * (q + 1) : r * (q + 1) + (xcd - r) * q) + off; }
        const int nig = WGM * nN, gid = wgid / nig, fm = gid * WGM, gsz = (nM - fm) < WGM ? (nM - fm) : WGM;
        u.pm = fm + ((wgid % nig) % gsz); u.pn = (wgid % nig) / gsz; return true;
    }
};
struct BlockDiagOrder {
    int RM, RN, n, G, c, first;
    __host__ __device__ void init(int ngroups, int RM_, int RN_, int G_, int c_, int first_ = 0) { RM = RM_; RN = RN_; n = ngroups * RM_ * RN_; G = G_; c = c_; first = first_; }
    __host__ __device__ bool next(int i, Unit& u) const {
        const int L = i * G + c; if (L >= n || (first && i > 0)) return false;
        const int g = L / (RM * RN), r = L % (RM * RN); u.pm = g * RM + r / RN; u.pn = g * RN + r % RN; return true;
    }
};

__device__ __forceinline__ unsigned cvt_pk_bf16(float lo, float hi) { unsigned r; asm volatile("v_cvt_pk_bf16_f32 %0, %1, %2" : "=v"(r) : "v"(lo), "v"(hi)); return r; }

template <class Epi, class Sched, bool ALIGN_EPI = false, bool SP2 = true>
__device__ __forceinline__ void gemm_phase(PG8_LAS unsigned char* lds, const Gemm g, const Sched S, const Epi E) {
    const int tid = threadIdx.x, wid = __builtin_amdgcn_readfirstlane(tid >> 6), lane = tid & 63, wr = wid >> 2, wc = wid & 3, fr = lane & 15, fq = lane >> 4;
    const int nt1 = g.K / BK, nt = (g.K + g.K2) / BK;
    unsigned voffA[2], voffB[2];
#pragma unroll
    for (int i = 0; i < 2; ++i) { int R, C; stage_rc(tid * 16 + i * 8192, R, C); const int Rb = Epi::PERM ? ((R & ~31) + perm32(R & 31)) : R;
        voffA[i] = (unsigned)(R * g.lda + C) * 2u; voffB[i] = (unsigned)(Rb * g.ldb + C) * 2u; }
    const size_t kstep = (size_t)(BK * 2);
    const size_t hstepA = (size_t)HALF * g.lda * 2, hstepB = (size_t)HALF * g.ldb * 2;
    const size_t tstepA = 2 * hstepA, tstepB = 2 * hstepB;
    const unsigned ldsw = (unsigned)wid * 1024u;
    const int aoff = lds_byte(wr * 64 + fr, fq * 8), boff = lds_byte(wc * 32 + fr, fq * 8);
#define PG8_SA(b, h) (((b) * 2 + (h)) * HTB)
#define PG8_SB(b, h) ((4 + (b) * 2 + (h)) * HTB)
#define PG8_STAGE(bufoff, gbase, voff) do { _Pragma("unroll") for (int _i = 0; _i < 2; ++_i) \
        __builtin_amdgcn_global_load_lds((const unsigned*)((const char*)(gbase) + (voff)[_i]), (PG8_LAS unsigned*)(lds + (bufoff) + ldsw + _i * 8192), 16, 0, 0); } while (0)
#define PG8_LDA(dst, b, h) do { _Pragma("unroll") for (int m = 0; m < 4; ++m) _Pragma("unroll") for (int k = 0; k < 2; ++k) dst[m][k] = *(const PG8_LAS bf16x8*)(lds + PG8_SA(b, h) + aoff + m * 2048 + k * 1024); } while (0)
#define PG8_LDB(dst, b, h) do { _Pragma("unroll") for (int n = 0; n < 2; ++n) _Pragma("unroll") for (int k = 0; k < 2; ++k) dst[n][k] = *(const PG8_LAS bf16x8*)(lds + PG8_SB(b, h) + boff + n * 2048 + k * 1024); } while (0)
#define PG8_MMA(ai, bj, At, Bt) do { __builtin_amdgcn_s_setprio(1); _Pragma("unroll") for (int m = 0; m < 4; ++m) _Pragma("unroll") for (int n = 0; n < 2; ++n) _Pragma("unroll") for (int k = 0; k < 2; ++k) \
        acc[ai][bj][m][n] = __builtin_amdgcn_mfma_f32_16x16x32_bf16(Bt[n][k], At[m][k], acc[ai][bj][m][n], 0, 0, 0); __builtin_amdgcn_s_setprio(0); } while (0)
#define PG8_WAIT_V(n) asm volatile("s_waitcnt vmcnt(" #n ")" ::: "memory")
#define PG8_WAIT_L(n) asm volatile("s_waitcnt lgkmcnt(" #n ")" ::: "memory")
#define PG8_BAR __builtin_amdgcn_s_barrier()
#define PG8_SCHED __builtin_amdgcn_sched_barrier(0)
    Unit cur, nxt; int ui = 0;
    if (!S.next(0, cur)) return;
    f32x4 acc[2][2][4][2];
#pragma unroll
    for (int a = 0; a < 2; ++a)
#pragma unroll
        for (int b = 0; b < 2; ++b)
#pragma unroll
            for (int m = 0; m < 4; ++m)
#pragma unroll
                for (int n = 0; n < 2; ++n) acc[a][b][m][n] = (f32x4){0.f, 0.f, 0.f, 0.f};
    bf16x8 At[4][2], B0[2][2], B1[2][2];
    const char* cA = (const char*)g.A + (size_t)cur.pm * tstepA; const char* cB = (const char*)g.Bt + (size_t)cur.pn * tstepB;
    const char* cA2 = (const char*)g.A2 + (size_t)cur.pm * tstepA; const char* cB2 = (const char*)g.Bt2 + (size_t)cur.pn * tstepB;
    {
        PG8_STAGE(PG8_SB(0, 0), cB, voffB); PG8_STAGE(PG8_SB(0, 1), cB + hstepB, voffB); PG8_STAGE(PG8_SA(0, 0), cA, voffA); PG8_STAGE(PG8_SA(0, 1), cA + hstepA, voffA);
        if (wr == 1) PG8_BAR;
        PG8_WAIT_V(2); PG8_BAR;
        PG8_STAGE(PG8_SB(1, 0), cB + kstep, voffB); PG8_STAGE(PG8_SA(1, 0), cA + kstep, voffA); PG8_STAGE(PG8_SB(1, 1), cB + hstepB + kstep, voffB);
        PG8_WAIT_V(6); PG8_BAR;
    }
    for (;;) {
        const bool has_next = S.next(ui + 1, nxt);
        const char* nA = has_next ? (const char*)g.A + (size_t)nxt.pm * tstepA : cA; const char* nB = has_next ? (const char*)g.Bt + (size_t)nxt.pn * tstepB : cB;
        for (int t = 0; t < nt; t += 2) {
            const bool last = (t == nt - 2);
            if constexpr (Epi::HAS_MID) { if (t == nt1) E.mid(acc, cur, wr, wc, fr, fq); }
            const char* a0 = (t < nt1) ? cA + (size_t)t * kstep : cA2 + (size_t)(t - nt1) * kstep;
            const char* a1 = a0 + kstep;
            const char* a2 = last ? nA : ((t + 2 < nt1) ? cA + (size_t)(t + 2) * kstep : cA2 + (size_t)(t + 2 - nt1) * kstep);
            const char* b2 = last ? nB : ((t + 2 < nt1) ? cB + (size_t)(t + 2) * kstep : cB2 + (size_t)(t + 2 - nt1) * kstep);
            const char* a3 = a2 + kstep; const char* b3 = b2 + kstep;
            PG8_LDB(B0, 0, 0); PG8_LDB(B1, 0, 1); PG8_SCHED; PG8_LDA(At, 0, 0); PG8_STAGE(PG8_SA(1, 1), a1 + hstepA, voffA);
            PG8_WAIT_V(8); PG8_WAIT_L(0); PG8_BAR; PG8_MMA(0, 0, At, B0); PG8_MMA(0, 1, At, B1); PG8_BAR; PG8_SCHED;
            PG8_LDA(At, 0, 1); PG8_STAGE(PG8_SB(0, 0), b2, voffB); PG8_STAGE(PG8_SB(0, 1), b2 + hstepB, voffB); PG8_STAGE(PG8_SA(0, 0), a2, voffA);
            PG8_WAIT_V(8); PG8_WAIT_L(0); PG8_BAR; PG8_MMA(1, 0, At, B0); PG8_MMA(1, 1, At, B1); PG8_BAR; PG8_SCHED;
            PG8_LDB(B0, 1, 0); PG8_LDB(B1, 1, 1); PG8_SCHED; PG8_LDA(At, 1, 0); PG8_STAGE(PG8_SA(0, 1), a2 + hstepA, voffA);
            PG8_WAIT_V(8); PG8_WAIT_L(0); PG8_BAR; PG8_MMA(0, 0, At, B0); PG8_MMA(0, 1, At, B1); PG8_BAR; PG8_SCHED;
            PG8_LDA(At, 1, 1); PG8_STAGE(PG8_SB(1, 0), b3, voffB); PG8_STAGE(PG8_SB(1, 1), b3 + hstepB, voffB); PG8_STAGE(PG8_SA(1, 0), a3, voffA);
            PG8_WAIT_V(8); PG8_WAIT_L(0); PG8_BAR; PG8_MMA(1, 0, At, B0); PG8_MMA(1, 1, At, B1); PG8_BAR; PG8_SCHED;
        }
        if constexpr (ALIGN_EPI) { if (wr == 0) PG8_BAR; }
        if constexpr (!Epi::AFTER_DRAIN) { E(acc, cur, wr, wc, fr, fq); }
        if (!has_next) break;
#pragma unroll
        for (int a = 0; a < 2; ++a)
#pragma unroll
            for (int b = 0; b < 2; ++b)
#pragma unroll
                for (int m = 0; m < 4; ++m)
#pragma unroll
                    for (int n = 0; n < 2; ++n) acc[a][b][m][n] = (f32x4){0.f, 0.f, 0.f, 0.f};
        cur = nxt; cA = nA; cB = nB; ++ui;
        cA2 = (const char*)g.A2 + (size_t)cur.pm * tstepA; cB2 = (const char*)g.Bt2 + (size_t)cur.pn * tstepB;
        if constexpr (ALIGN_EPI) { if (wr == 1) PG8_BAR; }
    }
    PG8_WAIT_V(0);
    if constexpr (!ALIGN_EPI) { if (wr == 0) PG8_BAR; }
    PG8_BAR;
    if constexpr (Epi::AFTER_DRAIN) { E.fused(acc, cur, wr, wc, fr, fq, lds, wid, lane); }
#undef PG8_SA
#undef PG8_SB
#undef PG8_STAGE
#undef PG8_LDA
#undef PG8_LDB
#undef PG8_MMA
#undef PG8_WAIT_V
#undef PG8_WAIT_L
#undef PG8_BAR
#undef PG8_SCHED
}

__device__ __forceinline__ float row_rnorm(const float* rowss, int row) {
    const f32x4* p = (const f32x4*)(rowss + (size_t)row * 16);
    const f32x4 a = p[0], b = p[1], c = p[2], d = p[3];
    const float s = ((a[0] + a[1]) + (a[2] + a[3])) + ((b[0] + b[1]) + (b[2] + b[3])) + ((c[0] + c[1]) + (c[2] + c[3])) + ((d[0] + d[1]) + (d[2] + d[3]));
    return __builtin_amdgcn_rsqf(s * (1.0f / 1024.0f) + EPS);
}

template <bool NORM> struct EpiSwiGLU {
    static constexpr bool PERM = true, AFTER_DRAIN = false, HAS_MID = false;
    bf16_t* O; const float* rowss; const float* bias;
    __device__ __forceinline__ void operator()(const f32x4 (&acc)[2][2][4][2], const Unit& u, int wr, int wc, int fr, int fq) const {
        const int row0 = u.pm * BM + wr * 64 + fr, b = u.pm >> 5;
        const int colB0 = u.pn * BM + wc * 32 + 8 * fq, ocol0 = u.pn * 128 + wc * 32 + 8 * fq;
        f32x4 bg[2], bu[2];
#pragma unroll
        for (int n = 0; n < 2; ++n) { bg[n] = NORM ? *(const f32x4*)(bias + (size_t)b * NGU + colB0 + 4 * n) : (f32x4){0.f, 0.f, 0.f, 0.f}; bu[n] = NORM ? *(const f32x4*)(bias + (size_t)b * NGU + colB0 + 128 + 4 * n) : (f32x4){0.f, 0.f, 0.f, 0.f}; }
#pragma unroll
        for (int ai = 0; ai < 2; ++ai)
#pragma unroll
            for (int m = 0; m < 4; ++m) {
                const int row = row0 + ai * HALF + m * 16;
                const float r = NORM ? row_rnorm(rowss, row) : 1.0f;
                float o[8];
#pragma unroll
                for (int n = 0; n < 2; ++n) {
                    f32x4 gv = acc[ai][0][m][n], uv = acc[ai][1][m][n];
                    if (NORM) { gv = gv * r + bg[n]; uv = uv * r + bu[n]; }
#pragma unroll
                    for (int j = 0; j < 4; ++j) o[4 * n + j] = siluf_(gv[j]) * uv[j];
                }
                u32x4 w; w.x = cvt_pk_bf16(o[0], o[1]); w.y = cvt_pk_bf16(o[2], o[3]); w.z = cvt_pk_bf16(o[4], o[5]); w.w = cvt_pk_bf16(o[6], o[7]);
                *(u32x4*)(O + (size_t)row * FF + ocol0) = w;
            }
    }
};

template <bool XS, int TAG> struct EpiResid {
    static constexpr bool PERM = false, AFTER_DRAIN = false, HAS_MID = false;
    const float* xin; float* xout; const float* gate; bf16_t* xs; const float* cs; float* rowss; float gscale;
    __device__ __forceinline__ void operator()(const f32x4 (&acc)[2][2][4][2], const Unit& u, int wr, int wc, int fr, int fq) const {
        const int row0 = u.pm * BM + wr * 64 + fr, b = u.pm >> 5, col0 = u.pn * BM + wc * 32 + 4 * fq;
        f32x4 gv[2][2], cv[2][2];
#pragma unroll
        for (int bj = 0; bj < 2; ++bj)
#pragma unroll
            for (int n = 0; n < 2; ++n) { const f32x4 g_ = *(const f32x4*)(gate + (size_t)b * NADA + col0 + bj * HALF + n * 16); const float gsc = gscale;
                gv[bj][n] = (f32x4){g_[0] * gsc, g_[1] * gsc, g_[2] * gsc, g_[3] * gsc};
                cv[bj][n] = XS ? *(const f32x4*)(cs + (size_t)b * D + col0 + bj * HALF + n * 16) : (f32x4){0.f, 0.f, 0.f, 0.f}; }
#pragma unroll
        for (int ai = 0; ai < 2; ++ai)
#pragma unroll
            for (int m = 0; m < 4; ++m) {
                const int row = row0 + ai * HALF + m * 16; const size_t off = (size_t)row * D + col0;
                float ss = 0.f;
#pragma unroll
                for (int bj = 0; bj < 2; ++bj)
#pragma unroll
                    for (int n = 0; n < 2; ++n) {
                        const f32x4 xv = *(const f32x4*)(xin + off + bj * HALF + n * 16);
                        const f32x4 v = xv + gv[bj][n] * acc[ai][bj][m][n];
                        *(f32x4*)(xout + off + bj * HALF + n * 16) = v;
                        ss += (v[0] * v[0] + v[1] * v[1]) + (v[2] * v[2] + v[3] * v[3]);
                        if (XS) { const f32x4 s = v * cv[bj][n]; v2u w; w.x = cvt_pk_bf16(s[0], s[1]); w.y = cvt_pk_bf16(s[2], s[3]); *(v2u*)(xs + off + bj * HALF + n * 16) = w; }
                    }
                ss += __shfl_xor(ss, 16); ss += __shfl_xor(ss, 32);
                if (fq == 0) rowss[(size_t)row * 16 + u.pn * 4 + wc] = ss;
            }
    }
};

struct EpiIn {
    static constexpr bool PERM = true, AFTER_DRAIN = false, HAS_MID = false;
    const float* rowss; const float* bias; bf16_t* q; bf16_t* k; bf16_t* v; bf16_t* ssmA; bf16_t* sga; bf16_t* sgs; float* kmeanp;
    __device__ __forceinline__ void operator()(const f32x4 (&acc)[2][2][4][2], const Unit& u, int wr, int wc, int fr, int fq) const {
        const int row0 = u.pm * BM + wr * 64 + fr, b = u.pm >> 5, nb = u.pm & 31;
        const int c0 = u.pn * BM + wc * 32 + 8 * fq;
        const int region = u.pn >> 1;
        f32x4 bv[2][2];
#pragma unroll
        for (int bj = 0; bj < 2; ++bj)
#pragma unroll
            for (int n = 0; n < 2; ++n) bv[bj][n] = *(const f32x4*)(bias + (size_t)b * NIN + c0 + bj * HALF + 4 * n);
        float cs[2][8];
#pragma unroll
        for (int bj = 0; bj < 2; ++bj)
#pragma unroll
            for (int j = 0; j < 8; ++j) cs[bj][j] = 0.f;
#pragma unroll
        for (int ai = 0; ai < 2; ++ai)
#pragma unroll
            for (int m = 0; m < 4; ++m) {
                const int row = row0 + ai * HALF + m * 16;
                const float r = row_rnorm(rowss, row);
#pragma unroll
                for (int bj = 0; bj < 2; ++bj) {
                    const f32x4 v0 = acc[ai][bj][m][0] * r + bv[bj][0], v1 = acc[ai][bj][m][1] * r + bv[bj][1];
                    float o[8] = {v0[0], v0[1], v0[2], v0[3], v1[0], v1[1], v1[2], v1[3]};
                    const int c = c0 + bj * HALF;
                    bf16_t* dst;
                    if (region == 0) {
#pragma unroll
                        for (int j = 0; j < 8; ++j) o[j] *= QSCALE;
                        dst = q + (size_t)row * AW + c;
                    } else if (region == 1) {
#pragma unroll
                        for (int j = 0; j < 8; ++j) cs[bj][j] += o[j];
                        dst = k + (size_t)row * AW + (c - 512);
                    } else if (region == 2) {
                        dst = v + (size_t)row * AW + (c - 1024);
                    } else if (region == 3) {
                        const int cc = c - 1536, gidx = cc >> 4, ch = cc & 15, t = row & (SEQ - 1);
                        dst = ssmA + ((size_t)(gidx * 1024 + b * NCH + (t >> 5)) * KSSM + (t & 31) * SC + ch);
                    } else if (region < 6) {
#pragma unroll
                        for (int j = 0; j < 8; ++j) o[j] = sigmoidf_(o[j]);
                        dst = sga + (size_t)row * D + (c - 2048);
                    } else {
#pragma unroll
                        for (int j = 0; j < 8; ++j) o[j] = fmaxf(sigmoidf_(o[j]), 1e-30f);
                        dst = sgs + (size_t)row * D + (c - 3072);
                    }
                    u32x4 w; w.x = cvt_pk_bf16(o[0], o[1]); w.y = cvt_pk_bf16(o[2], o[3]); w.z = cvt_pk_bf16(o[4], o[5]); w.w = cvt_pk_bf16(o[6], o[7]);
                    *(u32x4*)dst = w;
                }
            }
        if (region == 1) {
#pragma unroll
            for (int bj = 0; bj < 2; ++bj)
#pragma unroll
                for (int j = 0; j < 8; ++j) { float s = cs[bj][j]; s += __shfl_xor(s, 1); s += __shfl_xor(s, 2); s += __shfl_xor(s, 4); s += __shfl_xor(s, 8); cs[bj][j] = s; }
            if (fr == 0) {
#pragma unroll
                for (int bj = 0; bj < 2; ++bj) {
                    float* dstp = kmeanp + ((size_t)((b * NBLK + nb) * 2 + wr) * AW + (c0 + bj * HALF - 512));
                    *(f32x4*)dstp = (f32x4){cs[bj][0], cs[bj][1], cs[bj][2], cs[bj][3]}; *(f32x4*)(dstp + 4) = (f32x4){cs[bj][4], cs[bj][5], cs[bj][6], cs[bj][7]};
                }
            }
        }
    }
};

struct EpiGlu {
    static constexpr bool PERM = true, AFTER_DRAIN = false, HAS_MID = false;
    const bf16_t* y1; const float* bglu; bf16_t* yssm;
    __device__ __forceinline__ void operator()(const f32x4 (&acc)[2][2][4][2], const Unit& u, int wr, int wc, int fr, int fq) const {
        const int row0 = u.pm * BM + wr * 64 + fr, c0 = u.pn * BM + wc * 32 + 8 * fq;
        f32x4 bv[2][2];
#pragma unroll
        for (int bj = 0; bj < 2; ++bj)
#pragma unroll
            for (int n = 0; n < 2; ++n) bv[bj][n] = *(const f32x4*)(bglu + c0 + bj * HALF + 4 * n);
#pragma unroll
        for (int ai = 0; ai < 2; ++ai)
#pragma unroll
            for (int m = 0; m < 4; ++m) {
                const int row = row0 + ai * HALF + m * 16;
#pragma unroll
                for (int bj = 0; bj < 2; ++bj) {
                    const size_t off = (size_t)row * SW + c0 + bj * HALF;
                    const u32x4 yv = *(const u32x4*)(y1 + off);
                    const f32x4 z0 = acc[ai][bj][m][0] + bv[bj][0], z1 = acc[ai][bj][m][1] + bv[bj][1];
                    float o[8];
                    o[0] = bflo(yv.x) * sigmoidf_(z0[0]); o[1] = bfhi(yv.x) * sigmoidf_(z0[1]); o[2] = bflo(yv.y) * sigmoidf_(z0[2]); o[3] = bfhi(yv.y) * sigmoidf_(z0[3]);
                    o[4] = bflo(yv.z) * sigmoidf_(z1[0]); o[5] = bfhi(yv.z) * sigmoidf_(z1[1]); o[6] = bflo(yv.w) * sigmoidf_(z1[2]); o[7] = bfhi(yv.w) * sigmoidf_(z1[3]);
                    u32x4 w; w.x = cvt_pk_bf16(o[0], o[1]); w.y = cvt_pk_bf16(o[2], o[3]); w.z = cvt_pk_bf16(o[4], o[5]); w.w = cvt_pk_bf16(o[6], o[7]);
                    *(u32x4*)(yssm + off) = w;
                }
            }
    }
};

struct EpiMerge {
    static constexpr bool PERM = true, AFTER_DRAIN = false, HAS_MID = true;
    const bf16_t* sga; const bf16_t* sgs; bf16_t* merged;
    __device__ __forceinline__ void mid(f32x4 (&acc)[2][2][4][2], const Unit& u, int wr, int wc, int fr, int fq) const {
        int row0 = u.pm * BM + wr * 64 + fr, c0 = u.pn * BM + wc * 32 + 8 * fq;
        asm volatile("" : "+v"(row0), "+v"(c0));
#pragma unroll
        for (int ai = 0; ai < 2; ++ai)
#pragma unroll
            for (int m = 0; m < 4; ++m)
#pragma unroll
                for (int bj = 0; bj < 2; ++bj) {
                    const size_t off = (size_t)(row0 + ai * HALF + m * 16) * D + c0 + bj * HALF;
                    const u32x4 a = *(const u32x4*)(sga + off), s = *(const u32x4*)(sgs + off);
                    f32x4 r0, r1;
                    r0[0] = bflo(a.x) * fast_rcp(bflo(s.x)); r0[1] = bfhi(a.x) * fast_rcp(bfhi(s.x)); r0[2] = bflo(a.y) * fast_rcp(bflo(s.y)); r0[3] = bfhi(a.y) * fast_rcp(bfhi(s.y));
                    r1[0] = bflo(a.z) * fast_rcp(bflo(s.z)); r1[1] = bfhi(a.z) * fast_rcp(bfhi(s.z)); r1[2] = bflo(a.w) * fast_rcp(bflo(s.w)); r1[3] = bfhi(a.w) * fast_rcp(bfhi(s.w));
                    acc[ai][bj][m][0] *= r0; acc[ai][bj][m][1] *= r1;
                    if (bj == 1) asm volatile("" ::: "memory");
                }
    }
    __device__ __forceinline__ void operator()(const f32x4 (&acc)[2][2][4][2], const Unit& u, int wr, int wc, int fr, int fq) const {
        const int row0 = u.pm * BM + wr * 64 + fr, c0 = u.pn * BM + wc * 32 + 8 * fq;
#pragma unroll
        for (int ai = 0; ai < 2; ++ai)
#pragma unroll
            for (int m = 0; m < 4; ++m)
#pragma unroll
                for (int bj = 0; bj < 2; ++bj) {
                    const size_t off = (size_t)(row0 + ai * HALF + m * 16) * D + c0 + bj * HALF;
                    const u32x4 s = *(const u32x4*)(sgs + off);
                    const f32x4 v0 = acc[ai][bj][m][0], v1 = acc[ai][bj][m][1];
                    u32x4 w; w.x = cvt_pk_bf16(v0[0] * bflo(s.x), v0[1] * bfhi(s.x)); w.y = cvt_pk_bf16(v0[2] * bflo(s.y), v0[3] * bfhi(s.y));
                    w.z = cvt_pk_bf16(v1[0] * bflo(s.z), v1[1] * bfhi(s.z)); w.w = cvt_pk_bf16(v1[2] * bflo(s.w), v1[3] * bfhi(s.w));
                    *(u32x4*)(merged + off) = w;
                    if (bj == 1) asm volatile("" ::: "memory");
                }
    }
};

struct EpiSsmState {
    static constexpr bool PERM = false, AFTER_DRAIN = true, HAS_MID = false;
    bf16_t* ssmA; const float* lam_re; const float* lam_im; const float* log_dt;
    __device__ __forceinline__ void fused(f32x4 (&acc)[2][2][4][2], const Unit& u, int wr, int wc, int fr, int fq, PG8_LAS unsigned char* lds, int wid, int lane) const {
        PG8_LAS float* X = (PG8_LAS float*)lds;
        PG8_LAS float* Eb = (PG8_LAS float*)(lds + 135168);
#pragma unroll
        for (int ai = 0; ai < 2; ++ai)
#pragma unroll
            for (int m = 0; m < 4; ++m)
#pragma unroll
                for (int n = 0; n < 2; ++n) *(PG8_LAS f32x4*)(X + (ai * HALF + wr * 64 + m * 16 + fr) * 132 + wc * 32 + n * 16 + 4 * fq) = acc[ai][0][m][n];
        asm volatile("s_waitcnt lgkmcnt(0)" ::: "memory"); __builtin_amdgcn_s_barrier(); asm volatile("" ::: "memory");
        const int g = u.pn, p = lane, seg = wid;
        const float lr = lam_re[g * SP + p], li = lam_im[g * SP + p], dt = __expf(log_dt[g]);
        float ar, ai_; { float sn, cs; __sincosf(li * dt, &sn, &cs); const float mg = __expf(lr * dt); ar = mg * cs; ai_ = mg * sn; }
        float sr = ar, si = ai_;
#pragma unroll
        for (int q = 0; q < 5; ++q) { const float t0 = sr * sr - si * si, t1 = 2.f * sr * si; sr = t0; si = t1; }
        const float aLr = sr, aLi = si;
#pragma unroll
        for (int q = 0; q < 5; ++q) { const float t0 = sr * sr - si * si, t1 = 2.f * sr * si; sr = t0; si = t1; }
        const float aSr = sr, aSi = si;
        const PG8_LAS float* Xs = X + (seg * 32) * 132 + p;
        float er = 0.f, ei = 0.f;
#pragma unroll 8
        for (int r = 0; r < 32; ++r) { const float xr = Xs[r * 132], xi = Xs[r * 132 + 64]; const float nr = aLr * er - aLi * ei + xr, ni = aLr * ei + aLi * er + xi; er = nr; ei = ni; }
        Eb[(seg * 64 + p) * 2] = er; Eb[(seg * 64 + p) * 2 + 1] = ei;
        asm volatile("s_waitcnt lgkmcnt(0)" ::: "memory"); __builtin_amdgcn_s_barrier(); asm volatile("" ::: "memory");
        float cr = 0.f, ci = 0.f;
        for (int s2 = 0; s2 < seg; ++s2) { const float xr = Eb[(s2 * 64 + p) * 2], xi = Eb[(s2 * 64 + p) * 2 + 1]; const float nr = aSr * cr - aSi * ci + xr, ni = aSr * ci + aSi * cr + xi; cr = nr; ci = ni; }
        bf16_t* dst = ssmA + ((size_t)(u.pm * BM + seg * 32) * KSSM + 512 + p);
#pragma unroll 8
        for (int r = 0; r < 32; ++r) {
            dst[(size_t)r * KSSM] = (bf16_t)f2bf(cr); dst[(size_t)r * KSSM + 64] = (bf16_t)f2bf(ci);
            const float xr = Xs[r * 132], xi = Xs[r * 132 + 64]; const float nr = aLr * cr - aLi * ci + xr, ni = aLr * ci + aLi * cr + xi; cr = nr; ci = ni;
        }
        asm volatile("s_waitcnt lgkmcnt(0)" ::: "memory"); __builtin_amdgcn_s_barrier(); asm volatile("" ::: "memory");
    }
};

struct EpiSsmMain {
    static constexpr bool PERM = true, AFTER_DRAIN = false, HAS_MID = false;
    const bf16_t* ssmA; const float* dsk; bf16_t* y1;
    __device__ __forceinline__ void operator()(const f32x4 (&acc)[2][2][4][2], const Unit& u, int wr, int wc, int fr, int fq) const {
        const int g = u.pn >> 1, b = u.pm & 3, cbase = (u.pn & 1) * BM + wc * 32 + 8 * fq;
        const int rloc0 = wr * 64 + fr;
#pragma unroll
        for (int bj = 0; bj < 2; ++bj) {
            const int c = cbase + bj * HALF, s = c >> 4, ch0 = c & 15;
            const f32x4 d0 = *(const f32x4*)(dsk + g * SC + ch0), d1 = *(const f32x4*)(dsk + g * SC + ch0 + 4);
#pragma unroll
            for (int ai = 0; ai < 2; ++ai)
#pragma unroll
                for (int m = 0; m < 4; ++m) {
                    const int rloc = rloc0 + ai * HALF + m * 16;
                    const u32x4 uv = *(const u32x4*)(ssmA + (size_t)(u.pm * BM + rloc) * KSSM + c);
                    const f32x4 v0 = acc[ai][bj][m][0], v1 = acc[ai][bj][m][1];
                    float o[8];
                    o[0] = v0[0] + d0[0] * bflo(uv.x); o[1] = v0[1] + d0[1] * bfhi(uv.x); o[2] = v0[2] + d0[2] * bflo(uv.y); o[3] = v0[3] + d0[3] * bfhi(uv.y);
                    o[4] = v1[0] + d1[0] * bflo(uv.z); o[5] = v1[1] + d1[1] * bfhi(uv.z); o[6] = v1[2] + d1[2] * bflo(uv.w); o[7] = v1[3] + d1[3] * bfhi(uv.w);
#pragma unroll
                    for (int j = 0; j < 8; ++j) o[j] = gelu_tanh(o[j]);
                    u32x4 w; w.x = cvt_pk_bf16(o[0], o[1]); w.y = cvt_pk_bf16(o[2], o[3]); w.z = cvt_pk_bf16(o[4], o[5]); w.w = cvt_pk_bf16(o[6], o[7]);
                    *(u32x4*)(y1 + (size_t)(b * SEQ + rloc * SL + s) * SW + g * SC + ch0) = w;
                }
        }
    }
};
}


#define XB_TMO      128
#define XB_XCNT(j)  (256  + 64 * (j))
#define XB_XSUB(j)  (1280 + 64 * (j))
#define XB_XGEN(j)  (2304 + 64 * (j))
#define XB_TOP      3328
#define XB_TOPGEN   3392
#define XCD_BAR_WORDS 3456
#define XB_SPIN_CAP (1u << 20)

__device__ __forceinline__ unsigned xb_ld(unsigned* p)              { return __hip_atomic_load(p, __ATOMIC_RELAXED, __HIP_MEMORY_SCOPE_AGENT); }
__device__ __forceinline__ unsigned xb_add(unsigned* p, unsigned v) { return __hip_atomic_fetch_add(p, v, __ATOMIC_RELAXED, __HIP_MEMORY_SCOPE_AGENT); }
__device__ __forceinline__ unsigned xb_xcc_id() { return (unsigned)__builtin_amdgcn_s_getreg((3 << 11) | 20) & 0xFu; }
#define XB_SPIN(cond, bar) do { unsigned _sp = 0; while (cond) { __builtin_amdgcn_s_sleep(1); \
    if ((++_sp & 255u) == 0u) { if (xb_ld(&(bar)[XB_TMO])) break; if (_sp > XB_SPIN_CAP) { atomicAdd(&(bar)[XB_TMO], 1u); break; } } } } while (0)

struct XcdBarrier { unsigned* bar; unsigned x; volatile LAS unsigned* st; };
__device__ __forceinline__ XcdBarrier xcd_barrier_post(unsigned* bar, volatile LAS unsigned* st) {
    XcdBarrier b; b.bar = bar; b.x = xb_xcc_id(); b.st = st;
    if (threadIdx.x == 0) (void)xb_add(&bar[XB_XCNT(b.x)], 1u);
    return b;
}
__device__ __forceinline__ void xcd_barrier_complete(unsigned* bar, unsigned x, unsigned& nloc, unsigned& nx) {
    const unsigned G = gridDim.x * gridDim.y * gridDim.z;
    unsigned sum, cnt, mine, sp = 0u;
    for (;;) {
        sum = 0u; cnt = 0u; mine = 0u;
#pragma unroll
        for (unsigned j = 0; j < 16; ++j) { const unsigned c = xb_ld(&bar[XB_XCNT(j)]); sum += c; cnt += (c > 0u) ? 1u : 0u; mine = (j == x) ? c : mine; }
        if (sum == G) break;
        __builtin_amdgcn_s_sleep(1);
        if ((++sp & 255u) == 0u) { if (xb_ld(&bar[XB_TMO])) break; if (sp > XB_SPIN_CAP) { atomicAdd(&bar[XB_TMO], 1u); break; } }
    }
    nloc = mine > 0u ? mine : 1u; nx = cnt > 0u ? cnt : 1u;
}
__device__ __forceinline__ void xcd_barrier(const XcdBarrier& b) {
    asm volatile("s_waitcnt vmcnt(0)" ::: "memory");
    __syncthreads();
    if (threadIdx.x == 0) {
        unsigned* bar = b.bar;
        __builtin_amdgcn_s_waitcnt(0);
        unsigned nloc = b.st[0], nx = b.st[1];
        if (nloc == 0u) { xcd_barrier_complete(bar, b.x, nloc, nx); b.st[0] = nloc; b.st[1] = nx; }
        const unsigned old = xb_add(&bar[XB_XSUB(b.x)], 1u);
        const unsigned gen = old / nloc;
        if (old + 1u == (gen + 1u) * nloc) {
            __builtin_amdgcn_fence(__ATOMIC_RELEASE, "agent");
            asm volatile("s_waitcnt vmcnt(0)" ::: "memory");
            const unsigned og = xb_add(&bar[XB_TOP], 1u);
            const unsigned tg = og / nx;
            if (og + 1u == (tg + 1u) * nx) xb_add(&bar[XB_TOPGEN], 1u);
            else XB_SPIN(xb_ld(&bar[XB_TOPGEN]) == tg, bar);
            __builtin_amdgcn_fence(__ATOMIC_ACQUIRE, "agent");
            xb_add(&bar[XB_XGEN(b.x)], 1u);
            asm volatile("s_waitcnt vmcnt(0)" ::: "memory");
        } else {
            XB_SPIN(xb_ld(&bar[XB_XGEN(b.x)]) == gen, bar);
            __builtin_amdgcn_fence(__ATOMIC_ACQUIRE, "agent");
            asm volatile("s_waitcnt vmcnt(0)" ::: "memory");
        }
    }
    __syncthreads();
}

struct Frame {
    LAS unsigned char* lds;
    volatile LAS unsigned* MISC;
    gu32* ctl;
    int tid, lane, wave, vcu, G;
    unsigned char* ws;
    const float* in[26];
    float* out;
};
enum { IN_X = 0, IN_C, IN_WADA, IN_BADA, IN_NFFN1, IN_WFFN1IN, IN_WFFN1OUT, IN_NMIX, IN_WIN, IN_LAMRE, IN_LAMIM, IN_LOGDT, IN_BRE, IN_BIM, IN_CRE, IN_CIM, IN_SSMD,
       IN_WGLU, IN_BGLU, IN_WBRATT, IN_WBRSSM, IN_WOUT, IN_NFFN2, IN_WFFN2IN, IN_WFFN2OUT, IN_NFINAL };

__device__ __forceinline__ int gu_row(int n) { return n < FF ? ((n >> 7) << 8) + (n & 127) : (((n - FF) >> 7) << 8) + 128 + ((n - FF) & 127); }
__device__ __forceinline__ void p0_transpose_item(const float* W, int K, int N, bf16* WT, int mode, LAS float* scr, int item, int lane) {
    const int nblk = N / 32, kb = item / nblk, nb = item % nblk, k0 = 64 * kb, n0 = 32 * nb;
    const int r0 = mode ? gu_row(n0) : n0;
#pragma unroll 8
    for (int i = 0; i < 32; ++i) { const int kk = 2 * i + (lane >> 5); scr[kk * 33 + (lane & 31)] = W[(size_t)(k0 + kk) * N + n0 + (lane & 31)]; }
    LDS_WAIT(); asm volatile("" ::: "memory");
    const int c = lane & 7;
#pragma unroll
    for (int j = 0; j < 4; ++j) { const int n = (lane >> 3) + 8 * j; const LAS float* s = scr + (8 * c) * 33 + n;
        v4u o; o.x = pk2(s[0 * 33], s[1 * 33]); o.y = pk2(s[2 * 33], s[3 * 33]); o.z = pk2(s[4 * 33], s[5 * 33]); o.w = pk2(s[6 * 33], s[7 * 33]);
        *(GAS v4u*)(WT + (size_t)(r0 + n) * K + k0 + 8 * c) = o; }
    LDS_WAIT(); asm volatile("" ::: "memory");
}

__device__ __forceinline__ void ssm_lane_params(const Frame& F, int g, int p, float& lr_dt, float& li_dt, float& fr, float& fi) {
    const float lr = F.in[IN_LAMRE][g * SP + p], li = F.in[IN_LAMIM][g * SP + p], dt = __expf(F.in[IN_LOGDT][g]);
    lr_dt = lr * dt; li_dt = li * dt;
    float sn, cs; __sincosf(li_dt, &sn, &cs); const float mg = __expf(lr_dt);
    const float nr = mg * cs - 1.0f, ni = mg * sn, den = lr * lr + li * li;
    fr = (nr * lr + ni * li) / den; fi = (ni * lr - nr * li) / den;
}
__device__ __forceinline__ void cpow(float lr_dt, float li_dt, float n, float& pr, float& pi) { float sn, cs; __sincosf(li_dt * n, &sn, &cs); const float mg = __expf(lr_dt * n); pr = mg * cs; pi = mg * sn; }

__device__ __forceinline__ void p0_ssm_kmat_item(const Frame& F, int item, LAS float* scr) {
    const int g = item / 63, lag = item % 63 - 31, lane = F.lane;
    bf16* Bm = (bf16*)(F.ws + WS_BM) + (size_t)g * 512 * KSSM;
    const int co = lane >> 2, ci0 = (lane & 3) * 4;
    float k0 = 0.f, k1 = 0.f, k2 = 0.f, k3 = 0.f;
    if (lag >= 0) {
        LAS float* Dre = scr; LAS float* Dim = scr + 1024; LAS float* Cre = scr + 2048; LAS float* Cim = scr + 3072;
        float lr_dt, li_dt, fr, fi; ssm_lane_params(F, g, lane, lr_dt, li_dt, fr, fi);
        float pr, pi; cpow(lr_dt, li_dt, (float)lag, pr, pi);
#pragma unroll
        for (int c = 0; c < 16; c += 4) {
            f32x4 dr, di, cr4, ci4;
#pragma unroll
            for (int e = 0; e < 4; ++e) {
                const float br = F.in[IN_BRE][(g * SP + lane) * SC + c + e], bi = F.in[IN_BIM][(g * SP + lane) * SC + c + e];
                const float bbr = fr * br - fi * bi, bbi = fr * bi + fi * br;
                dr[e] = pr * bbr - pi * bbi; di[e] = pr * bbi + pi * bbr;
                cr4[e] = F.in[IN_CRE][(g * SC + c + e) * SP + lane]; ci4[e] = F.in[IN_CIM][(g * SC + c + e) * SP + lane];
            }
            *(LAS f32x4*)(Dre + lane * 16 + c) = dr; *(LAS f32x4*)(Dim + lane * 16 + c) = di; *(LAS f32x4*)(Cre + lane * 16 + c) = cr4; *(LAS f32x4*)(Cim + lane * 16 + c) = ci4;
        }
        LDS_WAIT(); asm volatile("" ::: "memory");
#pragma unroll 4
        for (int p = 0; p < 64; ++p) {
            const float cr = Cre[p * 16 + co], cim = Cim[p * 16 + co];
            const f32x4 dr = *(const LAS f32x4*)(Dre + p * 16 + ci0), di = *(const LAS f32x4*)(Dim + p * 16 + ci0);
            k0 += cr * dr[0] - cim * di[0]; k1 += cr * dr[1] - cim * di[1]; k2 += cr * dr[2] - cim * di[2]; k3 += cr * dr[3] - cim * di[3];
        }
        LDS_WAIT(); asm volatile("" ::: "memory");
    }
    const unsigned long long w = (unsigned long long)pk2(k0, k1) | ((unsigned long long)pk2(k2, k3) << 32);
    const int alag = lag < 0 ? -lag : lag;
    for (int i = 0; i < 32 - alag; ++i) { const int sI = lag >= 0 ? i + lag : i, tI = lag >= 0 ? i : i + alag;
        *(GAS unsigned long long*)(Bm + (size_t)(sI * 16 + co) * KSSM + tI * 16 + ci0) = w; }
}
__device__ __forceinline__ void p0_ssm_vs_item(const Frame& F, int item) {
    const int g = item >> 5, s = item & 31, p = F.lane;
    float lr_dt, li_dt, fr, fi; ssm_lane_params(F, g, p, lr_dt, li_dt, fr, fi);
    {
        float pr, pi; cpow(lr_dt, li_dt, (float)(s + 1), pr, pi);
        bf16* Bm = (bf16*)(F.ws + WS_BM) + (size_t)g * 512 * KSSM;
#pragma unroll
        for (int co = 0; co < 16; ++co) {
            const float cr = F.in[IN_CRE][(g * SC + co) * SP + p], ci = F.in[IN_CIM][(g * SC + co) * SP + p];
            bf16* row = Bm + (size_t)(s * 16 + co) * KSSM + 512;
            row[p] = (bf16)f2bf(cr * pr - ci * pi); row[64 + p] = (bf16)f2bf(-(cr * pi + ci * pr));
        }
    }
    {
        float pr, pi; cpow(lr_dt, li_dt, (float)(31 - s), pr, pi);
        bf16* Bs = (bf16*)(F.ws + WS_BS) + (size_t)g * 256 * 512;
        unsigned wr_[8], wi_[8];
#pragma unroll
        for (int c = 0; c < 16; c += 2) {
            float vr[2], vi[2];
#pragma unroll
            for (int e = 0; e < 2; ++e) { const float br = F.in[IN_BRE][(g * SP + p) * SC + c + e], bi = F.in[IN_BIM][(g * SP + p) * SC + c + e];
                const float bbr = fr * br - fi * bi, bbi = fr * bi + fi * br; vr[e] = pr * bbr - pi * bbi; vi[e] = pr * bbi + pi * bbr; }
            wr_[c >> 1] = pk2(vr[0], vr[1]); wi_[c >> 1] = pk2(vi[0], vi[1]);
        }
        GAS v4u* d0 = (GAS v4u*)(Bs + (size_t)p * 512 + s * 16); GAS v4u* d1 = (GAS v4u*)(Bs + (size_t)(64 + p) * 512 + s * 16);
        GAS v4u* z0 = (GAS v4u*)(Bs + (size_t)(128 + p) * 512 + s * 16); GAS v4u* z1 = (GAS v4u*)(Bs + (size_t)(192 + p) * 512 + s * 16);
        d0[0] = (v4u){wr_[0], wr_[1], wr_[2], wr_[3]}; d0[1] = (v4u){wr_[4], wr_[5], wr_[6], wr_[7]};
        d1[0] = (v4u){wi_[0], wi_[1], wi_[2], wi_[3]}; d1[1] = (v4u){wi_[4], wi_[5], wi_[6], wi_[7]};
        z0[0] = (v4u){0u, 0u, 0u, 0u}; z0[1] = (v4u){0u, 0u, 0u, 0u}; z1[0] = (v4u){0u, 0u, 0u, 0u}; z1[1] = (v4u){0u, 0u, 0u, 0u};
    }
}

__device__ __forceinline__ void p0_prologue(Frame& F) {
    LAS float* sl = (LAS float*)(F.lds + SILU_OFF);
    for (int i = F.tid; i < BATCH * D; i += NWAVES * 64) sl[i] = siluf_(F.in[IN_C][i]);
    __syncthreads();
    LAS float* scr = (LAS float*)(F.lds + RING_OFF + F.wave * 16384);
    const int gw = F.vcu * NWAVES + F.wave, NGW = F.G * NWAVES;
    bf16* ws16 = (bf16*)F.ws;
    constexpr int I_ADA = NADA / 64;
    constexpr int I_UP = (D / 64) * (NGU / 32), I_DN = (FF / 64) * (D / 32), I_IN = (D / 64) * (NIN / 32), I_GLU = (SW / 64) * (SW / 32), I_BR = (AW / 64) * (D / 32), I_OUT = (D / 64) * (D / 32);
    constexpr int I_KM = SG * 63, I_VS = SG * 32;
    constexpr int NITEMS = I_ADA + I_KM + I_VS + 2 * I_UP + 2 * I_DN + I_IN + I_GLU + 2 * I_BR + I_OUT;
    for (int it = gw; it < NITEMS; it += NGW) {
        int r = it;
        if (r < I_ADA) {
            const int n = r * 64 + F.lane; const float* W = F.in[IN_WADA] + n;
            float a0 = 0.f, a1 = 0.f, a2 = 0.f, a3 = 0.f;
#pragma unroll 2
            for (int k = 0; k < D; k += 4) {
                const f32x4 s0 = *(const LAS f32x4*)(sl + k), s1 = *(const LAS f32x4*)(sl + D + k), s2 = *(const LAS f32x4*)(sl + 2 * D + k), s3 = *(const LAS f32x4*)(sl + 3 * D + k);
#pragma unroll
                for (int i = 0; i < 4; ++i) { const float w = W[(size_t)(k + i) * NADA]; a0 += s0[i] * w; a1 += s1[i] * w; a2 += s2[i] * w; a3 += s3[i] * w; }
            }
            float* ada = (float*)(F.ws + WS_ADA); const float bb = F.in[IN_BADA][n];
            ada[n] = a0 + bb; ada[NADA + n] = a1 + bb; ada[2 * NADA + n] = a2 + bb; ada[3 * NADA + n] = a3 + bb;
            continue;
        }
        r -= I_ADA;
        if (r < I_KM) { p0_ssm_kmat_item(F, r, scr); continue; } r -= I_KM;
        if (r < I_VS) { p0_ssm_vs_item(F, r); continue; } r -= I_VS;
        if (r < I_UP) { p0_transpose_item(F.in[IN_WFFN1IN], D, NGU, ws16 + WS_W1T / 2, 1, scr, r, F.lane); continue; } r -= I_UP;
        if (r < I_UP) { p0_transpose_item(F.in[IN_WFFN2IN], D, NGU, ws16 + WS_W3T / 2, 1, scr, r, F.lane); continue; } r -= I_UP;
        if (r < I_DN) { p0_transpose_item(F.in[IN_WFFN1OUT], FF, D, ws16 + WS_W2T / 2, 0, scr, r, F.lane); continue; } r -= I_DN;
        if (r < I_DN) { p0_transpose_item(F.in[IN_WFFN2OUT], FF, D, ws16 + WS_W4T / 2, 0, scr, r, F.lane); continue; } r -= I_DN;
        if (r < I_IN) { p0_transpose_item(F.in[IN_WIN], D, NIN, ws16 + WS_WINT / 2, 0, scr, r, F.lane); continue; } r -= I_IN;
        if (r < I_GLU) { p0_transpose_item(F.in[IN_WGLU], SW, SW, ws16 + WS_WGLU / 2, 0, scr, r, F.lane); continue; } r -= I_GLU;
        if (r < I_BR) { p0_transpose_item(F.in[IN_WBRATT], AW, D, ws16 + WS_WBRA / 2, 0, scr, r, F.lane); continue; } r -= I_BR;
        if (r < I_BR) { p0_transpose_item(F.in[IN_WBRSSM], SW, D, ws16 + WS_WBRS / 2, 0, scr, r, F.lane); continue; } r -= I_BR;
        p0_transpose_item(F.in[IN_WOUT], D, D, ws16 + WS_WOUT / 2, 0, scr, r, F.lane);
    }
}

__device__ __forceinline__ void p1_phase(Frame& F) {
    const int gw = F.vcu * NWAVES + F.wave, NGW = F.G * NWAVES;
    const float* ada = (const float*)(F.ws + WS_ADA);
    for (int i = gw * 64 + F.lane; i < 2 * BATCH * D; i += NGW * 64) {
        const int which = i / (BATCH * D), r = i % (BATCH * D), b = r / D, c = r % D;
        const float gwt = which ? F.in[IN_NFFN2][c] : F.in[IN_NMIX][c];
        const float sc = ada[b * NADA + (which ? 7 : 4) * D + c];
        ((float*)(F.ws + (which ? WS_CS3 : WS_CS2)))[r] = gwt * (1.0f + sc);
    }
    for (int it = gw; it < NIN + NGU; it += NGW) {
        const bool second = it >= NIN; const int n = second ? it - NIN : it;
        const bf16* wrow = (const bf16*)(F.ws + (second ? WS_W3T : WS_WINT)) + (size_t)n * D;
        const float* sh = ada + (second ? 6 : 3) * D;
        float a[4] = {0.f, 0.f, 0.f, 0.f};
#pragma unroll
        for (int j = 0; j < 2; ++j) {
            const int k = 8 * F.lane + 512 * j;
            const v4u w = *(const GAS v4u*)(wrow + k);
            const float wf[8] = {bflo(w.x), bfhi(w.x), bflo(w.y), bfhi(w.y), bflo(w.z), bfhi(w.z), bflo(w.w), bfhi(w.w)};
#pragma unroll
            for (int b = 0; b < 4; ++b) { const f32x4 s0 = *(const f32x4*)(sh + b * NADA + k), s1 = *(const f32x4*)(sh + b * NADA + k + 4);
                a[b] += wf[0] * s0[0] + wf[1] * s0[1] + wf[2] * s0[2] + wf[3] * s0[3] + wf[4] * s1[0] + wf[5] * s1[1] + wf[6] * s1[2] + wf[7] * s1[3]; }
        }
#pragma unroll
        for (int b = 0; b < 4; ++b) a[b] = wave_sum(a[b]);
        if (F.lane == 0) { float* dst = (float*)(F.ws + (second ? WS_BIAS3 : WS_BIAS2)); const int N = second ? NGU : NIN;
#pragma unroll
            for (int b = 0; b < 4; ++b) dst[b * N + n] = a[b]; }
    }
    bf16* h1 = (bf16*)F.out;
    for (int m = gw; m < T; m += NGW) {
        const int b = m / SEQ;
        const GAS f32x4* xr = (const GAS f32x4*)(F.in[IN_X] + (size_t)m * D) + F.lane;
        f32x4 v[4]; float s = 0.f;
#pragma unroll
        for (int j = 0; j < 4; ++j) { v[j] = xr[64 * j]; s += (v[j].x * v[j].x + v[j].y * v[j].y) + (v[j].z * v[j].z + v[j].w * v[j].w); }
        const float rstd = __builtin_amdgcn_rsqf(wave_sum(s) * (1.f / D) + EPS);
        GAS unsigned long long* o8 = (GAS unsigned long long*)(h1 + (size_t)m * D) + F.lane;
#pragma unroll
        for (int j = 0; j < 4; ++j) {
            const int c = 4 * F.lane + 256 * j;
            const f32x4 g = *(const f32x4*)(F.in[IN_NFFN1] + c), sh = *(const f32x4*)(ada + b * NADA + c), sc = *(const f32x4*)(ada + b * NADA + D + c);
            const f32x4 h = v[j] * rstd * g * (sc + 1.0f) + sh;
            o8[64 * j] = (unsigned long long)pk2(h.x, h.y) | ((unsigned long long)pk2(h.z, h.w) << 32);
        }
    }
}

__device__ __forceinline__ void final_norm_phase(Frame& F) {
    const int gw = F.vcu * NWAVES + F.wave, NGW = F.G * NWAVES;
    const float* rowss = (const float*)(F.ws + WS_ROWSS);
    for (int m = gw; m < T; m += NGW) {
        const float r = pg8::row_rnorm(rowss, m);
        GAS f32x4* xr = (GAS f32x4*)(F.out + (size_t)m * D) + F.lane;
#pragma unroll
        for (int j = 0; j < 4; ++j) { const f32x4 g = *(const f32x4*)(F.in[IN_NFINAL] + 4 * F.lane + 256 * j); xr[64 * j] = xr[64 * j] * r * g; }
    }
}

__device__ __forceinline__ void gating_phase(Frame& F) {
    LAS float* km = (LAS float*)(F.lds + RING_OFF);
    const float* kmeanp = (const float*)(F.ws + WS_KMEANP);
    const bf16* q = (const bf16*)(F.ws + WS_Q);
    unsigned* sel = (unsigned*)(F.ws + WS_SEL);
    constexpr int NITEM = BATCH * NH * NBLK;
    for (int it = F.vcu; it < NITEM; it += F.G) {
        const int i = it & 31, h = (it >> 5) & 7, b = it >> 8;
        __syncthreads();
        for (int e = F.tid; e < i * 64; e += NWAVES * 64) { const int n = e >> 6, d = e & 63;
            km[e] = (kmeanp[(size_t)((b * NBLK + n) * 2 + 0) * AW + h * HD + d] + kmeanp[(size_t)((b * NBLK + n) * 2 + 1) * AW + h * HD + d]) * (1.0f / 256.0f); }
        __syncthreads();
        const int ql = F.lane & 31, half = F.lane >> 5, t = i * MBLK + F.wave * 32 + ql;
        const bf16* qrow = q + (size_t)(b * SEQ + t) * AW + h * HD;
        float qf[64];
#pragma unroll
        for (int c = 0; c < 8; ++c) { const v4u w = *(const GAS v4u*)(qrow + 8 * c);
            qf[8 * c + 0] = bflo(w.x); qf[8 * c + 1] = bfhi(w.x); qf[8 * c + 2] = bflo(w.y); qf[8 * c + 3] = bfhi(w.y); qf[8 * c + 4] = bflo(w.z); qf[8 * c + 5] = bfhi(w.z); qf[8 * c + 6] = bflo(w.w); qf[8 * c + 7] = bfhi(w.w); }
        float v0 = -3e38f, v1 = -3e38f, v2 = -3e38f; int i0 = 255, i1 = 255, i2 = 255;
        for (int n = half; n < i; n += 2) {
            const LAS f32x4* kr = (const LAS f32x4*)(km + n * 64);
            float dot = 0.f;
#pragma unroll
            for (int c = 0; c < 16; ++c) { const f32x4 kv = kr[c]; dot += qf[4 * c] * kv[0] + qf[4 * c + 1] * kv[1] + qf[4 * c + 2] * kv[2] + qf[4 * c + 3] * kv[3]; }
            if (dot > v0) { v2 = v1; i2 = i1; v1 = v0; i1 = i0; v0 = dot; i0 = n; }
            else if (dot > v1) { v2 = v1; i2 = i1; v1 = dot; i1 = n; }
            else if (dot > v2) { v2 = dot; i2 = n; }
        }
        const float ov[3] = {__shfl_xor(v0, 32), __shfl_xor(v1, 32), __shfl_xor(v2, 32)};
        const int oi[3] = {__shfl_xor(i0, 32), __shfl_xor(i1, 32), __shfl_xor(i2, 32)};
#pragma unroll
        for (int k = 0; k < 3; ++k) {
            const float d = ov[k]; const int n = oi[k];
            if (d > v0 || (d == v0 && n < i0)) { v2 = v1; i2 = i1; v1 = v0; i1 = i0; v0 = d; i0 = n; }
            else if (d > v1 || (d == v1 && n < i1)) { v2 = v1; i2 = i1; v1 = d; i1 = n; }
            else if (d > v2 || (d == v2 && n < i2)) { v2 = d; i2 = n; }
        }
        if (half == 0) sel[(size_t)(b * NH + h) * SEQ + t] = (unsigned)i0 | ((unsigned)i1 << 8) | ((unsigned)i2 << 16);
    }
}

namespace att {
typedef float f32x16 __attribute__((ext_vector_type(16)));
typedef short s16x4 __attribute__((ext_vector_type(4)));
typedef short v4i16_t __attribute__((ext_vector_type(4)));
typedef __bf16 bf16x2_t __attribute__((ext_vector_type(2)));
constexpr int ATT_K = 0, ATT_V = 32768, ATT_LIST = 65536, ATT_WS = 81920, ATT_OST = 83968, ATT_CNT = 116736;
__device__ __forceinline__ int crow(int r, int hi) { return (r & 3) + 8 * (r >> 2) + 4 * hi; }
__device__ __forceinline__ unsigned cvtpk(float lo, float hi) { f32x2 v = {lo, hi}; bf16x2_t b = __builtin_convertvector(v, bf16x2_t); return __builtin_bit_cast(unsigned, b); }
__device__ __forceinline__ s16x4 vtr(const LAS unsigned char* p) { return __builtin_bit_cast(s16x4, __builtin_amdgcn_ds_read_tr16_b64_v4i16((LAS v4i16_t*)p)); }
__device__ __forceinline__ float swapmax(float m) { auto rr = __builtin_amdgcn_permlane32_swap(__float_as_uint(m), __float_as_uint(m), false, false); return fmaxf(__uint_as_float(rr[0]), __uint_as_float(rr[1])); }
__device__ __forceinline__ float swapsum(float m) { auto rr = __builtin_amdgcn_permlane32_swap(__float_as_uint(m), __float_as_uint(m), false, false); return __uint_as_float(rr[0]) + __uint_as_float(rr[1]); }

__device__ __forceinline__ void load_kv(Frame& F, int b, int h, int j) {
    const bf16* K = (const bf16*)(F.ws + WS_K); const bf16* V = (const bf16*)(F.ws + WS_V);
    const size_t row0 = (size_t)(b * SEQ + j * MBLK);
#pragma unroll
    for (int kt = 0; kt < 4; ++kt) {
        const bf16* ksrc = K + (row0 + kt * 64 + F.lane) * AW + h * HD + F.wave * 8;
        __builtin_amdgcn_global_load_lds((const unsigned*)ksrc, (LAS unsigned*)(F.lds + ATT_K + kt * 8192 + F.wave * 1024), 16, 0, 0);
        const bf16* vsrc = V + (row0 + kt * 64 + 16 * (F.wave & 3) + (F.lane >> 2)) * AW + h * HD + (F.wave >> 2) * 32 + (F.lane & 3) * 8;
        __builtin_amdgcn_global_load_lds((const unsigned*)vsrc, (LAS unsigned*)(F.lds + ATT_V + kt * 8192 + F.wave * 1024), 16, 0, 0);
    }
}

template <bool CAUSAL>
__device__ __forceinline__ void attn_tile(Frame& F, const bf16* qrow, int reli, float slope2, int nkt, f32x16 (&o)[2], float& m_out, float& l_out) {
    const int lane = F.lane, r32 = lane & 31, hi = lane >> 5;
    bf16x8 qr[4];
#pragma unroll
    for (int d0 = 0; d0 < 4; ++d0) qr[d0] = *(const GAS bf16x8*)(qrow + d0 * 16 + hi * 8);
    LAS float* wsf = (LAS float*)(F.lds + ATT_WS + F.wave * 256);
    float m = -1e30f, l = 0.f;
#pragma unroll
    for (int r = 0; r < 16; ++r) { o[0][r] = 0.f; o[1][r] = 0.f; }
    const float base0 = slope2 * (float)(4 * hi - reli);
    for (int kt = 0; kt < nkt; ++kt) {
        const LAS unsigned char* Ks = F.lds + ATT_K + kt * 8192 + hi * 1024 + r32 * 16;
        f32x16 p0, p1;
        const float bkt = base0 + slope2 * (float)(64 * kt);
#pragma unroll
        for (int r = 0; r < 16; ++r) { p0[r] = bkt + slope2 * (float)((r & 3) + 8 * (r >> 2)); p1[r] = p0[r] + slope2 * 32.0f; }
#pragma unroll
        for (int d0 = 0; d0 < 4; ++d0) {
            const bf16x8 a0 = *(const LAS bf16x8*)(Ks + d0 * 2048), a1 = *(const LAS bf16x8*)(Ks + d0 * 2048 + 512);
            p0 = __builtin_amdgcn_mfma_f32_32x32x16_bf16(a0, qr[d0], p0, 0, 0, 0);
            p1 = __builtin_amdgcn_mfma_f32_32x32x16_bf16(a1, qr[d0], p1, 0, 0, 0);
        }
        if (CAUSAL) {
#pragma unroll
            for (int r = 0; r < 16; ++r) { const int kp = 64 * kt + crow(r, hi); if (kp > reli) p0[r] = -1e30f; if (kp + 32 > reli) p1[r] = -1e30f; }
        }
        float mt = fmaxf(p0[0], p1[0]);
#pragma unroll
        for (int r = 1; r < 16; ++r) mt = fmaxf(mt, fmaxf(p0[r], p1[r]));
        mt = swapmax(mt);
        const float mnew = fmaxf(m, mt), alpha = fast_exp2(m - mnew); m = mnew;
        float rs = 0.f;
#pragma unroll
        for (int r = 0; r < 16; ++r) { p0[r] = fast_exp2(p0[r] - mnew); p1[r] = fast_exp2(p1[r] - mnew); rs += p0[r] + p1[r]; }
        l = l * alpha + rs;
        if (hi == 0) wsf[r32] = alpha;
        asm volatile("s_waitcnt lgkmcnt(0)" ::: "memory");
#pragma unroll
        for (int r = 0; r < 16; ++r) { const float a = wsf[crow(r, hi)]; o[0][r] *= a; o[1][r] *= a; }
        asm volatile("" ::: "memory");
        v4u pw0, pw1, pw2, pw3;
        pw0.x = cvtpk(p0[0], p0[1]); pw0.y = cvtpk(p0[2], p0[3]); pw0.z = cvtpk(p0[4], p0[5]); pw0.w = cvtpk(p0[6], p0[7]);
        pw1.x = cvtpk(p0[8], p0[9]); pw1.y = cvtpk(p0[10], p0[11]); pw1.z = cvtpk(p0[12], p0[13]); pw1.w = cvtpk(p0[14], p0[15]);
        pw2.x = cvtpk(p1[0], p1[1]); pw2.y = cvtpk(p1[2], p1[3]); pw2.z = cvtpk(p1[4], p1[5]); pw2.w = cvtpk(p1[6], p1[7]);
        pw3.x = cvtpk(p1[8], p1[9]); pw3.y = cvtpk(p1[10], p1[11]); pw3.z = cvtpk(p1[12], p1[13]); pw3.w = cvtpk(p1[14], p1[15]);
        const LAS unsigned char* vp = F.lds + ATT_V + kt * 8192 + ((lane >> 4) & 1) * 32 + (lane & 3) * 8 + (4 * hi + ((lane & 15) >> 2)) * 64;
#pragma unroll
        for (int d0 = 0; d0 < 2; ++d0) {
#define ATT_PV(ks, pw) { const s16x4 lo = vtr(vp + d0 * 4096 + (ks) * 1024), hh = vtr(vp + d0 * 4096 + (ks) * 1024 + 512); \
            const bf16x8 vf = (bf16x8){lo[0], lo[1], lo[2], lo[3], hh[0], hh[1], hh[2], hh[3]}; \
            o[d0] = __builtin_amdgcn_mfma_f32_32x32x16_bf16(__builtin_bit_cast(bf16x8, pw), vf, o[d0], 0, 0, 0); }
            ATT_PV(0, pw0) ATT_PV(1, pw1) ATT_PV(2, pw2) ATT_PV(3, pw3)
#undef ATT_PV
        }
    }
    m_out = m; l_out = swapsum(l);
}

__device__ __forceinline__ void stage_o(Frame& F, const f32x16 (&o)[2], float l) {
    const int lane = F.lane, r32 = lane & 31, hi = lane >> 5;
    LAS float* wsf = (LAS float*)(F.lds + ATT_WS + F.wave * 256);
    LAS bf16* stg = (LAS bf16*)(F.lds + ATT_OST + F.wave * 4096);
    if (hi == 0) wsf[32 + r32] = l;
    asm volatile("s_waitcnt lgkmcnt(0)" ::: "memory");
#pragma unroll
    for (int r = 0; r < 16; ++r) { const int orow = crow(r, hi); const float rl = fast_rcp(wsf[32 + orow]);
        stg[orow * 64 + r32] = (bf16)f2bf(o[0][r] * rl); stg[orow * 64 + 32 + r32] = (bf16)f2bf(o[1][r] * rl); }
    asm volatile("s_waitcnt lgkmcnt(0)" ::: "memory");
}

__device__ __forceinline__ void gathered_phase(Frame& F) {
    const bf16* Q = (const bf16*)(F.ws + WS_Q);
    const unsigned* sel = (const unsigned*)(F.ws + WS_SEL);
    bf16* part = (bf16*)(F.ws + WS_PART); float* lseb = (float*)(F.ws + WS_LSE);
    LAS unsigned short* list = (LAS unsigned short*)(F.lds + ATT_LIST);
    LAS unsigned* cnt = (LAS unsigned*)(F.lds + ATT_CNT);
    constexpr int NITEM = BATCH * NH * (NBLK - 1);
    const int lane = F.lane, r32 = lane & 31, hi = lane >> 5;
    for (;;) {
        __syncthreads();
        if (F.tid == 0) { cnt[1] = __hip_atomic_fetch_add((unsigned*)(F.ctl + CW_QUEUE), 1u, RLX_AGENT); cnt[0] = 0u; }
        __syncthreads();
        const int item = (int)cnt[1];
        if (item >= NITEM) break;
        const int j = item >> 5, bh = item & 31, b = bh >> 3, h = bh & 7;
        load_kv(F, b, h, j);
        const unsigned* selrow = sel + (size_t)bh * SEQ;
        for (int tb = (j + 1) * MBLK + F.tid; tb < SEQ + F.tid; tb += NWAVES * 64) {
            const int t = tb - F.tid + F.tid;
            const bool inr = t < SEQ;
            const unsigned sw = inr ? selrow[t] : 0xffffffffu;
            const int own = t >> 8, nv = own < 3 ? own : 3;
            int slot = -1;
            if ((int)(sw & 255u) == j && nv > 0) slot = 0; else if ((int)((sw >> 8) & 255u) == j && nv > 1) slot = 1; else if ((int)((sw >> 16) & 255u) == j && nv > 2) slot = 2;
            const bool match = inr && slot >= 0;
            const unsigned long long bal = __ballot(match);
            const int tot = __popcll(bal), pre = __popcll(bal & ((1ull << lane) - 1ull));
            unsigned base = 0u;
            if (lane == 0 && tot) base = __hip_atomic_fetch_add(cnt, (unsigned)tot, __ATOMIC_RELAXED, __HIP_MEMORY_SCOPE_WORKGROUP);
            base = (unsigned)__builtin_amdgcn_readfirstlane((int)base);
            if (match) list[base + pre] = (unsigned short)(t | (slot << 13));
        }
        asm volatile("s_waitcnt vmcnt(0) lgkmcnt(0)" ::: "memory");
        __syncthreads();
        const int n = (int)cnt[0];
        const int ntile = (n + 31) >> 5;
        const float slope2 = exp2f(-(float)(h + 1)) * LOG2E;
        for (int tile = F.wave; tile < ntile; tile += NWAVES) {
            const int idx = tile * 32 + r32, idc = idx < n ? idx : n - 1;
            const unsigned e = list[idc];
            const int t = (int)(e & 0x1fffu);
            f32x16 o[2]; float m, l;
            attn_tile<false>(F, Q + (size_t)(b * SEQ + t) * AW + h * HD, t - j * MBLK, slope2, 4, o, m, l);
            if (hi == 0 && idx < n) lseb[((size_t)(b * SEQ + t) * NH + h) * 3 + (e >> 13)] = m + __log2f(l);
            stage_o(F, o, l);
            const LAS bf16* stg = (const LAS bf16*)(F.lds + ATT_OST + F.wave * 4096);
#pragma unroll
            for (int i = 0; i < 4; ++i) { const int row = i * 8 + (lane >> 3), ch = lane & 7, ri = tile * 32 + row;
                if (ri < n) { const unsigned er = list[ri]; const v4u v = *(const LAS v4u*)(stg + row * 64 + ch * 8);
                    *(GAS v4u*)(part + ((size_t)(b * SEQ + (int)(er & 0x1fffu)) * 3 + (er >> 13)) * AW + h * HD + ch * 8) = v; } }
            asm volatile("s_waitcnt lgkmcnt(0)" ::: "memory");
        }
    }
}

__device__ __forceinline__ void own_phase(Frame& F) {
    const bf16* Q = (const bf16*)(F.ws + WS_Q);
    const bf16* part = (const bf16*)(F.ws + WS_PART); const float* lseb = (const float*)(F.ws + WS_LSE);
    bf16* yatt = (bf16*)(F.ws + WS_YATT);
    constexpr int NITEM = BATCH * NH * NBLK;
    const int lane = F.lane, r32 = lane & 31, hi = lane >> 5;
    for (int it = F.vcu; it < NITEM; it += F.G) {
        const int i = it & 31, bh = it >> 5, b = bh >> 3, h = bh & 7;
        __syncthreads();
        load_kv(F, b, h, i);
        asm volatile("s_waitcnt vmcnt(0)" ::: "memory");
        __syncthreads();
        const float slope2 = exp2f(-(float)(h + 1)) * LOG2E;
        const int reli = F.wave * 32 + r32, t = i * MBLK + reli;
        f32x16 o[2]; float m, l;
        attn_tile<true>(F, Q + (size_t)(b * SEQ + t) * AW + h * HD, reli, slope2, (F.wave >> 1) + 1, o, m, l);
        LAS float* wsf = (LAS float*)(F.lds + ATT_WS + F.wave * 256);
        if (hi == 0) wsf[r32] = m + __log2f(l);
        stage_o(F, o, l);
        const LAS bf16* stg = (const LAS bf16*)(F.lds + ATT_OST + F.wave * 4096);
        const int nv = i < 3 ? i : 3;
#pragma unroll
        for (int k = 0; k < 4; ++k) {
            const int row = k * 8 + (lane >> 3), ch = lane & 7, tr = i * MBLK + F.wave * 32 + row;
            const v4u ov = *(const LAS v4u*)(stg + row * 64 + ch * 8);
            const float lown = wsf[row];
            float ls[3]; float M = lown;
#pragma unroll
            for (int s2 = 0; s2 < 3; ++s2) { ls[s2] = (s2 < nv) ? lseb[((size_t)(b * SEQ + tr) * NH + h) * 3 + s2] : -1e30f; M = fmaxf(M, ls[s2]); }
            float wown = fast_exp2(lown - M), W = wown;
            float a[8] = {bflo(ov.x) * wown, bfhi(ov.x) * wown, bflo(ov.y) * wown, bfhi(ov.y) * wown, bflo(ov.z) * wown, bfhi(ov.z) * wown, bflo(ov.w) * wown, bfhi(ov.w) * wown};
#pragma unroll
            for (int s2 = 0; s2 < 3; ++s2) if (s2 < nv) {
                const float w = fast_exp2(ls[s2] - M); W += w;
                const v4u pv = *(const GAS v4u*)(part + ((size_t)(b * SEQ + tr) * 3 + s2) * AW + h * HD + ch * 8);
                a[0] += w * bflo(pv.x); a[1] += w * bfhi(pv.x); a[2] += w * bflo(pv.y); a[3] += w * bfhi(pv.y); a[4] += w * bflo(pv.z); a[5] += w * bfhi(pv.z); a[6] += w * bflo(pv.w); a[7] += w * bfhi(pv.w);
            }
            const float rw = fast_rcp(W);
            v4u outv; outv.x = pk2(a[0] * rw, a[1] * rw); outv.y = pk2(a[2] * rw, a[3] * rw); outv.z = pk2(a[4] * rw, a[5] * rw); outv.w = pk2(a[6] * rw, a[7] * rw);
            *(GAS v4u*)(yatt + (size_t)(b * SEQ + tr) * AW + h * HD + ch * 8) = outv;
        }
        asm volatile("s_waitcnt lgkmcnt(0)" ::: "memory");
    }
}
}

__device__ __forceinline__ void attn_simple_phase(Frame& F) {
    LAS float* qs = (LAS float*)(F.lds + RING_OFF + F.wave * 8192);
    LAS float* pb = qs + 64;
    const bf16* q = (const bf16*)(F.ws + WS_Q); const bf16* k = (const bf16*)(F.ws + WS_K); const bf16* v = (const bf16*)(F.ws + WS_V);
    const unsigned* sel = (const unsigned*)(F.ws + WS_SEL);
    bf16* yatt = (bf16*)(F.ws + WS_YATT);
    const int gw = F.vcu * NWAVES + F.wave, NGW = F.G * NWAVES;
    for (int id = gw; id < BATCH * NH * SEQ; id += NGW) {
        const int t = id & (SEQ - 1), h = (id >> 13) & 7, b = id >> 16;
        const int own = t >> 8, nvalid = own < 3 ? own : 3;
        const float slope2 = exp2f(-(float)(h + 1)) * LOG2E;
        const size_t rowq = (size_t)(b * SEQ + t) * AW + h * HD;
        qs[F.lane] = bf2f(q[rowq + F.lane]);
        LDS_WAIT(); asm volatile("" ::: "memory");
        float qf[64];
#pragma unroll
        for (int c = 0; c < 16; ++c) { const f32x4 x = *(const LAS f32x4*)(qs + 4 * c); qf[4 * c] = x[0]; qf[4 * c + 1] = x[1]; qf[4 * c + 2] = x[2]; qf[4 * c + 3] = x[3]; }
        const unsigned sw = sel[(size_t)(b * NH + h) * SEQ + t];
        int blk[4]; blk[0] = sw & 255; blk[1] = (sw >> 8) & 255; blk[2] = (sw >> 16) & 255; blk[3] = own;
        float sc[16]; float mx = -1e30f;
#pragma unroll
        for (int s = 0; s < 4; ++s) {
            const bool valid = (s == 3) || (s < nvalid);
#pragma unroll
            for (int kk = 0; kk < 4; ++kk) {
                float val = -1e30f;
                if (valid) {
                    const int kpos = blk[s] * MBLK + kk * 64 + F.lane;
                    if (s < 3 || kpos <= t) {
                        const bf16* kr = k + (size_t)(b * SEQ + kpos) * AW + h * HD;
                        float dot = 0.f;
#pragma unroll
                        for (int c = 0; c < 8; ++c) { const v4u w = *(const GAS v4u*)(kr + 8 * c);
                            dot += qf[8 * c] * bflo(w.x) + qf[8 * c + 1] * bfhi(w.x) + qf[8 * c + 2] * bflo(w.y) + qf[8 * c + 3] * bfhi(w.y) + qf[8 * c + 4] * bflo(w.z) + qf[8 * c + 5] * bfhi(w.z) + qf[8 * c + 6] * bflo(w.w) + qf[8 * c + 7] * bfhi(w.w); }
                        val = dot + slope2 * (float)(kpos - t);
                    }
                }
                sc[s * 4 + kk] = val; mx = fmaxf(mx, val);
            }
        }
        mx = wave_max(mx);
        float l = 0.f;
#pragma unroll
        for (int i = 0; i < 16; ++i) { const float p = fast_exp2(sc[i] - mx); l += p; pb[i * 64 + F.lane] = p; }
        l = wave_sum(l);
        LDS_WAIT(); asm volatile("" ::: "memory");
        float o = 0.f;
#pragma unroll
        for (int s = 0; s < 4; ++s) {
            const bool valid = (s == 3) || (s < nvalid);
            if (!valid) continue;
            const int nk = (s == 3) ? (t & 255) + 1 : 256;
            const bf16* vb = v + (size_t)(b * SEQ + blk[s] * MBLK) * AW + h * HD + F.lane;
            const LAS float* pp = pb + s * 256;
#pragma unroll 8
            for (int j = 0; j < nk; ++j) o += pp[j] * bf2f(vb[(size_t)j * AW]);
        }
        yatt[rowq + F.lane] = (bf16)f2bf(o / l);
        LDS_WAIT(); asm volatile("" ::: "memory");
    }
}

__device__ __forceinline__ void ssm_simple_phase(Frame& F) {
    const int gw = F.vcu * NWAVES + F.wave;
    if (gw >= BATCH * SG) return;
    const int g = gw % SG, b = gw / SG, p = F.lane;
    const float lr = F.in[IN_LAMRE][g * SP + p], li = F.in[IN_LAMIM][g * SP + p], dt = expf(F.in[IN_LOGDT][g]);
    const float mag = expf(lr * dt), ang = li * dt;
    float sn_, cs_; sincosf(ang, &sn_, &cs_);
    const float ar = mag * cs_, ai = mag * sn_;
    const float nr = ar - 1.0f, ni = ai, den = lr * lr + li * li;
    const float fr = (nr * lr + ni * li) / den, fi = (ni * lr - nr * li) / den;
    float bbr[16], bbi[16], cr[16], ci[16];
#pragma unroll
    for (int c = 0; c < 16; ++c) {
        const float br = F.in[IN_BRE][(g * SP + p) * SC + c], bi = F.in[IN_BIM][(g * SP + p) * SC + c];
        bbr[c] = fr * br - fi * bi; bbi[c] = fr * bi + fi * br;
        cr[c] = F.in[IN_CRE][(g * SC + c) * SP + p]; ci[c] = F.in[IN_CIM][(g * SC + c) * SP + p];
    }
    const bf16* A = (const bf16*)(F.ws + WS_SSMA);
    bf16* y1 = (bf16*)(F.ws + WS_Y1);
    const float dsk = F.in[IN_SSMD][g * SC + (F.lane & 15)];
    float xr = 0.f, xi = 0.f;
    for (int t = 0; t < SEQ; ++t) {
        const bf16* urow = A + ((size_t)(g * 1024 + b * NCH + (t >> 5)) * KSSM + (t & 31) * SC);
        const float ul = bf2f(urow[F.lane & 15]);
        float bur = 0.f, bui = 0.f;
#pragma unroll
        for (int c = 0; c < 16; ++c) { const float uc = __shfl(ul, c); bur += bbr[c] * uc; bui += bbi[c] * uc; }
        const float nxr = ar * xr - ai * xi + bur, nxi = ar * xi + ai * xr + bui;
        xr = nxr; xi = nxi;
        float yv = 0.f;
#pragma unroll
        for (int c = 0; c < 16; ++c) { const float part = wave_sum(cr[c] * xr - ci[c] * xi); if ((F.lane & 15) == c) yv = part; }
        if (F.lane < 16) { const float val = yv + dsk * ul; y1[(size_t)(b * SEQ + t) * SW + g * SC + F.lane] = (bf16)f2bf(gelu_tanh(val)); }
    }
}

struct Args { const float* in[26]; float* out; unsigned char* ws; int ph_lo, ph_hi, li, pad; };

__global__ void __launch_bounds__(NWAVES * 64, 2) hybrid_fwd(Args args) {
    extern __shared__ __attribute__((aligned(16))) unsigned char lds[];
    Frame F;
    F.lds = (LAS unsigned char*)lds;
    F.MISC = (volatile LAS unsigned*)(F.lds + MISC_OFF);
    F.tid = threadIdx.x; F.lane = F.tid & 63; F.wave = __builtin_amdgcn_readfirstlane(F.tid >> 6);
    F.G = gridDim.x; { const int bx = blockIdx.x; F.vcu = (F.G % 8 == 0) ? (bx % 8) * (F.G / 8) + bx / 8 : bx; }
    F.ws = args.ws; F.ctl = (gu32*)(args.ws + WS_CTL); F.out = args.out;
#pragma unroll
    for (int i = 0; i < 26; ++i) F.in[i] = args.in[i];
    for (int u = F.tid; u < 64; u += NWAVES * 64) ((LAS unsigned*)(F.lds + MISC_OFF))[u] = 0u;
    __syncthreads();
    XcdBarrier bar; bar.bar = (unsigned*)(F.ctl + CW_BAR); bar.x = 0; bar.st = nullptr;
    if (MK_N_LAUNCHES == 1) bar = xcd_barrier_post((unsigned*)(F.ctl + CW_BAR), F.MISC + 8);
#define GRID_BAR() do { if (MK_N_LAUNCHES == 1) xcd_barrier(bar); } while (0)
    const int lo = args.ph_lo, hi = args.ph_hi;
#define IN(k) (lo <= (k) && (k) < hi)
#define BOTH(k) (IN(k) && IN((k) + 1))
    unsigned char* ws = args.ws;
    const float* ada = (const float*)(ws + WS_ADA);
    float* rowss = (float*)(ws + WS_ROWSS);
    const int bx = (int)blockIdx.x;

    if (IN(0)) { p0_prologue(F); if (BOTH(0)) GRID_BAR(); }
    if (IN(1)) { p1_phase(F); if (BOTH(1)) GRID_BAR(); }
    if (IN(2)) {
        pg8::Gemm g{(const bf16*)F.out, (const bf16*)(ws + WS_W1T), D, D, D, nullptr, nullptr, 0}; pg8::StaticOrder S; S.init(T, NGU, F.G, bx);
        pg8::EpiSwiGLU<false> E{(bf16*)(ws + WS_ACT), nullptr, nullptr};
        pg8::gemm_phase<pg8::EpiSwiGLU<false>, pg8::StaticOrder, true>(F.lds + RING_OFF, g, S, E);
        if (BOTH(2)) GRID_BAR();
    }
    if (IN(3)) {
        pg8::Gemm g{(const bf16*)(ws + WS_ACT), (const bf16*)(ws + WS_W2T), FF, FF, FF, nullptr, nullptr, 0}; pg8::StaticOrder S; S.init(T, D, F.G, bx);
        pg8::EpiResid<true, 0> E{F.in[IN_X], F.out, ada + 2 * D, (bf16*)(ws + WS_X1S), (const float*)(ws + WS_CS2), rowss, 0.5f};
        pg8::gemm_phase<pg8::EpiResid<true, 0>, pg8::StaticOrder, true>(F.lds + RING_OFF, g, S, E);
        if (BOTH(3)) GRID_BAR();
    }
    if (IN(4)) {
        pg8::Gemm g{(const bf16*)(ws + WS_X1S), (const bf16*)(ws + WS_WINT), D, D, D, nullptr, nullptr, 0}; pg8::StaticOrder S; S.init(T, NIN, F.G, bx);
        pg8::EpiIn E{rowss, (const float*)(ws + WS_BIAS2), (bf16*)(ws + WS_Q), (bf16*)(ws + WS_K), (bf16*)(ws + WS_V), (bf16*)(ws + WS_SSMA), (bf16*)(ws + WS_SGA), (bf16*)(ws + WS_SGS), (float*)(ws + WS_KMEANP)};
        pg8::gemm_phase<pg8::EpiIn, pg8::StaticOrder, true>(F.lds + RING_OFF, g, S, E);
        if (BOTH(4)) GRID_BAR();
    }
    if (IN(5)) {
        {
            pg8::Gemm g{(const bf16*)(ws + WS_SSMA), (const bf16*)(ws + WS_BS), KSSM, 512, 512, nullptr, nullptr, 0}; pg8::BlockDiagOrder S; S.init(SG, 4, 1, F.G, bx);
            pg8::EpiSsmState E{(bf16*)(ws + WS_SSMA), F.in[IN_LAMRE], F.in[IN_LAMIM], F.in[IN_LOGDT]};
            pg8::gemm_phase<pg8::EpiSsmState, pg8::BlockDiagOrder, false>(F.lds + RING_OFF, g, S, E);
        }
        gating_phase(F); if (BOTH(5)) GRID_BAR();
    }
    if (IN(6)) {
        {
            pg8::Gemm g{(const bf16*)(ws + WS_SSMA), (const bf16*)(ws + WS_BM), KSSM, KSSM, KSSM, nullptr, nullptr, 0}; pg8::BlockDiagOrder S; S.init(SG, 4, 2, F.G, bx);
            pg8::EpiSsmMain E{(const bf16*)(ws + WS_SSMA), F.in[IN_SSMD], (bf16*)(ws + WS_Y1)};
            pg8::gemm_phase<pg8::EpiSsmMain, pg8::BlockDiagOrder, true>(F.lds + RING_OFF, g, S, E);
        }
        att::gathered_phase(F); if (BOTH(6)) GRID_BAR(); }
    if (IN(7)) {
        pg8::Gemm g{(const bf16*)(ws + WS_Y1), (const bf16*)(ws + WS_WGLU), SW, SW, SW, nullptr, nullptr, 0}; pg8::StaticOrder S; S.init(T, SW, F.G, bx);
        pg8::EpiGlu E{(const bf16*)(ws + WS_Y1), F.in[IN_BGLU], (bf16*)(ws + WS_YSSM)};
        pg8::gemm_phase<pg8::EpiGlu, pg8::StaticOrder, true>(F.lds + RING_OFF, g, S, E);
        att::own_phase(F);
        if (BOTH(7)) GRID_BAR();
    }
    if (IN(8)) {
        pg8::Gemm g{(const bf16*)(ws + WS_YATT), (const bf16*)(ws + WS_WBRA), AW, AW, AW, (const bf16*)(ws + WS_YSSM), (const bf16*)(ws + WS_WBRS), SW}; pg8::StaticOrder S; S.init(T, D, F.G, bx);
        pg8::EpiMerge E{(const bf16*)(ws + WS_SGA), (const bf16*)(ws + WS_SGS), (bf16*)(ws + WS_MERGED)};
        pg8::gemm_phase<pg8::EpiMerge, pg8::StaticOrder, true>(F.lds + RING_OFF, g, S, E);
        if (BOTH(8)) GRID_BAR();
    }
    if (IN(9)) {
        pg8::Gemm g{(const bf16*)(ws + WS_MERGED), (const bf16*)(ws + WS_WOUT), D, D, D, nullptr, nullptr, 0}; pg8::StaticOrder S; S.init(T, D, F.G, bx);
        pg8::EpiResid<true, 1> E{F.out, F.out, ada + 5 * D, (bf16*)(ws + WS_X2S), (const float*)(ws + WS_CS3), rowss, 1.0f};
        pg8::gemm_phase<pg8::EpiResid<true, 1>, pg8::StaticOrder, true>(F.lds + RING_OFF, g, S, E);
        if (BOTH(9)) GRID_BAR();
    }
    if (IN(10)) {
        pg8::Gemm g{(const bf16*)(ws + WS_X2S), (const bf16*)(ws + WS_W3T), D, D, D, nullptr, nullptr, 0}; pg8::StaticOrder S; S.init(T, NGU, F.G, bx);
        pg8::EpiSwiGLU<true> E{(bf16*)(ws + WS_ACT), rowss, (const float*)(ws + WS_BIAS3)};
        pg8::gemm_phase<pg8::EpiSwiGLU<true>, pg8::StaticOrder, true>(F.lds + RING_OFF, g, S, E);
        if (BOTH(10)) GRID_BAR();
    }
    if (IN(11)) {
        pg8::Gemm g{(const bf16*)(ws + WS_ACT), (const bf16*)(ws + WS_W4T), FF, FF, FF, nullptr, nullptr, 0}; pg8::StaticOrder S; S.init(T, D, F.G, bx);
        pg8::EpiResid<false, 2> E{F.out, F.out, ada + 8 * D, nullptr, nullptr, rowss, 0.5f};
        pg8::gemm_phase<pg8::EpiResid<false, 2>, pg8::StaticOrder, true>(F.lds + RING_OFF, g, S, E);
        if (BOTH(11)) GRID_BAR();
    }
    if (IN(12)) { final_norm_phase(F); }
#undef IN
#undef BOTH
}

extern "C" void kernel_launch(void* const* d_in, const int* in_sizes, int n_in, void* d_out, int out_size, void* d_ws, size_t ws_size, hipStream_t stream) {
    static int grid = 0;
    if (grid == 0) {
        if (n_in != 26 || in_sizes[0] != T * D || out_size != T * D || ws_size < WS_END) { fprintf(stderr, "kernel_launch: unexpected shapes (n_in %d, in0 %d, out %d, ws %zu < %zu); nothing launched\n", n_in, n_in > 0 ? in_sizes[0] : -1, out_size, ws_size, (size_t)WS_END); grid = -1; return; }
        int dev = 0, cus = 0;
        if (hipGetDevice(&dev) != hipSuccess || hipDeviceGetAttribute(&cus, hipDeviceAttributeMultiprocessorCount, dev) != hipSuccess) { grid = -1; return; }
        if (hipFuncSetAttribute((const void*)hybrid_fwd, hipFuncAttributeMaxDynamicSharedMemorySize, LDS_BYTES) != hipSuccess) { fprintf(stderr, "kernel_launch: hipFuncSetAttribute failed\n"); grid = -1; return; }
        (void)hipGetLastError();
        grid = cus;
    }
    if (grid < 0) return;
    if (hipMemsetAsync((char*)d_ws + WS_CTL, 0, CTL_ZERO_BYTES, stream) != hipSuccess) return;
    Args a{};
    for (int i = 0; i < 26; ++i) a.in[i] = (const float*)d_in[i];
    a.out = (float*)d_out; a.ws = (unsigned char*)d_ws;
    for (int li = 0; li < MK_N_LAUNCHES; ++li) {
        a.ph_lo = (MK_N_LAUNCHES == 1) ? 0 : li; a.ph_hi = (MK_N_LAUNCHES == 1) ? N_PHASES : li + 1; a.li = li;
        hipLaunchKernelGGL(hybrid_fwd, dim3(grid), dim3(NWAVES * 64), LDS_BYTES, stream, a);
    }
}
```

```cpp
#include <hip/hip_runtime.h>
#include <hip/hip_bf16.h>
#include <cstdio>
#include <cstdint>

#ifndef MK_N_LAUNCHES
#define MK_N_LAUNCHES 1
#endif

constexpr int BATCH = 4, SEQ = 8192, T = BATCH * SEQ, D = 1024, FF = 2816, NGU = 2 * FF, NIN = 4096, AW = 512, SW = 512, NH = 8, HD = 64;
constexpr int NBLK = 32, MBLK = 256;
constexpr int SG = 32, SC = 16, SP = 64, SL = 32, NCH = SEQ / SL, KSSM = SC * SL + 2 * SP;
constexpr int NADA = 9 * D;
constexpr float EPS = 1e-6f;
constexpr float LOG2E = 1.4426950408889634f;
constexpr float QSCALE = 0.125f * LOG2E;
constexpr int N_PHASES = 13;

constexpr size_t MiB = 1u << 20;
constexpr size_t WS_CTL = 0, CTL_ZERO_BYTES = 1 * MiB;
constexpr size_t WS_ADA = 1 * MiB;
constexpr size_t WS_CS2 = WS_ADA + 147456;
constexpr size_t WS_CS3 = WS_CS2 + 16384;
constexpr size_t WS_BIAS2 = WS_CS3 + 16384;
constexpr size_t WS_BIAS3 = WS_BIAS2 + 65536;
constexpr size_t WS_KMEANP = 1 * MiB + 512 * 1024;
constexpr size_t WS_SEL = 2 * MiB;
constexpr size_t WS_LSE = 498 * MiB;
constexpr size_t WS_ROWSS = 4 * MiB;
constexpr size_t WS_WINT = 8 * MiB, WS_WGLU = 16 * MiB, WS_WBRA = 17 * MiB, WS_WBRS = 18 * MiB, WS_WOUT = 19 * MiB;
constexpr size_t WS_W1T = 21 * MiB, WS_W2T = 32 * MiB, WS_W3T = 37 * MiB + 512 * 1024, WS_W4T = 48 * MiB + 512 * 1024;
constexpr size_t WS_BM = 54 * MiB, WS_BS = 74 * MiB;
constexpr size_t WS_ARENA = 82 * MiB;
constexpr size_t WS_SGA = WS_ARENA, WS_SGS = WS_ARENA + 32 * MiB;
constexpr size_t WS_Q = WS_ARENA + 128 * MiB, WS_K = WS_ARENA + 160 * MiB, WS_V = WS_ARENA + 192 * MiB;
constexpr size_t WS_PART = WS_ARENA + 224 * MiB;
constexpr size_t WS_Y1 = WS_ARENA + 320 * MiB;
constexpr size_t WS_SSMA = WS_ARENA + 352 * MiB;
constexpr size_t WS_YSSM = WS_ARENA + 352 * MiB, WS_YATT = WS_ARENA + 384 * MiB;
constexpr size_t WS_X1S = WS_ARENA + 224 * MiB, WS_ACT = WS_ARENA, WS_MERGED = WS_ARENA + 128 * MiB, WS_X2S = WS_ARENA + 224 * MiB;
constexpr size_t WS_X3 = WS_ARENA + 224 * MiB;
constexpr size_t WS_END = WS_ARENA + 416 * MiB + 3 * MiB;
static_assert(WS_BIAS3 + 90112 <= WS_KMEANP && WS_W4T + (size_t)D * FF * 2 <= WS_BM && WS_BM + (size_t)SG * 512 * KSSM * 2 <= WS_BS && WS_BS + (size_t)SG * 256 * 512 * 2 <= WS_ARENA, "ws map");
static_assert((size_t)SG * 1024 * KSSM * 2 <= 40 * MiB && (size_t)T * FF * 2 <= 176 * MiB, "ws map 2");
constexpr int CW_BAR = 4096;
constexpr int CW_QUEUE = 256;

constexpr int RING_OFF = 0, RING_BYTES = 131072;
constexpr int SILU_OFF = 131072;
constexpr int RN_OFF = 147456;
constexpr int LDS_BYTES = 163840;
constexpr int MISC_OFF = LDS_BYTES - 256;

#define GAS __attribute__((address_space(1)))
#define LAS __attribute__((address_space(3)))
typedef unsigned short bf16;
typedef unsigned v4u __attribute__((ext_vector_type(4)));
typedef unsigned v2u __attribute__((ext_vector_type(2)));
typedef float f32x4 __attribute__((ext_vector_type(4)));
typedef float f32x2 __attribute__((ext_vector_type(2)));
typedef short bf16x8 __attribute__((ext_vector_type(8)));
typedef GAS unsigned gu32;
#define RLX_AGENT __ATOMIC_RELAXED, __HIP_MEMORY_SCOPE_AGENT
#define LDS_WAIT() asm volatile("s_waitcnt lgkmcnt(0)" ::: "memory")
#define VM_WAIT() asm volatile("s_waitcnt vmcnt(0)" ::: "memory")
constexpr int NWAVES = 8;

__device__ __forceinline__ unsigned f2bf(float f) { unsigned u = __builtin_bit_cast(unsigned, f); return (u + 0x7fffu + ((u >> 16) & 1u)) >> 16; }
__device__ __forceinline__ unsigned pk2(float lo, float hi) { return f2bf(lo) | (f2bf(hi) << 16); }
__device__ __forceinline__ float bf2f(unsigned short h) { return __builtin_bit_cast(float, (unsigned)h << 16); }
__device__ __forceinline__ float bflo(unsigned w) { return __builtin_bit_cast(float, w << 16); }
__device__ __forceinline__ float bfhi(unsigned w) { return __builtin_bit_cast(float, w & 0xffff0000u); }
__device__ __forceinline__ float fast_exp2(float x) { return __builtin_amdgcn_exp2f(x); }
__device__ __forceinline__ float fast_rcp(float x) { return __builtin_amdgcn_rcpf(x); }
__device__ __forceinline__ float sigmoidf_(float x) { return fast_rcp(1.0f + fast_exp2(-LOG2E * x)); }
__device__ __forceinline__ float siluf_(float x) { return x * sigmoidf_(x); }
__device__ __forceinline__ float gelu_tanh(float v) { const float u = 1.5957691216057308f * (v + 0.044715f * v * v * v); return v * fast_rcp(1.0f + fast_exp2(-LOG2E * u)); }
__device__ __forceinline__ float wave_sum(float v) {
#pragma unroll
    for (int o = 1; o < 64; o <<= 1) v += __shfl_xor(v, o);
    return v;
}
__device__ __forceinline__ float wave_max(float v) {
#pragma unroll
    for (int o = 1; o < 64; o <<= 1) v = fmaxf(v, __shfl_xor(v, o));
    return v;
}

namespace pg8 {
#define PG8_LAS __attribute__((address_space(3)))
typedef unsigned short bf16_t;
typedef short bf16x8 __attribute__((ext_vector_type(8)));
typedef float f32x4 __attribute__((ext_vector_type(4)));
typedef unsigned u32x4 __attribute__((ext_vector_type(4)));
constexpr int BM = 256, BK = 64, HALF = 128, HTB = HALF * BK * 2, STAGE_BYTES = 8 * HTB, NXCD = 8, WGM = 8;

__host__ __device__ __forceinline__ int lds_byte(int r, int c) { const int st = (r >> 4) * 2 + (c >> 5), rr = r & 15, cc = c & 31, ob = rr * 64 + cc * 2; return st * 1024 + (ob ^ (((ob >> 9) & 1) << 5)); }
__host__ __device__ __forceinline__ void stage_rc(int b, int& R, int& C) { const int st = b / 1024, sb = b % 1024, swz = sb ^ (((sb >> 9) & 1) << 5); R = (st >> 1) * 16 + swz / 64; C = (st & 1) * 32 + (swz % 64) / 2; }
__host__ __device__ __forceinline__ int perm32(int rho) { const int n = rho >> 4, i = rho & 15; return 8 * (i >> 2) + 4 * n + (i & 3); }

struct Unit { int pm, pn; };
struct Gemm { const bf16_t* A; const bf16_t* Bt; int lda, ldb, K; const bf16_t* A2; const bf16_t* Bt2; int K2; };

struct StaticOrder {
    int nM, nN, nwg, G, c;
    __host__ __device__ void init(int M, int N, int G_, int c_) { nM = M / BM; nN = N / BM; nwg = nM * nN; G = G_; c = c_; }
    __host__ __device__ bool next(int i, Unit& u) const {
        const long L = (long)i * G + c; if (L >= nwg) return false;
        int wgid = (int)L; { const int q = nwg / NXCD, r = nwg % NXCD, xcd = wgid % NXCD, off = wgid / NXCD; wgid = (xcd < r ? xcd * (q + 1) : r * (q + 1) + (xcd - r) * q) + off; }
        const int nig = WGM * nN, gid = wgid / nig, fm = gid * WGM, gsz = (nM - fm) < WGM ? (nM - fm) : WGM;
        u.pm = fm + ((wgid % nig) % gsz); u.pn = (wgid % nig) / gsz; return true;
    }
};
struct BlockDiagOrder {
    int RM, RN, n, G, c, first;
    __host__ __device__ void init(int ngroups, int RM_, int RN_, int G_, int c_, int first_ = 0) { RM = RM_; RN = RN_; n = ngroups * RM_ * RN_; G = G_; c = c_; first = first_; }
    __host__ __device__ bool next(int i, Unit& u) const {
        const int L = i * G + c; if (L >= n || (first && i > 0)) return false;
        const int g = L / (RM * RN), r = L % (RM * RN); u.pm = g * RM + r / RN; u.pn = g * RN + r % RN; return true;
    }
};

__device__ __forceinline__ unsigned cvt_pk_bf16(float lo, float hi) { unsigned r; asm volatile("v_cvt_pk_bf16_f32 %0, %1, %2" : "=v"(r) : "v"(lo), "v"(hi)); return r; }

template <class Epi, class Sched, bool ALIGN_EPI = false, bool SP2 = true>
__device__ __forceinline__ void gemm_phase(PG8_LAS unsigned char* lds, const Gemm g, const Sched S, const Epi E) {
    const int tid = threadIdx.x, wid = __builtin_amdgcn_readfirstlane(tid >> 6), lane = tid & 63, wr = wid >> 2, wc = wid & 3, fr = lane & 15, fq = lane >> 4;
    const int nt1 = g.K / BK, nt = (g.K + g.K2) / BK;
    unsigned voffA[2], voffB[2];
#pragma unroll
    for (int i = 0; i < 2; ++i) { int R, C; stage_rc(tid * 16 + i * 8192, R, C); const int Rb = Epi::PERM ? ((R & ~31) + perm32(R & 31)) : R;
        voffA[i] = (unsigned)(R * g.lda + C) * 2u; voffB[i] = (unsigned)(Rb * g.ldb + C) * 2u; }
    const size_t kstep = (size_t)(BK * 2);
    const size_t hstepA = (size_t)HALF * g.lda * 2, hstepB = (size_t)HALF * g.ldb * 2;
    const size_t tstepA = 2 * hstepA, tstepB = 2 * hstepB;
    const unsigned ldsw = (unsigned)wid * 1024u;
    const int aoff = lds_byte(wr * 64 + fr, fq * 8), boff = lds_byte(wc * 32 + fr, fq * 8);
#define PG8_SA(b, h) (((b) * 2 + (h)) * HTB)
#define PG8_SB(b, h) ((4 + (b) * 2 + (h)) * HTB)
#define PG8_STAGE(bufoff, gbase, voff) do { _Pragma("unroll") for (int _i = 0; _i < 2; ++_i) \
        __builtin_amdgcn_global_load_lds((const unsigned*)((const char*)(gbase) + (voff)[_i]), (PG8_LAS unsigned*)(lds + (bufoff) + ldsw + _i * 8192), 16, 0, 0); } while (0)
#define PG8_LDA(dst, b, h) do { _Pragma("unroll") for (int m = 0; m < 4; ++m) _Pragma("unroll") for (int k = 0; k < 2; ++k) dst[m][k] = *(const PG8_LAS bf16x8*)(lds + PG8_SA(b, h) + aoff + m * 2048 + k * 1024); } while (0)
#define PG8_LDB(dst, b, h) do { _Pragma("unroll") for (int n = 0; n < 2; ++n) _Pragma("unroll") for (int k = 0; k < 2; ++k) dst[n][k] = *(const PG8_LAS bf16x8*)(lds + PG8_SB(b, h) + boff + n * 2048 + k * 1024); } while (0)
#define PG8_MMA(ai, bj, At, Bt) do { __builtin_amdgcn_s_setprio(1); _Pragma("unroll") for (int m = 0; m < 4; ++m) _Pragma("unroll") for (int n = 0; n < 2; ++n) _Pragma("unroll") for (int k = 0; k < 2; ++k) \
        acc[ai][bj][m][n] = __builtin_amdgcn_mfma_f32_16x16x32_bf16(Bt[n][k], At[m][k], acc[ai][bj][m][n], 0, 0, 0); __builtin_amdgcn_s_setprio(0); } while (0)
#define PG8_WAIT_V(n) asm volatile("s_waitcnt vmcnt(" #n ")" ::: "memory")
#define PG8_WAIT_L(n) asm volatile("s_waitcnt lgkmcnt(" #n ")" ::: "memory")
#define PG8_BAR __builtin_amdgcn_s_barrier()
#define PG8_SCHED __builtin_amdgcn_sched_barrier(0)
    Unit cur, nxt; int ui = 0;
    if (!S.next(0, cur)) return;
    f32x4 acc[2][2][4][2];
#pragma unroll
    for (int a = 0; a < 2; ++a)
#pragma unroll
        for (int b = 0; b < 2; ++b)
#pragma unroll
            for (int m = 0; m < 4; ++m)
#pragma unroll
                for (int n = 0; n < 2; ++n) acc[a][b][m][n] = (f32x4){0.f, 0.f, 0.f, 0.f};
    bf16x8 At[4][2], B0[2][2], B1[2][2];
    const char* cA = (const char*)g.A + (size_t)cur.pm * tstepA; const char* cB = (const char*)g.Bt + (size_t)cur.pn * tstepB;
    const char* cA2 = (const char*)g.A2 + (size_t)cur.pm * tstepA; const char* cB2 = (const char*)g.Bt2 + (size_t)cur.pn * tstepB;
    {
        PG8_STAGE(PG8_SB(0, 0), cB, voffB); PG8_STAGE(PG8_SB(0, 1), cB + hstepB, voffB); PG8_STAGE(PG8_SA(0, 0), cA, voffA); PG8_STAGE(PG8_SA(0, 1), cA + hstepA, voffA);
        if (wr == 1) PG8_BAR;
        PG8_WAIT_V(2); PG8_BAR;
        PG8_STAGE(PG8_SB(1, 0), cB + kstep, voffB); PG8_STAGE(PG8_SA(1, 0), cA + kstep, voffA); PG8_STAGE(PG8_SB(1, 1), cB + hstepB + kstep, voffB);
        PG8_WAIT_V(6); PG8_BAR;
    }
    for (;;) {
        const bool has_next = S.next(ui + 1, nxt);
        const char* nA = has_next ? (const char*)g.A + (size_t)nxt.pm * tstepA : cA; const char* nB = has_next ? (const char*)g.Bt + (size_t)nxt.pn * tstepB : cB;
        for (int t = 0; t < nt; t += 2) {
            const bool last = (t == nt - 2);
            if constexpr (Epi::HAS_MID) { if (t == nt1) E.mid(acc, cur, wr, wc, fr, fq); }
            const char* a0 = (t < nt1) ? cA + (size_t)t * kstep : cA2 + (size_t)(t - nt1) * kstep;
            const char* a1 = a0 + kstep;
            const char* a2 = last ? nA : ((t + 2 < nt1) ? cA + (size_t)(t + 2) * kstep : cA2 + (size_t)(t + 2 - nt1) * kstep);
            const char* b2 = last ? nB : ((t + 2 < nt1) ? cB + (size_t)(t + 2) * kstep : cB2 + (size_t)(t + 2 - nt1) * kstep);
            const char* a3 = a2 + kstep; const char* b3 = b2 + kstep;
            PG8_LDB(B0, 0, 0); PG8_LDB(B1, 0, 1); PG8_SCHED; PG8_LDA(At, 0, 0); PG8_STAGE(PG8_SA(1, 1), a1 + hstepA, voffA);
            PG8_WAIT_V(8); PG8_WAIT_L(0); PG8_BAR; PG8_MMA(0, 0, At, B0); PG8_MMA(0, 1, At, B1); PG8_BAR; PG8_SCHED;
            PG8_LDA(At, 0, 1); PG8_STAGE(PG8_SB(0, 0), b2, voffB); PG8_STAGE(PG8_SB(0, 1), b2 + hstepB, voffB); PG8_STAGE(PG8_SA(0, 0), a2, voffA);
            PG8_WAIT_V(8); PG8_WAIT_L(0); PG8_BAR; PG8_MMA(1, 0, At, B0); PG8_MMA(1, 1, At, B1); PG8_BAR; PG8_SCHED;
            PG8_LDB(B0, 1, 0); PG8_LDB(B1, 1, 1); PG8_SCHED; PG8_LDA(At, 1, 0); PG8_STAGE(PG8_SA(0, 1), a2 + hstepA, voffA);
            PG8_WAIT_V(8); PG8_WAIT_L(0); PG8_BAR; PG8_MMA(0, 0, At, B0); PG8_MMA(0, 1, At, B1); PG8_BAR; PG8_SCHED;
            PG8_LDA(At, 1, 1); PG8_STAGE(PG8_SB(1, 0), b3, voffB); PG8_STAGE(PG8_SB(1, 1), b3 + hstepB, voffB); PG8_STAGE(PG8_SA(1, 0), a3, voffA);
            PG8_WAIT_V(8); PG8_WAIT_L(0); PG8_BAR; PG8_MMA(1, 0, At, B0); PG8_MMA(1, 1, At, B1); PG8_BAR; PG8_SCHED;
        }
        if constexpr (ALIGN_EPI) { if (wr == 0) PG8_BAR; }
        if constexpr (!Epi::AFTER_DRAIN) { E(acc, cur, wr, wc, fr, fq); }
        if (!has_next) break;
#pragma unroll
        for (int a = 0; a < 2; ++a)
#pragma unroll
            for (int b = 0; b < 2; ++b)
#pragma unroll
                for (int m = 0; m < 4; ++m)
#pragma unroll
                    for (int n = 0; n < 2; ++n) acc[a][b][m][n] = (f32x4){0.f, 0.f, 0.f, 0.f};
        cur = nxt; cA = nA; cB = nB; ++ui;
        cA2 = (const char*)g.A2 + (size_t)cur.pm * tstepA; cB2 = (const char*)g.Bt2 + (size_t)cur.pn * tstepB;
        if constexpr (ALIGN_EPI) { if (wr == 1) PG8_BAR; }
    }
    PG8_WAIT_V(0);
    if constexpr (!ALIGN_EPI) { if (wr == 0) PG8_BAR; }
    PG8_BAR;
    if constexpr (Epi::AFTER_DRAIN) { E.fused(acc, cur, wr, wc, fr, fq, lds, wid, lane); }
#undef PG8_SA
#undef PG8_SB
#undef PG8_STAGE
#undef PG8_LDA
#undef PG8_LDB
#undef PG8_MMA
#undef PG8_WAIT_V
#undef PG8_WAIT_L
#undef PG8_BAR
#undef PG8_SCHED
}

__device__ __forceinline__ float row_rnorm(const float* rowss, int row) {
    const f32x4* p = (const f32x4*)(rowss + (size_t)row * 32);
    f32x4 t = p[0];
#pragma unroll
    for (int i = 1; i < 8; ++i) t += p[i];
    return __builtin_amdgcn_rsqf(((t[0] + t[1]) + (t[2] + t[3])) * (1.0f / 1024.0f) + EPS);
}

__device__ __forceinline__ void stage_rnorm(const float* rowss, int pm, int wr, int lane, PG8_LAS float* rn) {
    const int sub = lane >> 3, chunk = lane & 7;
#pragma unroll
    for (int it = 0; it < 16; ++it) {
        const int loc = it * 8 + sub;
        const int row = pm * BM + (loc >> 6) * HALF + wr * 64 + (loc & 63);
        const f32x4 t = *(const f32x4*)(rowss + (size_t)row * 32 + chunk * 4);
        float sm = (t[0] + t[1]) + (t[2] + t[3]);
        sm += __shfl_xor(sm, 1); sm += __shfl_xor(sm, 2); sm += __shfl_xor(sm, 4);
        if (chunk == 0) rn[loc] = __builtin_amdgcn_rsqf(sm * (1.0f / 1024.0f) + EPS);
    }
    asm volatile("s_waitcnt lgkmcnt(0)" ::: "memory");
}

template <bool NORM> struct EpiSwiGLU {
    static constexpr bool PERM = true, AFTER_DRAIN = false, HAS_MID = false;
    bf16_t* O; const float* rowss; const float* bias; PG8_LAS float* rnb;
    __device__ __forceinline__ void operator()(const f32x4 (&acc)[2][2][4][2], const Unit& u, int wr, int wc, int fr, int fq) const {
        const int row0 = u.pm * BM + wr * 64 + fr, b = u.pm >> 5;
        const int colB0 = u.pn * BM + wc * 32 + 8 * fq, ocol0 = u.pn * 128 + wc * 32 + 8 * fq;
        f32x4 bg[2], bu[2];
#pragma unroll
        for (int n = 0; n < 2; ++n) { bg[n] = NORM ? *(const f32x4*)(bias + (size_t)b * NGU + colB0 + 4 * n) : (f32x4){0.f, 0.f, 0.f, 0.f}; bu[n] = NORM ? *(const f32x4*)(bias + (size_t)b * NGU + colB0 + 128 + 4 * n) : (f32x4){0.f, 0.f, 0.f, 0.f}; }
        PG8_LAS float* rn = rnb + (wr * 4 + wc) * 128;
        if (NORM) stage_rnorm(rowss, u.pm, wr, fq * 16 + fr, rn);
#pragma unroll
        for (int ai = 0; ai < 2; ++ai)
#pragma unroll
            for (int m = 0; m < 4; ++m) {
                const int row = row0 + ai * HALF + m * 16;
                const float r = NORM ? rn[ai * 64 + m * 16 + fr] : 1.0f;
                float o[8];
#pragma unroll
                for (int n = 0; n < 2; ++n) {
                    f32x4 gv = acc[ai][0][m][n], uv = acc[ai][1][m][n];
                    if (NORM) { gv = gv * r + bg[n]; uv = uv * r + bu[n]; }
#pragma unroll
                    for (int j = 0; j < 4; ++j) o[4 * n + j] = siluf_(gv[j]) * uv[j];
                }
                u32x4 w; w.x = cvt_pk_bf16(o[0], o[1]); w.y = cvt_pk_bf16(o[2], o[3]); w.z = cvt_pk_bf16(o[4], o[5]); w.w = cvt_pk_bf16(o[6], o[7]);
                *(u32x4*)(O + (size_t)row * FF + ocol0) = w;
            }
    }
};

template <bool XS, int TAG> struct EpiResid {
    static constexpr bool PERM = true, AFTER_DRAIN = false, HAS_MID = false;
    const bf16_t* xin; bf16_t* xout; const float* gate; bf16_t* xs; const float* cs; float* rowss; float gscale;
    __device__ __forceinline__ void operator()(const f32x4 (&acc)[2][2][4][2], const Unit& u, int wr, int wc, int fr, int fq) const {
        const int row0 = u.pm * BM + wr * 64 + fr, b = u.pm >> 5, col0 = u.pn * BM + wc * 32 + 8 * fq;
        const float gsc = gscale;
#pragma unroll
        for (int bj = 0; bj < 2; ++bj) {
            const int c = col0 + bj * HALF;
            u32x4 xr[1][2][4];
#pragma unroll
            for (int ai = 0; ai < 2; ++ai)
#pragma unroll
                for (int m = 0; m < 4; ++m) xr[0][ai][m] = *(const u32x4*)(xin + (size_t)(row0 + ai * HALF + m * 16) * D + c);
            asm volatile("" ::: "memory");
            const f32x4 g0 = *(const f32x4*)(gate + (size_t)b * NADA + c), g1 = *(const f32x4*)(gate + (size_t)b * NADA + c + 4);
            const float gv[8] = {g0[0] * gsc, g0[1] * gsc, g0[2] * gsc, g0[3] * gsc, g1[0] * gsc, g1[1] * gsc, g1[2] * gsc, g1[3] * gsc};
            float cv[8];
            if (XS) { const f32x4 c0 = *(const f32x4*)(cs + (size_t)b * D + c), c1 = *(const f32x4*)(cs + (size_t)b * D + c + 4);
                cv[0] = c0[0]; cv[1] = c0[1]; cv[2] = c0[2]; cv[3] = c0[3]; cv[4] = c1[0]; cv[5] = c1[1]; cv[6] = c1[2]; cv[7] = c1[3]; }
#pragma unroll
            for (int ai = 0; ai < 2; ++ai)
#pragma unroll
                for (int m = 0; m < 4; ++m) {
                    const int row = row0 + ai * HALF + m * 16; const size_t off = (size_t)row * D + c;
                    const u32x4 a = xr[0][ai][m];
                    const f32x4 a0 = acc[ai][bj][m][0], a1 = acc[ai][bj][m][1];
                    float v[8] = {bflo(a.x) + gv[0] * a0[0], bfhi(a.x) + gv[1] * a0[1], bflo(a.y) + gv[2] * a0[2], bfhi(a.y) + gv[3] * a0[3],
                                  bflo(a.z) + gv[4] * a1[0], bfhi(a.z) + gv[5] * a1[1], bflo(a.w) + gv[6] * a1[2], bfhi(a.w) + gv[7] * a1[3]};
                    float ss = 0.f;
#pragma unroll
                    for (int j = 0; j < 8; ++j) ss += v[j] * v[j];
                    u32x4 w; w.x = cvt_pk_bf16(v[0], v[1]); w.y = cvt_pk_bf16(v[2], v[3]); w.z = cvt_pk_bf16(v[4], v[5]); w.w = cvt_pk_bf16(v[6], v[7]);
                    *(u32x4*)(xout + off) = w;
                    if (XS) { u32x4 w2; w2.x = cvt_pk_bf16(v[0] * cv[0], v[1] * cv[1]); w2.y = cvt_pk_bf16(v[2] * cv[2], v[3] * cv[3]); w2.z = cvt_pk_bf16(v[4] * cv[4], v[5] * cv[5]); w2.w = cvt_pk_bf16(v[6] * cv[6], v[7] * cv[7]);
                        *(u32x4*)(xs + off) = w2; }
                    ss += __shfl_xor(ss, 16); ss += __shfl_xor(ss, 32);
                    if (fq == 0) rowss[(size_t)row * 32 + (u.pn * 4 + wc) * 2 + bj] = ss;
                }
            asm volatile("" ::: "memory");
        }
    }
};

struct EpiIn {
    static constexpr bool PERM = true, AFTER_DRAIN = false, HAS_MID = false;
    const float* rowss; const float* bias; bf16_t* q; bf16_t* k; bf16_t* v; bf16_t* ssmA; unsigned char* sga; unsigned char* sgs; float* kmeanp; PG8_LAS float* rnb;
    __device__ __forceinline__ void operator()(const f32x4 (&acc)[2][2][4][2], const Unit& u, int wr, int wc, int fr, int fq) const {
        const int row0 = u.pm * BM + wr * 64 + fr, b = u.pm >> 5, nb = u.pm & 31;
        const int c0 = u.pn * BM + wc * 32 + 8 * fq;
        const int region = u.pn >> 1;
        f32x4 bv[2][2];
#pragma unroll
        for (int bj = 0; bj < 2; ++bj)
#pragma unroll
            for (int n = 0; n < 2; ++n) bv[bj][n] = *(const f32x4*)(bias + (size_t)b * NIN + c0 + bj * HALF + 4 * n);
        float cs[2][8];
#pragma unroll
        for (int bj = 0; bj < 2; ++bj)
#pragma unroll
            for (int j = 0; j < 8; ++j) cs[bj][j] = 0.f;
        PG8_LAS float* rn = rnb + (wr * 4 + wc) * 128;
        stage_rnorm(rowss, u.pm, wr, fq * 16 + fr, rn);
#pragma unroll
        for (int ai = 0; ai < 2; ++ai)
#pragma unroll
            for (int m = 0; m < 4; ++m) {
                const int row = row0 + ai * HALF + m * 16;
                const float r = rn[ai * 64 + m * 16 + fr];
#pragma unroll
                for (int bj = 0; bj < 2; ++bj) {
                    const f32x4 v0 = acc[ai][bj][m][0] * r + bv[bj][0], v1 = acc[ai][bj][m][1] * r + bv[bj][1];
                    float o[8] = {v0[0], v0[1], v0[2], v0[3], v1[0], v1[1], v1[2], v1[3]};
                    const int c = c0 + bj * HALF;
                    bf16_t* dst;
                    if (region == 0) {
#pragma unroll
                        for (int j = 0; j < 8; ++j) o[j] *= QSCALE;
                        dst = q + (size_t)row * AW + c;
                    } else if (region == 1) {
#pragma unroll
                        for (int j = 0; j < 8; ++j) cs[bj][j] += o[j];
                        dst = k + (size_t)row * AW + (c - 512);
                    } else if (region == 2) {
                        dst = v + (size_t)row * AW + (c - 1024);
                    } else if (region == 3) {
                        const int cc = c - 1536, gidx = cc >> 4, ch = cc & 15, t = row & (SEQ - 1);
                        dst = ssmA + ((size_t)(gidx * 1024 + b * NCH + (t >> 5)) * KSSM + (t & 31) * SC + ch);
                    } else {
                        unsigned qv[8];
#pragma unroll
                        for (int j = 0; j < 8; ++j) { const unsigned t_ = (unsigned)(sigmoidf_(o[j]) * 256.0f); qv[j] = t_ > 255u ? 255u : t_; }
                        v2u w8; w8.x = qv[0] | (qv[1] << 8) | (qv[2] << 16) | (qv[3] << 24); w8.y = qv[4] | (qv[5] << 8) | (qv[6] << 16) | (qv[7] << 24);
                        unsigned char* g8 = (region < 6) ? sga + (size_t)row * D + (c - 2048) : sgs + (size_t)row * D + (c - 3072);
                        *(v2u*)g8 = w8;
                        continue;
                    }
                    u32x4 w; w.x = cvt_pk_bf16(o[0], o[1]); w.y = cvt_pk_bf16(o[2], o[3]); w.z = cvt_pk_bf16(o[4], o[5]); w.w = cvt_pk_bf16(o[6], o[7]);
                    *(u32x4*)dst = w;
                }
            }
        if (region == 1) {
#pragma unroll
            for (int bj = 0; bj < 2; ++bj)
#pragma unroll
                for (int j = 0; j < 8; ++j) { float s = cs[bj][j]; s += __shfl_xor(s, 1); s += __shfl_xor(s, 2); s += __shfl_xor(s, 4); s += __shfl_xor(s, 8); cs[bj][j] = s; }
            if (fr == 0) {
#pragma unroll
                for (int bj = 0; bj < 2; ++bj) {
                    float* dstp = kmeanp + ((size_t)((b * NBLK + nb) * 2 + wr) * AW + (c0 + bj * HALF - 512));
                    *(f32x4*)dstp = (f32x4){cs[bj][0], cs[bj][1], cs[bj][2], cs[bj][3]}; *(f32x4*)(dstp + 4) = (f32x4){cs[bj][4], cs[bj][5], cs[bj][6], cs[bj][7]};
                }
            }
        }
    }
};

struct EpiGlu {
    static constexpr bool PERM = true, AFTER_DRAIN = false, HAS_MID = false;
    const bf16_t* y1; const float* bglu; bf16_t* yssm;
    __device__ __forceinline__ void operator()(const f32x4 (&acc)[2][2][4][2], const Unit& u, int wr, int wc, int fr, int fq) const {
        const int row0 = u.pm * BM + wr * 64 + fr, c0 = u.pn * BM + wc * 32 + 8 * fq;
        f32x4 bv[2][2];
#pragma unroll
        for (int bj = 0; bj < 2; ++bj)
#pragma unroll
            for (int n = 0; n < 2; ++n) bv[bj][n] = *(const f32x4*)(bglu + c0 + bj * HALF + 4 * n);
#pragma unroll
        for (int ai = 0; ai < 2; ++ai)
#pragma unroll
            for (int m = 0; m < 4; ++m) {
                const int row = row0 + ai * HALF + m * 16;
#pragma unroll
                for (int bj = 0; bj < 2; ++bj) {
                    const size_t off = (size_t)row * SW + c0 + bj * HALF;
                    const u32x4 yv = *(const u32x4*)(y1 + off);
                    const f32x4 z0 = acc[ai][bj][m][0] + bv[bj][0], z1 = acc[ai][bj][m][1] + bv[bj][1];
                    float o[8];
                    o[0] = bflo(yv.x) * sigmoidf_(z0[0]); o[1] = bfhi(yv.x) * sigmoidf_(z0[1]); o[2] = bflo(yv.y) * sigmoidf_(z0[2]); o[3] = bfhi(yv.y) * sigmoidf_(z0[3]);
                    o[4] = bflo(yv.z) * sigmoidf_(z1[0]); o[5] = bfhi(yv.z) * sigmoidf_(z1[1]); o[6] = bflo(yv.w) * sigmoidf_(z1[2]); o[7] = bfhi(yv.w) * sigmoidf_(z1[3]);
                    u32x4 w; w.x = cvt_pk_bf16(o[0], o[1]); w.y = cvt_pk_bf16(o[2], o[3]); w.z = cvt_pk_bf16(o[4], o[5]); w.w = cvt_pk_bf16(o[6], o[7]);
                    *(u32x4*)(yssm + off) = w;
                }
            }
    }
};

__device__ __forceinline__ float gq(unsigned w, int i) { return (float)((w >> (8 * i)) & 255u) + 0.5f; }
struct EpiMerge {
    static constexpr bool PERM = true, AFTER_DRAIN = false, HAS_MID = true;
    const unsigned char* sga; const unsigned char* sgs; bf16_t* merged;
    __device__ __forceinline__ void mid(f32x4 (&acc)[2][2][4][2], const Unit& u, int wr, int wc, int fr, int fq) const {
        int row0 = u.pm * BM + wr * 64 + fr, c0 = u.pn * BM + wc * 32 + 8 * fq;
        asm volatile("" : "+v"(row0), "+v"(c0));
        v2u av[2][4][2], sv[2][4][2];
#pragma unroll
        for (int ai = 0; ai < 2; ++ai)
#pragma unroll
            for (int m = 0; m < 4; ++m)
#pragma unroll
                for (int bj = 0; bj < 2; ++bj) { const size_t off = (size_t)(row0 + ai * HALF + m * 16) * D + c0 + bj * HALF; av[ai][m][bj] = *(const v2u*)(sga + off); sv[ai][m][bj] = *(const v2u*)(sgs + off); }
        asm volatile("" ::: "memory");
#pragma unroll
        for (int ai = 0; ai < 2; ++ai)
#pragma unroll
            for (int m = 0; m < 4; ++m)
#pragma unroll
                for (int bj = 0; bj < 2; ++bj) {
                    const v2u a = av[ai][m][bj], sq = sv[ai][m][bj];
                    f32x4 r0, r1;
#pragma unroll
                    for (int j = 0; j < 4; ++j) { r0[j] = gq(a.x, j) * fast_rcp(gq(sq.x, j)); r1[j] = gq(a.y, j) * fast_rcp(gq(sq.y, j)); }
                    acc[ai][bj][m][0] *= r0; acc[ai][bj][m][1] *= r1;
                }
    }
    __device__ __forceinline__ void operator()(const f32x4 (&acc)[2][2][4][2], const Unit& u, int wr, int wc, int fr, int fq) const {
        const int row0 = u.pm * BM + wr * 64 + fr, c0 = u.pn * BM + wc * 32 + 8 * fq;
        v2u sv[2][4][2];
#pragma unroll
        for (int ai = 0; ai < 2; ++ai)
#pragma unroll
            for (int m = 0; m < 4; ++m)
#pragma unroll
                for (int bj = 0; bj < 2; ++bj) sv[ai][m][bj] = *(const v2u*)(sgs + (size_t)(row0 + ai * HALF + m * 16) * D + c0 + bj * HALF);
        asm volatile("" ::: "memory");
        const float sc = 1.0f / 256.0f;
#pragma unroll
        for (int ai = 0; ai < 2; ++ai)
#pragma unroll
            for (int m = 0; m < 4; ++m)
#pragma unroll
                for (int bj = 0; bj < 2; ++bj) {
                    const size_t off = (size_t)(row0 + ai * HALF + m * 16) * D + c0 + bj * HALF;
                    const v2u sq = sv[ai][m][bj];
                    const f32x4 v0 = acc[ai][bj][m][0] * sc, v1 = acc[ai][bj][m][1] * sc;
                    u32x4 w; w.x = cvt_pk_bf16(v0[0] * gq(sq.x, 0), v0[1] * gq(sq.x, 1)); w.y = cvt_pk_bf16(v0[2] * gq(sq.x, 2), v0[3] * gq(sq.x, 3));
                    w.z = cvt_pk_bf16(v1[0] * gq(sq.y, 0), v1[1] * gq(sq.y, 1)); w.w = cvt_pk_bf16(v1[2] * gq(sq.y, 2), v1[3] * gq(sq.y, 3));
                    *(u32x4*)(merged + off) = w;
                }
    }
};

struct EpiSsmState {
    static constexpr bool PERM = false, AFTER_DRAIN = true, HAS_MID = false;
    bf16_t* ssmA; const float* lam_re; const float* lam_im; const float* log_dt;
    __device__ __forceinline__ void fused(f32x4 (&acc)[2][2][4][2], const Unit& u, int wr, int wc, int fr, int fq, PG8_LAS unsigned char* lds, int wid, int lane) const {
        PG8_LAS float* X = (PG8_LAS float*)lds;
        PG8_LAS float* Eb = (PG8_LAS float*)(lds + 135168);
#pragma unroll
        for (int ai = 0; ai < 2; ++ai)
#pragma unroll
            for (int m = 0; m < 4; ++m)
#pragma unroll
                for (int n = 0; n < 2; ++n) *(PG8_LAS f32x4*)(X + (ai * HALF + wr * 64 + m * 16 + fr) * 132 + wc * 32 + n * 16 + 4 * fq) = acc[ai][0][m][n];
        asm volatile("s_waitcnt lgkmcnt(0)" ::: "memory"); __builtin_amdgcn_s_barrier(); asm volatile("" ::: "memory");
        const int g = u.pn, p = lane, seg = wid;
        const float lr = lam_re[g * SP + p], li = lam_im[g * SP + p], dt = __expf(log_dt[g]);
        float ar, ai_; { float sn, cs; __sincosf(li * dt, &sn, &cs); const float mg = __expf(lr * dt); ar = mg * cs; ai_ = mg * sn; }
        float sr = ar, si = ai_;
#pragma unroll
        for (int q = 0; q < 5; ++q) { const float t0 = sr * sr - si * si, t1 = 2.f * sr * si; sr = t0; si = t1; }
        const float aLr = sr, aLi = si;
#pragma unroll
        for (int q = 0; q < 5; ++q) { const float t0 = sr * sr - si * si, t1 = 2.f * sr * si; sr = t0; si = t1; }
        const float aSr = sr, aSi = si;
        const PG8_LAS float* Xs = X + (seg * 32) * 132 + p;
        float er = 0.f, ei = 0.f;
#pragma unroll 8
        for (int r = 0; r < 32; ++r) { const float xr = Xs[r * 132], xi = Xs[r * 132 + 64]; const float nr = aLr * er - aLi * ei + xr, ni = aLr * ei + aLi * er + xi; er = nr; ei = ni; }
        Eb[(seg * 64 + p) * 2] = er; Eb[(seg * 64 + p) * 2 + 1] = ei;
        asm volatile("s_waitcnt lgkmcnt(0)" ::: "memory"); __builtin_amdgcn_s_barrier(); asm volatile("" ::: "memory");
        float cr = 0.f, ci = 0.f;
        for (int s2 = 0; s2 < seg; ++s2) { const float xr = Eb[(s2 * 64 + p) * 2], xi = Eb[(s2 * 64 + p) * 2 + 1]; const float nr = aSr * cr - aSi * ci + xr, ni = aSr * ci + aSi * cr + xi; cr = nr; ci = ni; }
        bf16_t* dst = ssmA + ((size_t)(u.pm * BM + seg * 32) * KSSM + 512 + p);
#pragma unroll 8
        for (int r = 0; r < 32; ++r) {
            dst[(size_t)r * KSSM] = (bf16_t)f2bf(cr); dst[(size_t)r * KSSM + 64] = (bf16_t)f2bf(ci);
            const float xr = Xs[r * 132], xi = Xs[r * 132 + 64]; const float nr = aLr * cr - aLi * ci + xr, ni = aLr * ci + aLi * cr + xi; cr = nr; ci = ni;
        }
        asm volatile("s_waitcnt lgkmcnt(0)" ::: "memory"); __builtin_amdgcn_s_barrier(); asm volatile("" ::: "memory");
    }
};

struct EpiSsmMain {
    static constexpr bool PERM = true, AFTER_DRAIN = false, HAS_MID = false;
    const bf16_t* ssmA; const float* dsk; bf16_t* y1;
    __device__ __forceinline__ void operator()(const f32x4 (&acc)[2][2][4][2], const Unit& u, int wr, int wc, int fr, int fq) const {
        const int g = u.pn >> 1, b = u.pm & 3, cbase = (u.pn & 1) * BM + wc * 32 + 8 * fq;
        const int rloc0 = wr * 64 + fr;
#pragma unroll
        for (int bj = 0; bj < 2; ++bj) {
            const int c = cbase + bj * HALF, s = c >> 4, ch0 = c & 15;
            const f32x4 d0 = *(const f32x4*)(dsk + g * SC + ch0), d1 = *(const f32x4*)(dsk + g * SC + ch0 + 4);
#pragma unroll
            for (int ai = 0; ai < 2; ++ai)
#pragma unroll
                for (int m = 0; m < 4; ++m) {
                    const int rloc = rloc0 + ai * HALF + m * 16;
                    const u32x4 uv = *(const u32x4*)(ssmA + (size_t)(u.pm * BM + rloc) * KSSM + c);
                    const f32x4 v0 = acc[ai][bj][m][0], v1 = acc[ai][bj][m][1];
                    float o[8];
                    o[0] = v0[0] + d0[0] * bflo(uv.x); o[1] = v0[1] + d0[1] * bfhi(uv.x); o[2] = v0[2] + d0[2] * bflo(uv.y); o[3] = v0[3] + d0[3] * bfhi(uv.y);
                    o[4] = v1[0] + d1[0] * bflo(uv.z); o[5] = v1[1] + d1[1] * bfhi(uv.z); o[6] = v1[2] + d1[2] * bflo(uv.w); o[7] = v1[3] + d1[3] * bfhi(uv.w);
#pragma unroll
                    for (int j = 0; j < 8; ++j) o[j] = gelu_tanh(o[j]);
                    u32x4 w; w.x = cvt_pk_bf16(o[0], o[1]); w.y = cvt_pk_bf16(o[2], o[3]); w.z = cvt_pk_bf16(o[4], o[5]); w.w = cvt_pk_bf16(o[6], o[7]);
                    *(u32x4*)(y1 + (size_t)(b * SEQ + rloc * SL + s) * SW + g * SC + ch0) = w;
                }
        }
    }
};
}


#define XB_TMO      128
#define XB_XCNT(j)  (256  + 64 * (j))
#define XB_XSUB(j)  (1280 + 64 * (j))
#define XB_XGEN(j)  (2304 + 64 * (j))
#define XB_TOP      3328
#define XB_TOPGEN   3392
#define XCD_BAR_WORDS 3456
#define XB_SPIN_CAP (1u << 20)

__device__ __forceinline__ unsigned xb_ld(unsigned* p)              { return __hip_atomic_load(p, __ATOMIC_RELAXED, __HIP_MEMORY_SCOPE_AGENT); }
__device__ __forceinline__ unsigned xb_add(unsigned* p, unsigned v) { return __hip_atomic_fetch_add(p, v, __ATOMIC_RELAXED, __HIP_MEMORY_SCOPE_AGENT); }
__device__ __forceinline__ unsigned xb_xcc_id() { return (unsigned)__builtin_amdgcn_s_getreg((3 << 11) | 20) & 0xFu; }
#define XB_SPIN(cond, bar) do { unsigned _sp = 0; while (cond) { __builtin_amdgcn_s_sleep(1); \
    if ((++_sp & 255u) == 0u) { if (xb_ld(&(bar)[XB_TMO])) break; if (_sp > XB_SPIN_CAP) { atomicAdd(&(bar)[XB_TMO], 1u); break; } } } } while (0)

struct XcdBarrier { unsigned* bar; unsigned x; volatile LAS unsigned* st; };
__device__ __forceinline__ XcdBarrier xcd_barrier_post(unsigned* bar, volatile LAS unsigned* st) {
    XcdBarrier b; b.bar = bar; b.x = xb_xcc_id(); b.st = st;
    if (threadIdx.x == 0) (void)xb_add(&bar[XB_XCNT(b.x)], 1u);
    return b;
}
__device__ __forceinline__ void xcd_barrier_complete(unsigned* bar, unsigned x, unsigned& nloc, unsigned& nx) {
    const unsigned G = gridDim.x * gridDim.y * gridDim.z;
    unsigned sum, cnt, mine, sp = 0u;
    for (;;) {
        sum = 0u; cnt = 0u; mine = 0u;
#pragma unroll
        for (unsigned j = 0; j < 16; ++j) { const unsigned c = xb_ld(&bar[XB_XCNT(j)]); sum += c; cnt += (c > 0u) ? 1u : 0u; mine = (j == x) ? c : mine; }
        if (sum == G) break;
        __builtin_amdgcn_s_sleep(1);
        if ((++sp & 255u) == 0u) { if (xb_ld(&bar[XB_TMO])) break; if (sp > XB_SPIN_CAP) { atomicAdd(&bar[XB_TMO], 1u); break; } }
    }
    nloc = mine > 0u ? mine : 1u; nx = cnt > 0u ? cnt : 1u;
}
__device__ __forceinline__ void xcd_barrier(const XcdBarrier& b) {
    asm volatile("s_waitcnt vmcnt(0)" ::: "memory");
    __syncthreads();
    if (threadIdx.x == 0) {
        unsigned* bar = b.bar;
        __builtin_amdgcn_s_waitcnt(0);
        unsigned nloc = b.st[0], nx = b.st[1];
        if (nloc == 0u) { xcd_barrier_complete(bar, b.x, nloc, nx); b.st[0] = nloc; b.st[1] = nx; }
        const unsigned old = xb_add(&bar[XB_XSUB(b.x)], 1u);
        const unsigned gen = old / nloc;
        if (old + 1u == (gen + 1u) * nloc) {
            __builtin_amdgcn_fence(__ATOMIC_RELEASE, "agent");
            asm volatile("s_waitcnt vmcnt(0)" ::: "memory");
            const unsigned og = xb_add(&bar[XB_TOP], 1u);
            const unsigned tg = og / nx;
            if (og + 1u == (tg + 1u) * nx) xb_add(&bar[XB_TOPGEN], 1u);
            else XB_SPIN(xb_ld(&bar[XB_TOPGEN]) == tg, bar);
            __builtin_amdgcn_fence(__ATOMIC_ACQUIRE, "agent");
            xb_add(&bar[XB_XGEN(b.x)], 1u);
            asm volatile("s_waitcnt vmcnt(0)" ::: "memory");
        } else {
            XB_SPIN(xb_ld(&bar[XB_XGEN(b.x)]) == gen, bar);
            __builtin_amdgcn_fence(__ATOMIC_ACQUIRE, "agent");
            asm volatile("s_waitcnt vmcnt(0)" ::: "memory");
        }
    }
    __syncthreads();
}

struct Frame {
    LAS unsigned char* lds;
    volatile LAS unsigned* MISC;
    gu32* ctl;
    int tid, lane, wave, vcu, G;
    unsigned char* ws;
    const float* in[26];
    float* out;
};
enum { IN_X = 0, IN_C, IN_WADA, IN_BADA, IN_NFFN1, IN_WFFN1IN, IN_WFFN1OUT, IN_NMIX, IN_WIN, IN_LAMRE, IN_LAMIM, IN_LOGDT, IN_BRE, IN_BIM, IN_CRE, IN_CIM, IN_SSMD,
       IN_WGLU, IN_BGLU, IN_WBRATT, IN_WBRSSM, IN_WOUT, IN_NFFN2, IN_WFFN2IN, IN_WFFN2OUT, IN_NFINAL };

__device__ __forceinline__ int gu_row(int n) { return n < FF ? ((n >> 7) << 8) + (n & 127) : (((n - FF) >> 7) << 8) + 128 + ((n - FF) & 127); }
__device__ __forceinline__ void p0_transpose_item(const float* W, int K, int N, bf16* WT, int mode, LAS float* scr, int item, int lane) {
    const int nblk = N / 32, kb = item / nblk, nb = item % nblk, k0 = 64 * kb, n0 = 32 * nb;
    const int r0 = mode ? gu_row(n0) : n0;
#pragma unroll 8
    for (int i = 0; i < 32; ++i) { const int kk = 2 * i + (lane >> 5); scr[kk * 33 + (lane & 31)] = W[(size_t)(k0 + kk) * N + n0 + (lane & 31)]; }
    LDS_WAIT(); asm volatile("" ::: "memory");
    const int c = lane & 7;
#pragma unroll
    for (int j = 0; j < 4; ++j) { const int n = (lane >> 3) + 8 * j; const LAS float* s = scr + (8 * c) * 33 + n;
        v4u o; o.x = pk2(s[0 * 33], s[1 * 33]); o.y = pk2(s[2 * 33], s[3 * 33]); o.z = pk2(s[4 * 33], s[5 * 33]); o.w = pk2(s[6 * 33], s[7 * 33]);
        *(GAS v4u*)(WT + (size_t)(r0 + n) * K + k0 + 8 * c) = o; }
    LDS_WAIT(); asm volatile("" ::: "memory");
}

__device__ __forceinline__ void ssm_lane_params(const Frame& F, int g, int p, float& lr_dt, float& li_dt, float& fr, float& fi) {
    const float lr = F.in[IN_LAMRE][g * SP + p], li = F.in[IN_LAMIM][g * SP + p], dt = __expf(F.in[IN_LOGDT][g]);
    lr_dt = lr * dt; li_dt = li * dt;
    float sn, cs; __sincosf(li_dt, &sn, &cs); const float mg = __expf(lr_dt);
    const float nr = mg * cs - 1.0f, ni = mg * sn, den = lr * lr + li * li;
    fr = (nr * lr + ni * li) / den; fi = (ni * lr - nr * li) / den;
}
__device__ __forceinline__ void cpow(float lr_dt, float li_dt, float n, float& pr, float& pi) { float sn, cs; __sincosf(li_dt * n, &sn, &cs); const float mg = __expf(lr_dt * n); pr = mg * cs; pi = mg * sn; }

__device__ __forceinline__ void p0_ssm_kmat_item(const Frame& F, int item, LAS float* scr) {
    const int g = item / 63, lag = item % 63 - 31, lane = F.lane;
    bf16* Bm = (bf16*)(F.ws + WS_BM) + (size_t)g * 512 * KSSM;
    const int co = lane >> 2, ci0 = (lane & 3) * 4;
    float k0 = 0.f, k1 = 0.f, k2 = 0.f, k3 = 0.f;
    if (lag >= 0) {
        LAS float* Dre = scr; LAS float* Dim = scr + 1024; LAS float* Cre = scr + 2048; LAS float* Cim = scr + 3072;
        float lr_dt, li_dt, fr, fi; ssm_lane_params(F, g, lane, lr_dt, li_dt, fr, fi);
        float pr, pi; cpow(lr_dt, li_dt, (float)lag, pr, pi);
#pragma unroll
        for (int c = 0; c < 16; c += 4) {
            f32x4 dr, di, cr4, ci4;
#pragma unroll
            for (int e = 0; e < 4; ++e) {
                const float br = F.in[IN_BRE][(g * SP + lane) * SC + c + e], bi = F.in[IN_BIM][(g * SP + lane) * SC + c + e];
                const float bbr = fr * br - fi * bi, bbi = fr * bi + fi * br;
                dr[e] = pr * bbr - pi * bbi; di[e] = pr * bbi + pi * bbr;
                cr4[e] = F.in[IN_CRE][(g * SC + c + e) * SP + lane]; ci4[e] = F.in[IN_CIM][(g * SC + c + e) * SP + lane];
            }
            *(LAS f32x4*)(Dre + lane * 16 + c) = dr; *(LAS f32x4*)(Dim + lane * 16 + c) = di; *(LAS f32x4*)(Cre + lane * 16 + c) = cr4; *(LAS f32x4*)(Cim + lane * 16 + c) = ci4;
        }
        LDS_WAIT(); asm volatile("" ::: "memory");
#pragma unroll 4
        for (int p = 0; p < 64; ++p) {
            const float cr = Cre[p * 16 + co], cim = Cim[p * 16 + co];
            const f32x4 dr = *(const LAS f32x4*)(Dre + p * 16 + ci0), di = *(const LAS f32x4*)(Dim + p * 16 + ci0);
            k0 += cr * dr[0] - cim * di[0]; k1 += cr * dr[1] - cim * di[1]; k2 += cr * dr[2] - cim * di[2]; k3 += cr * dr[3] - cim * di[3];
        }
        LDS_WAIT(); asm volatile("" ::: "memory");
    }
    const unsigned long long w = (unsigned long long)pk2(k0, k1) | ((unsigned long long)pk2(k2, k3) << 32);
    const int alag = lag < 0 ? -lag : lag;
    for (int i = 0; i < 32 - alag; ++i) { const int sI = lag >= 0 ? i + lag : i, tI = lag >= 0 ? i : i + alag;
        *(GAS unsigned long long*)(Bm + (size_t)(sI * 16 + co) * KSSM + tI * 16 + ci0) = w; }
}
__device__ __forceinline__ void p0_ssm_vs_item(const Frame& F, int item) {
    const int g = item >> 5, s = item & 31, p = F.lane;
    float lr_dt, li_dt, fr, fi; ssm_lane_params(F, g, p, lr_dt, li_dt, fr, fi);
    {
        float pr, pi; cpow(lr_dt, li_dt, (float)(s + 1), pr, pi);
        bf16* Bm = (bf16*)(F.ws + WS_BM) + (size_t)g * 512 * KSSM;
#pragma unroll
        for (int co = 0; co < 16; ++co) {
            const float cr = F.in[IN_CRE][(g * SC + co) * SP + p], ci = F.in[IN_CIM][(g * SC + co) * SP + p];
            bf16* row = Bm + (size_t)(s * 16 + co) * KSSM + 512;
            row[p] = (bf16)f2bf(cr * pr - ci * pi); row[64 + p] = (bf16)f2bf(-(cr * pi + ci * pr));
        }
    }
    {
        float pr, pi; cpow(lr_dt, li_dt, (float)(31 - s), pr, pi);
        bf16* Bs = (bf16*)(F.ws + WS_BS) + (size_t)g * 256 * 512;
        unsigned wr_[8], wi_[8];
#pragma unroll
        for (int c = 0; c < 16; c += 2) {
            float vr[2], vi[2];
#pragma unroll
            for (int e = 0; e < 2; ++e) { const float br = F.in[IN_BRE][(g * SP + p) * SC + c + e], bi = F.in[IN_BIM][(g * SP + p) * SC + c + e];
                const float bbr = fr * br - fi * bi, bbi = fr * bi + fi * br; vr[e] = pr * bbr - pi * bbi; vi[e] = pr * bbi + pi * bbr; }
            wr_[c >> 1] = pk2(vr[0], vr[1]); wi_[c >> 1] = pk2(vi[0], vi[1]);
        }
        GAS v4u* d0 = (GAS v4u*)(Bs + (size_t)p * 512 + s * 16); GAS v4u* d1 = (GAS v4u*)(Bs + (size_t)(64 + p) * 512 + s * 16);
        GAS v4u* z0 = (GAS v4u*)(Bs + (size_t)(128 + p) * 512 + s * 16); GAS v4u* z1 = (GAS v4u*)(Bs + (size_t)(192 + p) * 512 + s * 16);
        d0[0] = (v4u){wr_[0], wr_[1], wr_[2], wr_[3]}; d0[1] = (v4u){wr_[4], wr_[5], wr_[6], wr_[7]};
        d1[0] = (v4u){wi_[0], wi_[1], wi_[2], wi_[3]}; d1[1] = (v4u){wi_[4], wi_[5], wi_[6], wi_[7]};
        z0[0] = (v4u){0u, 0u, 0u, 0u}; z0[1] = (v4u){0u, 0u, 0u, 0u}; z1[0] = (v4u){0u, 0u, 0u, 0u}; z1[1] = (v4u){0u, 0u, 0u, 0u};
    }
}

__device__ __forceinline__ void p0_prologue(Frame& F) {
    LAS float* sl = (LAS float*)(F.lds + SILU_OFF);
    for (int i = F.tid; i < BATCH * D; i += NWAVES * 64) sl[i] = siluf_(F.in[IN_C][i]);
    __syncthreads();
    LAS float* scr = (LAS float*)(F.lds + RING_OFF + F.wave * 16384);
    const int gw = F.vcu * NWAVES + F.wave, NGW = F.G * NWAVES;
    bf16* ws16 = (bf16*)F.ws;
    constexpr int I_ADA = NADA / 64;
    constexpr int I_UP = (D / 64) * (NGU / 32), I_DN = (FF / 64) * (D / 32), I_IN = (D / 64) * (NIN / 32), I_GLU = (SW / 64) * (SW / 32), I_BR = (AW / 64) * (D / 32), I_OUT = (D / 64) * (D / 32);
    constexpr int I_KM = SG * 63, I_VS = SG * 32;
    constexpr int NITEMS = I_ADA + I_KM + I_VS + 2 * I_UP + 2 * I_DN + I_IN + I_GLU + 2 * I_BR + I_OUT;
    for (int it = gw; it < NITEMS; it += NGW) {
        int r = it;
        if (r < I_ADA) {
            const int n = r * 64 + F.lane; const float* W = F.in[IN_WADA] + n;
            float a0 = 0.f, a1 = 0.f, a2 = 0.f, a3 = 0.f;
#pragma unroll 2
            for (int k = 0; k < D; k += 4) {
                const f32x4 s0 = *(const LAS f32x4*)(sl + k), s1 = *(const LAS f32x4*)(sl + D + k), s2 = *(const LAS f32x4*)(sl + 2 * D + k), s3 = *(const LAS f32x4*)(sl + 3 * D + k);
#pragma unroll
                for (int i = 0; i < 4; ++i) { const float w = W[(size_t)(k + i) * NADA]; a0 += s0[i] * w; a1 += s1[i] * w; a2 += s2[i] * w; a3 += s3[i] * w; }
            }
            float* ada = (float*)(F.ws + WS_ADA); const float bb = F.in[IN_BADA][n];
            ada[n] = a0 + bb; ada[NADA + n] = a1 + bb; ada[2 * NADA + n] = a2 + bb; ada[3 * NADA + n] = a3 + bb;
            continue;
        }
        r -= I_ADA;
        if (r < I_KM) { p0_ssm_kmat_item(F, r, scr); continue; } r -= I_KM;
        if (r < I_VS) { p0_ssm_vs_item(F, r); continue; } r -= I_VS;
        if (r < I_UP) { p0_transpose_item(F.in[IN_WFFN1IN], D, NGU, ws16 + WS_W1T / 2, 1, scr, r, F.lane); continue; } r -= I_UP;
        if (r < I_UP) { p0_transpose_item(F.in[IN_WFFN2IN], D, NGU, ws16 + WS_W3T / 2, 1, scr, r, F.lane); continue; } r -= I_UP;
        if (r < I_DN) { p0_transpose_item(F.in[IN_WFFN1OUT], FF, D, ws16 + WS_W2T / 2, 0, scr, r, F.lane); continue; } r -= I_DN;
        if (r < I_DN) { p0_transpose_item(F.in[IN_WFFN2OUT], FF, D, ws16 + WS_W4T / 2, 0, scr, r, F.lane); continue; } r -= I_DN;
        if (r < I_IN) { p0_transpose_item(F.in[IN_WIN], D, NIN, ws16 + WS_WINT / 2, 0, scr, r, F.lane); continue; } r -= I_IN;
        if (r < I_GLU) { p0_transpose_item(F.in[IN_WGLU], SW, SW, ws16 + WS_WGLU / 2, 0, scr, r, F.lane); continue; } r -= I_GLU;
        if (r < I_BR) { p0_transpose_item(F.in[IN_WBRATT], AW, D, ws16 + WS_WBRA / 2, 0, scr, r, F.lane); continue; } r -= I_BR;
        if (r < I_BR) { p0_transpose_item(F.in[IN_WBRSSM], SW, D, ws16 + WS_WBRS / 2, 0, scr, r, F.lane); continue; } r -= I_BR;
        p0_transpose_item(F.in[IN_WOUT], D, D, ws16 + WS_WOUT / 2, 0, scr, r, F.lane);
    }
}

__device__ __forceinline__ void p1_phase(Frame& F) {
    const int gw = F.vcu * NWAVES + F.wave, NGW = F.G * NWAVES;
    const float* ada = (const float*)(F.ws + WS_ADA);
    for (int i = gw * 64 + F.lane; i < 2 * BATCH * D; i += NGW * 64) {
        const int which = i / (BATCH * D), r = i % (BATCH * D), b = r / D, c = r % D;
        const float gwt = which ? F.in[IN_NFFN2][c] : F.in[IN_NMIX][c];
        const float sc = ada[b * NADA + (which ? 7 : 4) * D + c];
        ((float*)(F.ws + (which ? WS_CS3 : WS_CS2)))[r] = gwt * (1.0f + sc);
    }
    for (int it = gw; it < NIN + NGU; it += NGW) {
        const bool second = it >= NIN; const int n = second ? it - NIN : it;
        const bf16* wrow = (const bf16*)(F.ws + (second ? WS_W3T : WS_WINT)) + (size_t)n * D;
        const float* sh = ada + (second ? 6 : 3) * D;
        float a[4] = {0.f, 0.f, 0.f, 0.f};
#pragma unroll
        for (int j = 0; j < 2; ++j) {
            const int k = 8 * F.lane + 512 * j;
            const v4u w = *(const GAS v4u*)(wrow + k);
            const float wf[8] = {bflo(w.x), bfhi(w.x), bflo(w.y), bfhi(w.y), bflo(w.z), bfhi(w.z), bflo(w.w), bfhi(w.w)};
#pragma unroll
            for (int b = 0; b < 4; ++b) { const f32x4 s0 = *(const f32x4*)(sh + b * NADA + k), s1 = *(const f32x4*)(sh + b * NADA + k + 4);
                a[b] += wf[0] * s0[0] + wf[1] * s0[1] + wf[2] * s0[2] + wf[3] * s0[3] + wf[4] * s1[0] + wf[5] * s1[1] + wf[6] * s1[2] + wf[7] * s1[3]; }
        }
#pragma unroll
        for (int b = 0; b < 4; ++b) a[b] = wave_sum(a[b]);
        if (F.lane == 0) { float* dst = (float*)(F.ws + (second ? WS_BIAS3 : WS_BIAS2)); const int N = second ? NGU : NIN;
#pragma unroll
            for (int b = 0; b < 4; ++b) dst[b * N + n] = a[b]; }
    }
    bf16* h1 = (bf16*)F.out;
    for (int m0 = gw * 4; m0 < T; m0 += NGW * 4) {
        const int b = m0 / SEQ;
        f32x4 v[4][4]; float rstd[4];
#pragma unroll
        for (int q = 0; q < 4; ++q) { const GAS f32x4* xr = (const GAS f32x4*)(F.in[IN_X] + (size_t)(m0 + q) * D) + F.lane;
#pragma unroll
            for (int j = 0; j < 4; ++j) v[q][j] = xr[64 * j]; }
#pragma unroll
        for (int q = 0; q < 4; ++q) { float s = 0.f;
#pragma unroll
            for (int j = 0; j < 4; ++j) s += (v[q][j].x * v[q][j].x + v[q][j].y * v[q][j].y) + (v[q][j].z * v[q][j].z + v[q][j].w * v[q][j].w);
            rstd[q] = __builtin_amdgcn_rsqf(wave_sum(s) * (1.f / D) + EPS); }
#pragma unroll
        for (int j = 0; j < 4; ++j) {
            const int c = 4 * F.lane + 256 * j;
            const f32x4 g = *(const f32x4*)(F.in[IN_NFFN1] + c), sh = *(const f32x4*)(ada + b * NADA + c), sc = *(const f32x4*)(ada + b * NADA + D + c);
            const f32x4 gs = g * (sc + 1.0f);
#pragma unroll
            for (int q = 0; q < 4; ++q) { const f32x4 h = v[q][j] * rstd[q] * gs + sh;
                ((GAS unsigned long long*)(h1 + (size_t)(m0 + q) * D))[F.lane + 64 * j] = (unsigned long long)pk2(h.x, h.y) | ((unsigned long long)pk2(h.z, h.w) << 32);
                ((GAS unsigned long long*)(h1 + (size_t)(T + m0 + q) * D))[F.lane + 64 * j] = (unsigned long long)pk2(v[q][j].x, v[q][j].y) | ((unsigned long long)pk2(v[q][j].z, v[q][j].w) << 32); }
        }
    }
}

__device__ __forceinline__ void final_norm_phase(Frame& F) {
    const int gw = F.vcu * NWAVES + F.wave, NGW = F.G * NWAVES;
    const float* rowss = (const float*)(F.ws + WS_ROWSS);
    const bf16* x3 = (const bf16*)(F.ws + WS_X3);
    const int c0 = 8 * F.lane;
    f32x4 g[2][2];
#pragma unroll
    for (int j = 0; j < 2; ++j) { g[j][0] = *(const f32x4*)(F.in[IN_NFINAL] + c0 + 512 * j); g[j][1] = *(const f32x4*)(F.in[IN_NFINAL] + c0 + 512 * j + 4); }
    for (int m0 = gw * 4; m0 < T; m0 += NGW * 4) {
        float r[4]; v4u xv[4][2];
#pragma unroll
        for (int q = 0; q < 4; ++q) { r[q] = pg8::row_rnorm(rowss, m0 + q);
#pragma unroll
            for (int j = 0; j < 2; ++j) xv[q][j] = *(const GAS v4u*)(x3 + (size_t)(m0 + q) * D + c0 + 512 * j); }
#pragma unroll
        for (int q = 0; q < 4; ++q)
#pragma unroll
            for (int j = 0; j < 2; ++j) {
                const v4u a = xv[q][j]; GAS f32x4* o = (GAS f32x4*)(F.out + (size_t)(m0 + q) * D + c0 + 512 * j);
                o[0] = (f32x4){bflo(a.x), bfhi(a.x), bflo(a.y), bfhi(a.y)} * r[q] * g[j][0];
                o[1] = (f32x4){bflo(a.z), bfhi(a.z), bflo(a.w), bfhi(a.w)} * r[q] * g[j][1];
            }
    }
}

__device__ __forceinline__ void gating_phase(Frame& F, int rep) {
    LAS float* km = (LAS float*)(F.lds + RING_OFF);
    const float* kmeanp = (const float*)(F.ws + WS_KMEANP);
    const bf16* q = (const bf16*)(F.ws + WS_Q);
    unsigned* sel = (unsigned*)(F.ws + WS_SEL);
    constexpr int NITEM = BATCH * NH * (NBLK - 1);
    LAS unsigned* qslot = (LAS unsigned*)(F.lds + 32768);
    for (;;) {
        __syncthreads();
        if (F.tid == 0) qslot[0] = __hip_atomic_fetch_add((unsigned*)(F.ctl + CW_QUEUE + 128 + 64 * rep), 1u, RLX_AGENT);
        __syncthreads();
        const int it = (int)qslot[0];
        if (it >= NITEM) break;
        const int i = 31 - (it >> 5), h = it & 7, b = (it >> 3) & 3;
        for (int e = F.tid; e < i * 64; e += NWAVES * 64) { const int n = e >> 6, d = e & 63;
            km[e] = (kmeanp[(size_t)((b * NBLK + n) * 2 + 0) * AW + h * HD + d] + kmeanp[(size_t)((b * NBLK + n) * 2 + 1) * AW + h * HD + d]) * (1.0f / 256.0f); }
        __syncthreads();
        const int ql = F.lane & 31, half = F.lane >> 5, t = i * MBLK + F.wave * 32 + ql;
        const bf16* qrow = q + (size_t)(b * SEQ + t) * AW + h * HD;
        float qf[64];
#pragma unroll
        for (int c = 0; c < 8; ++c) { const v4u w = *(const GAS v4u*)(qrow + 8 * c);
            qf[8 * c + 0] = bflo(w.x); qf[8 * c + 1] = bfhi(w.x); qf[8 * c + 2] = bflo(w.y); qf[8 * c + 3] = bfhi(w.y); qf[8 * c + 4] = bflo(w.z); qf[8 * c + 5] = bfhi(w.z); qf[8 * c + 6] = bflo(w.w); qf[8 * c + 7] = bfhi(w.w); }
        float v0 = -3e38f, v1 = -3e38f, v2 = -3e38f; int i0 = 255, i1 = 255, i2 = 255;
        for (int n = half; n < i; n += 2) {
            const LAS f32x4* kr = (const LAS f32x4*)(km + n * 64);
            float dot = 0.f;
#pragma unroll
            for (int c = 0; c < 16; ++c) { const f32x4 kv = kr[c]; dot += qf[4 * c] * kv[0] + qf[4 * c + 1] * kv[1] + qf[4 * c + 2] * kv[2] + qf[4 * c + 3] * kv[3]; }
            if (dot > v0) { v2 = v1; i2 = i1; v1 = v0; i1 = i0; v0 = dot; i0 = n; }
            else if (dot > v1) { v2 = v1; i2 = i1; v1 = dot; i1 = n; }
            else if (dot > v2) { v2 = dot; i2 = n; }
        }
        const float ov[3] = {__shfl_xor(v0, 32), __shfl_xor(v1, 32), __shfl_xor(v2, 32)};
        const int oi[3] = {__shfl_xor(i0, 32), __shfl_xor(i1, 32), __shfl_xor(i2, 32)};
#pragma unroll
        for (int k = 0; k < 3; ++k) {
            const float d = ov[k]; const int n = oi[k];
            if (d > v0 || (d == v0 && n < i0)) { v2 = v1; i2 = i1; v1 = v0; i1 = i0; v0 = d; i0 = n; }
            else if (d > v1 || (d == v1 && n < i1)) { v2 = v1; i2 = i1; v1 = d; i1 = n; }
            else if (d > v2 || (d == v2 && n < i2)) { v2 = d; i2 = n; }
        }
        if (half == 0) sel[(size_t)(b * NH + h) * SEQ + t] = (unsigned)i0 | ((unsigned)i1 << 8) | ((unsigned)i2 << 16);
    }
}

namespace att {
typedef float f32x16 __attribute__((ext_vector_type(16)));
typedef short s16x4 __attribute__((ext_vector_type(4)));
typedef short v4i16_t __attribute__((ext_vector_type(4)));
typedef __bf16 bf16x2_t __attribute__((ext_vector_type(2)));
constexpr int ATT_K = 0, ATT_V = 32768, ATT_LIST = 65536, ATT_WS = 81920, ATT_OST = 83968, ATT_CNT = 116736;
__device__ __forceinline__ int crow(int r, int hi) { return (r & 3) + 8 * (r >> 2) + 4 * hi; }
__device__ __forceinline__ unsigned cvtpk(float lo, float hi) { f32x2 v = {lo, hi}; bf16x2_t b = __builtin_convertvector(v, bf16x2_t); return __builtin_bit_cast(unsigned, b); }
__device__ __forceinline__ s16x4 vtr(const LAS unsigned char* p) { return __builtin_bit_cast(s16x4, __builtin_amdgcn_ds_read_tr16_b64_v4i16((LAS v4i16_t*)p)); }
__device__ __forceinline__ float swapmax(float m) { auto rr = __builtin_amdgcn_permlane32_swap(__float_as_uint(m), __float_as_uint(m), false, false); return fmaxf(__uint_as_float(rr[0]), __uint_as_float(rr[1])); }
__device__ __forceinline__ float swapsum(float m) { auto rr = __builtin_amdgcn_permlane32_swap(__float_as_uint(m), __float_as_uint(m), false, false); return __uint_as_float(rr[0]) + __uint_as_float(rr[1]); }

__device__ __forceinline__ void load_kv(Frame& F, int b, int h, int j) {
    const bf16* K = (const bf16*)(F.ws + WS_K); const bf16* V = (const bf16*)(F.ws + WS_V);
    const size_t row0 = (size_t)(b * SEQ + j * MBLK);
#pragma unroll
    for (int kt = 0; kt < 4; ++kt) {
        const bf16* ksrc = K + (row0 + kt * 64 + F.lane) * AW + h * HD + F.wave * 8;
        __builtin_amdgcn_global_load_lds((const unsigned*)ksrc, (LAS unsigned*)(F.lds + ATT_K + kt * 8192 + F.wave * 1024), 16, 0, 0);
        const bf16* vsrc = V + (row0 + kt * 64 + 16 * (F.wave & 3) + (F.lane >> 2)) * AW + h * HD + (F.wave >> 2) * 32 + (F.lane & 3) * 8;
        __builtin_amdgcn_global_load_lds((const unsigned*)vsrc, (LAS unsigned*)(F.lds + ATT_V + kt * 8192 + F.wave * 1024), 16, 0, 0);
    }
}

template <bool CAUSAL>
__device__ __forceinline__ void attn_tile(Frame& F, const bf16x8 (&qr)[4], int reli, float slope2, int nkt, f32x16 (&o)[2], float& m_out, float& l_out) {
    const int lane = F.lane, r32 = lane & 31, hi = lane >> 5;
    LAS float* wsf = (LAS float*)(F.lds + ATT_WS + F.wave * 256);
    float m = -1e30f, l = 0.f;
#pragma unroll
    for (int r = 0; r < 16; ++r) { o[0][r] = 0.f; o[1][r] = 0.f; }
    const float base0 = slope2 * (float)(4 * hi - reli);
    for (int kt = 0; kt < nkt; ++kt) {
        const LAS unsigned char* Ks = F.lds + ATT_K + kt * 8192 + hi * 1024 + r32 * 16;
        f32x16 p0, p1;
        const float bkt = base0 + slope2 * (float)(64 * kt);
#pragma unroll
        for (int r = 0; r < 16; ++r) { p0[r] = bkt + slope2 * (float)((r & 3) + 8 * (r >> 2)); p1[r] = p0[r] + slope2 * 32.0f; }
#pragma unroll
        for (int d0 = 0; d0 < 4; ++d0) {
            const bf16x8 a0 = *(const LAS bf16x8*)(Ks + d0 * 2048), a1 = *(const LAS bf16x8*)(Ks + d0 * 2048 + 512);
            p0 = __builtin_amdgcn_mfma_f32_32x32x16_bf16(a0, qr[d0], p0, 0, 0, 0);
            p1 = __builtin_amdgcn_mfma_f32_32x32x16_bf16(a1, qr[d0], p1, 0, 0, 0);
        }
        if (CAUSAL) {
#pragma unroll
            for (int r = 0; r < 16; ++r) { const int kp = 64 * kt + crow(r, hi); if (kp > reli) p0[r] = -1e30f; if (kp + 32 > reli) p1[r] = -1e30f; }
        }
        float mt = fmaxf(p0[0], p1[0]);
#pragma unroll
        for (int r = 1; r < 16; ++r) mt = fmaxf(mt, fmaxf(p0[r], p1[r]));
        mt = swapmax(mt);
        const float mnew = fmaxf(m, mt), alpha = fast_exp2(m - mnew); m = mnew;
        float rs = 0.f;
#pragma unroll
        for (int r = 0; r < 16; ++r) { p0[r] = fast_exp2(p0[r] - mnew); p1[r] = fast_exp2(p1[r] - mnew); rs += p0[r] + p1[r]; }
        l = l * alpha + rs;
        if (hi == 0) wsf[r32] = alpha;
        asm volatile("s_waitcnt lgkmcnt(0)" ::: "memory");
#pragma unroll
        for (int r = 0; r < 16; ++r) { const float a = wsf[crow(r, hi)]; o[0][r] *= a; o[1][r] *= a; }
        asm volatile("" ::: "memory");
        v4u pw0, pw1, pw2, pw3;
        pw0.x = cvtpk(p0[0], p0[1]); pw0.y = cvtpk(p0[2], p0[3]); pw0.z = cvtpk(p0[4], p0[5]); pw0.w = cvtpk(p0[6], p0[7]);
        pw1.x = cvtpk(p0[8], p0[9]); pw1.y = cvtpk(p0[10], p0[11]); pw1.z = cvtpk(p0[12], p0[13]); pw1.w = cvtpk(p0[14], p0[15]);
        pw2.x = cvtpk(p1[0], p1[1]); pw2.y = cvtpk(p1[2], p1[3]); pw2.z = cvtpk(p1[4], p1[5]); pw2.w = cvtpk(p1[6], p1[7]);
        pw3.x = cvtpk(p1[8], p1[9]); pw3.y = cvtpk(p1[10], p1[11]); pw3.z = cvtpk(p1[12], p1[13]); pw3.w = cvtpk(p1[14], p1[15]);
        const LAS unsigned char* vp = F.lds + ATT_V + kt * 8192 + ((lane >> 4) & 1) * 32 + (lane & 3) * 8 + (4 * hi + ((lane & 15) >> 2)) * 64;
#pragma unroll
        for (int d0 = 0; d0 < 2; ++d0) {
#define ATT_PV(ks, pw) { const s16x4 lo = vtr(vp + d0 * 4096 + (ks) * 1024), hh = vtr(vp + d0 * 4096 + (ks) * 1024 + 512); \
            const bf16x8 vf = (bf16x8){lo[0], lo[1], lo[2], lo[3], hh[0], hh[1], hh[2], hh[3]}; \
            o[d0] = __builtin_amdgcn_mfma_f32_32x32x16_bf16(__builtin_bit_cast(bf16x8, pw), vf, o[d0], 0, 0, 0); }
            ATT_PV(0, pw0) ATT_PV(1, pw1) ATT_PV(2, pw2) ATT_PV(3, pw3)
#undef ATT_PV
        }
    }
    m_out = m; l_out = swapsum(l);
}

__device__ __forceinline__ void stage_o(Frame& F, const f32x16 (&o)[2], float l) {
    const int lane = F.lane, r32 = lane & 31, hi = lane >> 5;
    LAS float* wsf = (LAS float*)(F.lds + ATT_WS + F.wave * 256);
    LAS bf16* stg = (LAS bf16*)(F.lds + ATT_OST + F.wave * 4096);
    if (hi == 0) wsf[32 + r32] = l;
    asm volatile("s_waitcnt lgkmcnt(0)" ::: "memory");
#pragma unroll
    for (int r = 0; r < 16; ++r) { const int orow = crow(r, hi); const float rl = fast_rcp(wsf[32 + orow]);
        stg[orow * 64 + r32] = (bf16)f2bf(o[0][r] * rl); stg[orow * 64 + 32 + r32] = (bf16)f2bf(o[1][r] * rl); }
    asm volatile("s_waitcnt lgkmcnt(0)" ::: "memory");
}

__device__ __forceinline__ void gathered_phase(Frame& F, int rep) {
    const bf16* Q = (const bf16*)(F.ws + WS_Q);
    const unsigned* sel = (const unsigned*)(F.ws + WS_SEL);
    bf16* part = (bf16*)(F.ws + WS_PART); float* lseb = (float*)(F.ws + WS_LSE);
    LAS unsigned short* list = (LAS unsigned short*)(F.lds + ATT_LIST);
    LAS unsigned* cnt = (LAS unsigned*)(F.lds + ATT_CNT);
    constexpr int NITEM = BATCH * NH * (NBLK - 1);
    const int lane = F.lane, r32 = lane & 31, hi = lane >> 5;
    for (;;) {
        __syncthreads();
        if (F.tid == 0) { cnt[1] = __hip_atomic_fetch_add((unsigned*)(F.ctl + CW_QUEUE + 64 * rep), 1u, RLX_AGENT); cnt[0] = 0u; }
        __syncthreads();
        const int item = (int)cnt[1];
        if (item >= NITEM) break;
        const int j = item >> 5, bh = item & 31, b = bh >> 3, h = bh & 7;
        load_kv(F, b, h, j);
        const unsigned* selrow = sel + (size_t)bh * SEQ;
        const int tstart = (j + 1) * MBLK, nk = (SEQ - tstart + NWAVES * 64 - 1) / (NWAVES * 64);
        unsigned sw[16];
#pragma unroll
        for (int k = 0; k < 16; ++k) { const int t = tstart + k * NWAVES * 64 + F.tid; sw[k] = (k < nk && t < SEQ) ? selrow[t] : 0xffffffffu; }
#pragma unroll
        for (int k = 0; k < 16; ++k) if (k < nk) {
            const int t = tstart + k * NWAVES * 64 + F.tid;
            const int own = t >> 8, nv = own < 3 ? own : 3;
            int slot = -1;
            if ((int)(sw[k] & 255u) == j && nv > 0) slot = 0; else if ((int)((sw[k] >> 8) & 255u) == j && nv > 1) slot = 1; else if ((int)((sw[k] >> 16) & 255u) == j && nv > 2) slot = 2;
            const bool match = t < SEQ && slot >= 0;
            const unsigned long long bal = __ballot(match);
            const int tot = __popcll(bal), pre = __popcll(bal & ((1ull << lane) - 1ull));
            unsigned base = 0u;
            if (lane == 0 && tot) base = __hip_atomic_fetch_add(cnt, (unsigned)tot, __ATOMIC_RELAXED, __HIP_MEMORY_SCOPE_WORKGROUP);
            base = (unsigned)__builtin_amdgcn_readfirstlane((int)base);
            if (match) list[base + pre] = (unsigned short)(t | (slot << 13));
        }
        asm volatile("s_waitcnt vmcnt(0) lgkmcnt(0)" ::: "memory");
        __syncthreads();
        const int n = (int)cnt[0];
        const int ntile = (n + 31) >> 5;
        const float slope2 = exp2f(-(float)(h + 1)) * LOG2E;
        bf16x8 qn[4]; unsigned en = 0u;
        if (F.wave < ntile) { const int idx = F.wave * 32 + r32; en = list[idx < n ? idx : n - 1];
            const bf16* qrow = Q + (size_t)(b * SEQ + (int)(en & 0x1fffu)) * AW + h * HD;
#pragma unroll
            for (int d0 = 0; d0 < 4; ++d0) qn[d0] = *(const GAS bf16x8*)(qrow + d0 * 16 + hi * 8); }
        for (int tile = F.wave; tile < ntile; tile += NWAVES) {
            const int idx = tile * 32 + r32;
            const unsigned e = en; const int t = (int)(e & 0x1fffu);
            bf16x8 qr[4];
#pragma unroll
            for (int d0 = 0; d0 < 4; ++d0) qr[d0] = qn[d0];
            if (tile + NWAVES < ntile) { const int idx2 = (tile + NWAVES) * 32 + r32; en = list[idx2 < n ? idx2 : n - 1];
                const bf16* qrow = Q + (size_t)(b * SEQ + (int)(en & 0x1fffu)) * AW + h * HD;
#pragma unroll
                for (int d0 = 0; d0 < 4; ++d0) qn[d0] = *(const GAS bf16x8*)(qrow + d0 * 16 + hi * 8); }
            f32x16 o[2]; float m, l;
            attn_tile<false>(F, qr, t - j * MBLK, slope2, 4, o, m, l);
            if (hi == 0 && idx < n) lseb[((size_t)(b * SEQ + t) * NH + h) * 3 + (e >> 13)] = m + __log2f(l);
            stage_o(F, o, l);
            const LAS bf16* stg = (const LAS bf16*)(F.lds + ATT_OST + F.wave * 4096);
#pragma unroll
            for (int i = 0; i < 4; ++i) { const int row = i * 8 + (lane >> 3), ch = lane & 7, ri = tile * 32 + row;
                if (ri < n) { const unsigned er = list[ri]; const v4u v = *(const LAS v4u*)(stg + row * 64 + ch * 8);
                    *(GAS v4u*)(part + ((size_t)(b * SEQ + (int)(er & 0x1fffu)) * 3 + (er >> 13)) * AW + h * HD + ch * 8) = v; } }
            asm volatile("s_waitcnt lgkmcnt(0)" ::: "memory");
        }
    }
}

__device__ __forceinline__ void own_phase(Frame& F) {
    const bf16* Q = (const bf16*)(F.ws + WS_Q);
    const bf16* part = (const bf16*)(F.ws + WS_PART); const float* lseb = (const float*)(F.ws + WS_LSE);
    bf16* yatt = (bf16*)(F.ws + WS_YATT);
    constexpr int NITEM = BATCH * NH * NBLK;
    const int lane = F.lane, r32 = lane & 31, hi = lane >> 5;
    for (int it = F.vcu; it < NITEM; it += F.G) {
        const int i = it & 31, bh = it >> 5, b = bh >> 3, h = bh & 7;
        __syncthreads();
        load_kv(F, b, h, i);
        const float slope2 = exp2f(-(float)(h + 1)) * LOG2E;
        const int reli = F.wave * 32 + r32, t = i * MBLK + reli;
        bf16x8 qr[4];
        { const bf16* qrow = Q + (size_t)(b * SEQ + t) * AW + h * HD;
#pragma unroll
          for (int d0 = 0; d0 < 4; ++d0) qr[d0] = *(const GAS bf16x8*)(qrow + d0 * 16 + hi * 8); }
        asm volatile("s_waitcnt vmcnt(0)" ::: "memory");
        __syncthreads();
        f32x16 o[2]; float m, l;
        attn_tile<true>(F, qr, reli, slope2, (F.wave >> 1) + 1, o, m, l);
        LAS float* wsf = (LAS float*)(F.lds + ATT_WS + F.wave * 256);
        if (hi == 0) wsf[r32] = m + __log2f(l);
        stage_o(F, o, l);
        const LAS bf16* stg = (const LAS bf16*)(F.lds + ATT_OST + F.wave * 4096);
        const int nv = i < 3 ? i : 3;
#pragma unroll
        for (int k = 0; k < 4; ++k) {
            const int row = k * 8 + (lane >> 3), ch = lane & 7, tr = i * MBLK + F.wave * 32 + row;
            const v4u ov = *(const LAS v4u*)(stg + row * 64 + ch * 8);
            const float lown = wsf[row];
            float ls[3]; float M = lown;
#pragma unroll
            for (int s2 = 0; s2 < 3; ++s2) { ls[s2] = (s2 < nv) ? lseb[((size_t)(b * SEQ + tr) * NH + h) * 3 + s2] : -1e30f; M = fmaxf(M, ls[s2]); }
            float wown = fast_exp2(lown - M), W = wown;
            float a[8] = {bflo(ov.x) * wown, bfhi(ov.x) * wown, bflo(ov.y) * wown, bfhi(ov.y) * wown, bflo(ov.z) * wown, bfhi(ov.z) * wown, bflo(ov.w) * wown, bfhi(ov.w) * wown};
#pragma unroll
            for (int s2 = 0; s2 < 3; ++s2) if (s2 < nv) {
                const float w = fast_exp2(ls[s2] - M); W += w;
                const v4u pv = *(const GAS v4u*)(part + ((size_t)(b * SEQ + tr) * 3 + s2) * AW + h * HD + ch * 8);
                a[0] += w * bflo(pv.x); a[1] += w * bfhi(pv.x); a[2] += w * bflo(pv.y); a[3] += w * bfhi(pv.y); a[4] += w * bflo(pv.z); a[5] += w * bfhi(pv.z); a[6] += w * bflo(pv.w); a[7] += w * bfhi(pv.w);
            }
            const float rw = fast_rcp(W);
            v4u outv; outv.x = pk2(a[0] * rw, a[1] * rw); outv.y = pk2(a[2] * rw, a[3] * rw); outv.z = pk2(a[4] * rw, a[5] * rw); outv.w = pk2(a[6] * rw, a[7] * rw);
            *(GAS v4u*)(yatt + (size_t)(b * SEQ + tr) * AW + h * HD + ch * 8) = outv;
        }
        asm volatile("s_waitcnt lgkmcnt(0)" ::: "memory");
    }
}
}

__device__ __forceinline__ void attn_simple_phase(Frame& F) {
    LAS float* qs = (LAS float*)(F.lds + RING_OFF + F.wave * 8192);
    LAS float* pb = qs + 64;
    const bf16* q = (const bf16*)(F.ws + WS_Q); const bf16* k = (const bf16*)(F.ws + WS_K); const bf16* v = (const bf16*)(F.ws + WS_V);
    const unsigned* sel = (const unsigned*)(F.ws + WS_SEL);
    bf16* yatt = (bf16*)(F.ws + WS_YATT);
    const int gw = F.vcu * NWAVES + F.wave, NGW = F.G * NWAVES;
    for (int id = gw; id < BATCH * NH * SEQ; id += NGW) {
        const int t = id & (SEQ - 1), h = (id >> 13) & 7, b = id >> 16;
        const int own = t >> 8, nvalid = own < 3 ? own : 3;
        const float slope2 = exp2f(-(float)(h + 1)) * LOG2E;
        const size_t rowq = (size_t)(b * SEQ + t) * AW + h * HD;
        qs[F.lane] = bf2f(q[rowq + F.lane]);
        LDS_WAIT(); asm volatile("" ::: "memory");
        float qf[64];
#pragma unroll
        for (int c = 0; c < 16; ++c) { const f32x4 x = *(const LAS f32x4*)(qs + 4 * c); qf[4 * c] = x[0]; qf[4 * c + 1] = x[1]; qf[4 * c + 2] = x[2]; qf[4 * c + 3] = x[3]; }
        const unsigned sw = sel[(size_t)(b * NH + h) * SEQ + t];
        int blk[4]; blk[0] = sw & 255; blk[1] = (sw >> 8) & 255; blk[2] = (sw >> 16) & 255; blk[3] = own;
        float sc[16]; float mx = -1e30f;
#pragma unroll
        for (int s = 0; s < 4; ++s) {
            const bool valid = (s == 3) || (s < nvalid);
#pragma unroll
            for (int kk = 0; kk < 4; ++kk) {
                float val = -1e30f;
                if (valid) {
                    const int kpos = blk[s] * MBLK + kk * 64 + F.lane;
                    if (s < 3 || kpos <= t) {
                        const bf16* kr = k + (size_t)(b * SEQ + kpos) * AW + h * HD;
                        float dot = 0.f;
#pragma unroll
                        for (int c = 0; c < 8; ++c) { const v4u w = *(const GAS v4u*)(kr + 8 * c);
                            dot += qf[8 * c] * bflo(w.x) + qf[8 * c + 1] * bfhi(w.x) + qf[8 * c + 2] * bflo(w.y) + qf[8 * c + 3] * bfhi(w.y) + qf[8 * c + 4] * bflo(w.z) + qf[8 * c + 5] * bfhi(w.z) + qf[8 * c + 6] * bflo(w.w) + qf[8 * c + 7] * bfhi(w.w); }
                        val = dot + slope2 * (float)(kpos - t);
                    }
                }
                sc[s * 4 + kk] = val; mx = fmaxf(mx, val);
            }
        }
        mx = wave_max(mx);
        float l = 0.f;
#pragma unroll
        for (int i = 0; i < 16; ++i) { const float p = fast_exp2(sc[i] - mx); l += p; pb[i * 64 + F.lane] = p; }
        l = wave_sum(l);
        LDS_WAIT(); asm volatile("" ::: "memory");
        float o = 0.f;
#pragma unroll
        for (int s = 0; s < 4; ++s) {
            const bool valid = (s == 3) || (s < nvalid);
            if (!valid) continue;
            const int nk = (s == 3) ? (t & 255) + 1 : 256;
            const bf16* vb = v + (size_t)(b * SEQ + blk[s] * MBLK) * AW + h * HD + F.lane;
            const LAS float* pp = pb + s * 256;
#pragma unroll 8
            for (int j = 0; j < nk; ++j) o += pp[j] * bf2f(vb[(size_t)j * AW]);
        }
        yatt[rowq + F.lane] = (bf16)f2bf(o / l);
        LDS_WAIT(); asm volatile("" ::: "memory");
    }
}

__device__ __forceinline__ void ssm_simple_phase(Frame& F) {
    const int gw = F.vcu * NWAVES + F.wave;
    if (gw >= BATCH * SG) return;
    const int g = gw % SG, b = gw / SG, p = F.lane;
    const float lr = F.in[IN_LAMRE][g * SP + p], li = F.in[IN_LAMIM][g * SP + p], dt = expf(F.in[IN_LOGDT][g]);
    const float mag = expf(lr * dt), ang = li * dt;
    float sn_, cs_; sincosf(ang, &sn_, &cs_);
    const float ar = mag * cs_, ai = mag * sn_;
    const float nr = ar - 1.0f, ni = ai, den = lr * lr + li * li;
    const float fr = (nr * lr + ni * li) / den, fi = (ni * lr - nr * li) / den;
    float bbr[16], bbi[16], cr[16], ci[16];
#pragma unroll
    for (int c = 0; c < 16; ++c) {
        const float br = F.in[IN_BRE][(g * SP + p) * SC + c], bi = F.in[IN_BIM][(g * SP + p) * SC + c];
        bbr[c] = fr * br - fi * bi; bbi[c] = fr * bi + fi * br;
        cr[c] = F.in[IN_CRE][(g * SC + c) * SP + p]; ci[c] = F.in[IN_CIM][(g * SC + c) * SP + p];
    }
    const bf16* A = (const bf16*)(F.ws + WS_SSMA);
    bf16* y1 = (bf16*)(F.ws + WS_Y1);
    const float dsk = F.in[IN_SSMD][g * SC + (F.lane & 15)];
    float xr = 0.f, xi = 0.f;
    for (int t = 0; t < SEQ; ++t) {
        const bf16* urow = A + ((size_t)(g * 1024 + b * NCH + (t >> 5)) * KSSM + (t & 31) * SC);
        const float ul = bf2f(urow[F.lane & 15]);
        float bur = 0.f, bui = 0.f;
#pragma unroll
        for (int c = 0; c < 16; ++c) { const float uc = __shfl(ul, c); bur += bbr[c] * uc; bui += bbi[c] * uc; }
        const float nxr = ar * xr - ai * xi + bur, nxi = ar * xi + ai * xr + bui;
        xr = nxr; xi = nxi;
        float yv = 0.f;
#pragma unroll
        for (int c = 0; c < 16; ++c) { const float part = wave_sum(cr[c] * xr - ci[c] * xi); if ((F.lane & 15) == c) yv = part; }
        if (F.lane < 16) { const float val = yv + dsk * ul; y1[(size_t)(b * SEQ + t) * SW + g * SC + F.lane] = (bf16)f2bf(gelu_tanh(val)); }
    }
}

struct Args { const float* in[26]; float* out; unsigned char* ws; int ph_lo, ph_hi, li, pad; };

__global__ void __launch_bounds__(NWAVES * 64, 2) hybrid_fwd(Args args) {
    extern __shared__ __attribute__((aligned(16))) unsigned char lds[];
    Frame F;
    F.lds = (LAS unsigned char*)lds;
    F.MISC = (volatile LAS unsigned*)(F.lds + MISC_OFF);
    F.tid = threadIdx.x; F.lane = F.tid & 63; F.wave = __builtin_amdgcn_readfirstlane(F.tid >> 6);
    F.G = gridDim.x; { const int bx = blockIdx.x; F.vcu = (F.G % 8 == 0) ? (bx % 8) * (F.G / 8) + bx / 8 : bx; }
    F.ws = args.ws; F.ctl = (gu32*)(args.ws + WS_CTL); F.out = args.out;
#pragma unroll
    for (int i = 0; i < 26; ++i) F.in[i] = args.in[i];
    for (int u = F.tid; u < 64; u += NWAVES * 64) ((LAS unsigned*)(F.lds + MISC_OFF))[u] = 0u;
    __syncthreads();
    XcdBarrier bar; bar.bar = (unsigned*)(F.ctl + CW_BAR); bar.x = 0; bar.st = nullptr;
    if (MK_N_LAUNCHES == 1) bar = xcd_barrier_post((unsigned*)(F.ctl + CW_BAR), F.MISC + 8);
#define GRID_BAR() do { if (MK_N_LAUNCHES == 1) xcd_barrier(bar); } while (0)
#ifndef DUP_MASK
#define DUP_MASK 0
#endif
#define NREP(k) (((DUP_MASK >> (k)) & 1) ? 2 : 1)
    const int lo = args.ph_lo, hi = args.ph_hi;
#define IN(k) (lo <= (k) && (k) < hi)
#define BOTH(k) (IN(k) && IN((k) + 1))
    unsigned char* ws = args.ws;
    const float* ada = (const float*)(ws + WS_ADA);
    float* rowss = (float*)(ws + WS_ROWSS);
    const int bx = (int)blockIdx.x;

    if (IN(0)) { _Pragma("unroll") for (int rep = 0; rep < NREP(0); ++rep) { if (rep) GRID_BAR(); p0_prologue(F); } if (BOTH(0)) GRID_BAR(); }
    if (IN(1)) { _Pragma("unroll") for (int rep = 0; rep < NREP(1); ++rep) { if (rep) GRID_BAR(); p1_phase(F); } if (BOTH(1)) GRID_BAR(); }
    if (IN(2)) { _Pragma("unroll") for (int rep = 0; rep < NREP(2); ++rep) { if (rep) GRID_BAR();
        pg8::Gemm g{(const bf16*)F.out, (const bf16*)(ws + WS_W1T), D, D, D, nullptr, nullptr, 0}; pg8::StaticOrder S; S.init(T, NGU, F.G, bx);
        pg8::EpiSwiGLU<false> E{(bf16*)(ws + WS_ACT), nullptr, nullptr, (LAS float*)(F.lds + RN_OFF)};
        pg8::gemm_phase<pg8::EpiSwiGLU<false>, pg8::StaticOrder, true>(F.lds + RING_OFF, g, S, E);
        } if (BOTH(2)) GRID_BAR();
    }
    if (IN(3)) { _Pragma("unroll") for (int rep = 0; rep < NREP(3); ++rep) { if (rep) GRID_BAR();
        pg8::Gemm g{(const bf16*)(ws + WS_ACT), (const bf16*)(ws + WS_W2T), FF, FF, FF, nullptr, nullptr, 0}; pg8::StaticOrder S; S.init(T, D, F.G, bx);
        pg8::EpiResid<true, 0> E{(const bf16*)F.out + (size_t)T * D, (bf16*)F.out, ada + 2 * D, (bf16*)(ws + WS_X1S), (const float*)(ws + WS_CS2), rowss, 0.5f};
        pg8::gemm_phase<pg8::EpiResid<true, 0>, pg8::StaticOrder, true>(F.lds + RING_OFF, g, S, E);
        } if (BOTH(3)) GRID_BAR();
    }
    if (IN(4)) { _Pragma("unroll") for (int rep = 0; rep < NREP(4); ++rep) { if (rep) GRID_BAR();
        pg8::Gemm g{(const bf16*)(ws + WS_X1S), (const bf16*)(ws + WS_WINT), D, D, D, nullptr, nullptr, 0}; pg8::StaticOrder S; S.init(T, NIN, F.G, bx);
        pg8::EpiIn E{rowss, (const float*)(ws + WS_BIAS2), (bf16*)(ws + WS_Q), (bf16*)(ws + WS_K), (bf16*)(ws + WS_V), (bf16*)(ws + WS_SSMA), (unsigned char*)(ws + WS_SGA), (unsigned char*)(ws + WS_SGS), (float*)(ws + WS_KMEANP), (LAS float*)(F.lds + RN_OFF)};
        pg8::gemm_phase<pg8::EpiIn, pg8::StaticOrder, true>(F.lds + RING_OFF, g, S, E);
        } if (BOTH(4)) GRID_BAR();
    }
    if (IN(5)) { _Pragma("unroll") for (int rep = 0; rep < NREP(5); ++rep) { if (rep) GRID_BAR();
        {
            pg8::Gemm g{(const bf16*)(ws + WS_SSMA), (const bf16*)(ws + WS_BS), KSSM, 512, 512, nullptr, nullptr, 0}; pg8::BlockDiagOrder S; S.init(SG, 4, 1, F.G, bx);
            pg8::EpiSsmState E{(bf16*)(ws + WS_SSMA), F.in[IN_LAMRE], F.in[IN_LAMIM], F.in[IN_LOGDT]};
            pg8::gemm_phase<pg8::EpiSsmState, pg8::BlockDiagOrder, false>(F.lds + RING_OFF, g, S, E);
        }
        gating_phase(F, rep);
        } if (BOTH(5)) GRID_BAR();
    }
    if (IN(6)) { _Pragma("unroll") for (int rep = 0; rep < NREP(6); ++rep) { if (rep) GRID_BAR();
        {
            pg8::Gemm g{(const bf16*)(ws + WS_SSMA), (const bf16*)(ws + WS_BM), KSSM, KSSM, KSSM, nullptr, nullptr, 0}; pg8::BlockDiagOrder S; S.init(SG, 4, 2, F.G, bx);
            pg8::EpiSsmMain E{(const bf16*)(ws + WS_SSMA), F.in[IN_SSMD], (bf16*)(ws + WS_Y1)};
            pg8::gemm_phase<pg8::EpiSsmMain, pg8::BlockDiagOrder, true>(F.lds + RING_OFF, g, S, E);
        }
        att::gathered_phase(F, rep);
        } if (BOTH(6)) GRID_BAR();
    }
    if (IN(7)) { _Pragma("unroll") for (int rep = 0; rep < NREP(7); ++rep) { if (rep) GRID_BAR();
        pg8::Gemm g{(const bf16*)(ws + WS_Y1), (const bf16*)(ws + WS_WGLU), SW, SW, SW, nullptr, nullptr, 0}; pg8::StaticOrder S; S.init(T, SW, F.G, bx);
        pg8::EpiGlu E{(const bf16*)(ws + WS_Y1), F.in[IN_BGLU], (bf16*)(ws + WS_YSSM)};
        pg8::gemm_phase<pg8::EpiGlu, pg8::StaticOrder, true>(F.lds + RING_OFF, g, S, E);
        att::own_phase(F);
        } if (BOTH(7)) GRID_BAR();
    }
    if (IN(8)) { _Pragma("unroll") for (int rep = 0; rep < NREP(8); ++rep) { if (rep) GRID_BAR();
        pg8::Gemm g{(const bf16*)(ws + WS_YATT), (const bf16*)(ws + WS_WBRA), AW, AW, AW, (const bf16*)(ws + WS_YSSM), (const bf16*)(ws + WS_WBRS), SW}; pg8::StaticOrder S; S.init(T, D, F.G, bx);
        pg8::EpiMerge E{(const unsigned char*)(ws + WS_SGA), (const unsigned char*)(ws + WS_SGS), (bf16*)(ws + WS_MERGED)};
        pg8::gemm_phase<pg8::EpiMerge, pg8::StaticOrder, true>(F.lds + RING_OFF, g, S, E);
        } if (BOTH(8)) GRID_BAR();
    }
    if (IN(9)) { _Pragma("unroll") for (int rep = 0; rep < NREP(9); ++rep) { if (rep) GRID_BAR();
        pg8::Gemm g{(const bf16*)(ws + WS_MERGED), (const bf16*)(ws + WS_WOUT), D, D, D, nullptr, nullptr, 0}; pg8::StaticOrder S; S.init(T, D, F.G, bx);
        pg8::EpiResid<true, 1> E{(const bf16*)F.out, (bf16*)F.out + (size_t)T * D, ada + 5 * D, (bf16*)(ws + WS_X2S), (const float*)(ws + WS_CS3), rowss, 1.0f};
        pg8::gemm_phase<pg8::EpiResid<true, 1>, pg8::StaticOrder, true>(F.lds + RING_OFF, g, S, E);
        } if (BOTH(9)) GRID_BAR();
    }
    if (IN(10)) { _Pragma("unroll") for (int rep = 0; rep < NREP(10); ++rep) { if (rep) GRID_BAR();
        pg8::Gemm g{(const bf16*)(ws + WS_X2S), (const bf16*)(ws + WS_W3T), D, D, D, nullptr, nullptr, 0}; pg8::StaticOrder S; S.init(T, NGU, F.G, bx);
        pg8::EpiSwiGLU<true> E{(bf16*)(ws + WS_ACT), rowss, (const float*)(ws + WS_BIAS3), (LAS float*)(F.lds + RN_OFF)};
        pg8::gemm_phase<pg8::EpiSwiGLU<true>, pg8::StaticOrder, true>(F.lds + RING_OFF, g, S, E);
        } if (BOTH(10)) GRID_BAR();
    }
    if (IN(11)) { _Pragma("unroll") for (int rep = 0; rep < NREP(11); ++rep) { if (rep) GRID_BAR();
        pg8::Gemm g{(const bf16*)(ws + WS_ACT), (const bf16*)(ws + WS_W4T), FF, FF, FF, nullptr, nullptr, 0}; pg8::StaticOrder S; S.init(T, D, F.G, bx);
        pg8::EpiResid<false, 2> E{(const bf16*)F.out + (size_t)T * D, (bf16*)(ws + WS_X3), ada + 8 * D, nullptr, nullptr, rowss, 0.5f};
        pg8::gemm_phase<pg8::EpiResid<false, 2>, pg8::StaticOrder, true>(F.lds + RING_OFF, g, S, E);
        } if (BOTH(11)) GRID_BAR();
    }
    if (IN(12)) { _Pragma("unroll") for (int rep = 0; rep < NREP(12); ++rep) { if (rep) GRID_BAR(); final_norm_phase(F); }  }
#undef IN
#undef BOTH
}

extern "C" void kernel_launch(void* const* d_in, const int* in_sizes, int n_in, void* d_out, int out_size, void* d_ws, size_t ws_size, hipStream_t stream) {
    static int grid = 0;
    if (grid == 0) {
        if (n_in != 26 || in_sizes[0] != T * D || out_size != T * D || ws_size < WS_END) { fprintf(stderr, "kernel_launch: unexpected shapes (n_in %d, in0 %d, out %d, ws %zu < %zu); nothing launched\n", n_in, n_in > 0 ? in_sizes[0] : -1, out_size, ws_size, (size_t)WS_END); grid = -1; return; }
        int dev = 0, cus = 0;
        if (hipGetDevice(&dev) != hipSuccess || hipDeviceGetAttribute(&cus, hipDeviceAttributeMultiprocessorCount, dev) != hipSuccess) { grid = -1; return; }
        if (hipFuncSetAttribute((const void*)hybrid_fwd, hipFuncAttributeMaxDynamicSharedMemorySize, LDS_BYTES) != hipSuccess) { fprintf(stderr, "kernel_launch: hipFuncSetAttribute failed\n"); grid = -1; return; }
        (void)hipGetLastError();
        grid = cus;
    }
    if (grid < 0) return;
    if (hipMemsetAsync((char*)d_ws + WS_CTL, 0, CTL_ZERO_BYTES, stream) != hipSuccess) return;
    Args a{};
    for (int i = 0; i < 26; ++i) a.in[i] = (const float*)d_in[i];
    a.out = (float*)d_out; a.ws = (unsigned char*)d_ws;
    for (int li = 0; li < MK_N_LAUNCHES; ++li) {
        a.ph_lo = (MK_N_LAUNCHES == 1) ? 0 : li; a.ph_hi = (MK_N_LAUNCHES == 1) ? N_PHASES : li + 1; a.li = li;
        hipLaunchKernelGGL(hybrid_fwd, dim3(grid), dim3(NWAVES * 64), LDS_BYTES, stream, a);
    }
}
```

```cpp
#include <hip/hip_runtime.h>
#include <hip/hip_bf16.h>
#include <cstdio>
#include <cstdint>

#ifndef MK_N_LAUNCHES
#define MK_N_LAUNCHES 1
#endif

constexpr int BATCH = 4, SEQ = 8192, T = BATCH * SEQ, D = 1024, FF = 2816, NGU = 2 * FF, NIN = 4096, AW = 512, SW = 512, NH = 8, HD = 64;
constexpr int NBLK = 32, MBLK = 256;
constexpr int SG = 32, SC = 16, SP = 64, SL = 32, NCH = SEQ / SL, KSSM = SC * SL + 2 * SP;
constexpr int NADA = 9 * D;
constexpr float EPS = 1e-6f;
constexpr float LOG2E = 1.4426950408889634f;
constexpr float QSCALE = 0.125f * LOG2E;
constexpr int N_PHASES = 13;

constexpr size_t MiB = 1u << 20;
constexpr size_t WS_CTL = 0, CTL_ZERO_BYTES = 1 * MiB;
constexpr size_t WS_ADA = 1 * MiB;
constexpr size_t WS_CS2 = WS_ADA + 147456;
constexpr size_t WS_CS3 = WS_CS2 + 16384;
constexpr size_t WS_BIAS2 = WS_CS3 + 16384;
constexpr size_t WS_BIAS3 = WS_BIAS2 + 65536;
constexpr size_t WS_KMEANP = 1 * MiB + 512 * 1024;
constexpr size_t WS_SEL = 2 * MiB;
constexpr size_t WS_LSE = 498 * MiB;
constexpr size_t WS_ROWSS = 4 * MiB;
constexpr size_t WS_WINT = 8 * MiB, WS_WGLU = 16 * MiB, WS_WBRA = 17 * MiB, WS_WBRS = 18 * MiB, WS_WOUT = 19 * MiB;
constexpr size_t WS_W1T = 21 * MiB, WS_W2T = 32 * MiB, WS_W3T = 37 * MiB + 512 * 1024, WS_W4T = 48 * MiB + 512 * 1024;
constexpr size_t WS_BM = 54 * MiB, WS_BS = 74 * MiB;
constexpr size_t WS_ARENA = 82 * MiB;
constexpr size_t WS_SGA = WS_ARENA, WS_SGS = WS_ARENA + 32 * MiB;
constexpr size_t WS_Q = WS_ARENA + 128 * MiB, WS_K = WS_ARENA + 160 * MiB, WS_V = WS_ARENA + 192 * MiB;
constexpr size_t WS_PART = WS_ARENA + 224 * MiB;
constexpr size_t WS_Y1 = WS_ARENA + 320 * MiB;
constexpr size_t WS_SSMA = WS_ARENA + 352 * MiB;
constexpr size_t WS_YSSM = WS_ARENA + 352 * MiB, WS_YATT = WS_ARENA + 384 * MiB;
constexpr size_t WS_X1S = WS_ARENA + 224 * MiB, WS_ACT = WS_ARENA, WS_MERGED = WS_ARENA + 128 * MiB, WS_X2S = WS_ARENA + 224 * MiB;
constexpr size_t WS_X3 = WS_ARENA + 224 * MiB;
constexpr size_t WS_END = WS_ARENA + 416 * MiB + 3 * MiB;
static_assert(WS_BIAS3 + 90112 <= WS_KMEANP && WS_W4T + (size_t)D * FF * 2 <= WS_BM && WS_BM + (size_t)SG * 512 * KSSM * 2 <= WS_BS && WS_BS + (size_t)SG * 256 * 512 * 2 <= WS_ARENA, "ws map");
static_assert((size_t)SG * 1024 * KSSM * 2 <= 40 * MiB && (size_t)T * FF * 2 <= 176 * MiB, "ws map 2");
constexpr int CW_BAR = 4096;
constexpr int CW_QUEUE = 256;

constexpr int RING_OFF = 0, RING_BYTES = 131072;
constexpr int SILU_OFF = 131072;
constexpr int RN_OFF = 147456;
constexpr int LDS_BYTES = 163840;
constexpr int MISC_OFF = LDS_BYTES - 256;

#define GAS __attribute__((address_space(1)))
#define LAS __attribute__((address_space(3)))
typedef unsigned short bf16;
typedef unsigned v4u __attribute__((ext_vector_type(4)));
typedef unsigned v2u __attribute__((ext_vector_type(2)));
typedef float f32x4 __attribute__((ext_vector_type(4)));
typedef float f32x2 __attribute__((ext_vector_type(2)));
typedef short bf16x8 __attribute__((ext_vector_type(8)));
typedef GAS unsigned gu32;
#define RLX_AGENT __ATOMIC_RELAXED, __HIP_MEMORY_SCOPE_AGENT
#define LDS_WAIT() asm volatile("s_waitcnt lgkmcnt(0)" ::: "memory")
#define VM_WAIT() asm volatile("s_waitcnt vmcnt(0)" ::: "memory")
constexpr int NWAVES = 8;

__device__ __forceinline__ unsigned f2bf(float f) { unsigned u = __builtin_bit_cast(unsigned, f); return (u + 0x7fffu + ((u >> 16) & 1u)) >> 16; }
__device__ __forceinline__ unsigned pk2(float lo, float hi) { return f2bf(lo) | (f2bf(hi) << 16); }
__device__ __forceinline__ float bf2f(unsigned short h) { return __builtin_bit_cast(float, (unsigned)h << 16); }
__device__ __forceinline__ float bflo(unsigned w) { return __builtin_bit_cast(float, w << 16); }
__device__ __forceinline__ float bfhi(unsigned w) { return __builtin_bit_cast(float, w & 0xffff0000u); }
__device__ __forceinline__ float fast_exp2(float x) { return __builtin_amdgcn_exp2f(x); }
__device__ __forceinline__ float fast_rcp(float x) { return __builtin_amdgcn_rcpf(x); }
__device__ __forceinline__ float sigmoidf_(float x) { return fast_rcp(1.0f + fast_exp2(-LOG2E * x)); }
__device__ __forceinline__ float siluf_(float x) { return x * sigmoidf_(x); }
__device__ __forceinline__ float gelu_tanh(float v) { const float u = 1.5957691216057308f * (v + 0.044715f * v * v * v); return v * fast_rcp(1.0f + fast_exp2(-LOG2E * u)); }
__device__ __forceinline__ float wave_sum(float v) {
#pragma unroll
    for (int o = 1; o < 64; o <<= 1) v += __shfl_xor(v, o);
    return v;
}
__device__ __forceinline__ float wave_max(float v) {
#pragma unroll
    for (int o = 1; o < 64; o <<= 1) v = fmaxf(v, __shfl_xor(v, o));
    return v;
}

namespace pg8 {
#define PG8_LAS __attribute__((address_space(3)))
typedef unsigned short bf16_t;
typedef short bf16x8 __attribute__((ext_vector_type(8)));
typedef float f32x4 __attribute__((ext_vector_type(4)));
typedef unsigned u32x4 __attribute__((ext_vector_type(4)));
constexpr int BM = 256, BK = 64, HALF = 128, HTB = HALF * BK * 2, STAGE_BYTES = 8 * HTB, NXCD = 8, WGM = 8;

__host__ __device__ __forceinline__ int lds_byte(int r, int c) { const int st = (r >> 4) * 2 + (c >> 5), rr = r & 15, cc = c & 31, ob = rr * 64 + cc * 2; return st * 1024 + (ob ^ (((ob >> 9) & 1) << 5)); }
__host__ __device__ __forceinline__ void stage_rc(int b, int& R, int& C) { const int st = b / 1024, sb = b % 1024, swz = sb ^ (((sb >> 9) & 1) << 5); R = (st >> 1) * 16 + swz / 64; C = (st & 1) * 32 + (swz % 64) / 2; }
__host__ __device__ __forceinline__ int perm32(int rho) { const int n = rho >> 4, i = rho & 15; return 8 * (i >> 2) + 4 * n + (i & 3); }

struct Unit { int pm, pn; };
struct Gemm { const bf16_t* A; const bf16_t* Bt; int lda, ldb, K; const bf16_t* A2; const bf16_t* Bt2; int K2; };

struct StaticOrder {
    int nM, nN, nwg, G, c;
    __host__ __device__ void init(int M, int N, int G_, int c_) { nM = M / BM; nN = N / BM; nwg = nM * nN; G = G_; c = c_; }
    __host__ __device__ bool next(int i, Unit& u) const {
        const long L = (long)i * G + c; if (L >= nwg) return false;
        int wgid = (int)L; { const int q = nwg / NXCD, r = nwg % NXCD, xcd = wgid % NXCD, off = wgid / NXCD; wgid = (xcd < r ? xcd * (q + 1) : r * (q + 1) + (xcd - r) * q) + off; }
        const int nig = WGM * nN, gid = wgid / nig, fm = gid * WGM, gsz = (nM - fm) < WGM ? (nM - fm) : WGM;
        u.pm = fm + ((wgid % nig) % gsz); u.pn = (wgid % nig) / gsz; return true;
    }
};
struct BlockDiagOrder {
    int RM, RN, n, G, c, first;
    __host__ __device__ void init(int ngroups, int RM_, int RN_, int G_, int c_, int first_ = 0) { RM = RM_; RN = RN_; n = ngroups * RM_ * RN_; G = G_; c = c_; first = first_; }
    __host__ __device__ bool next(int i, Unit& u) const {
        const int L = i * G + c; if (L >= n || (first && i > 0)) return false;
        const int g = L / (RM * RN), r = L % (RM * RN); u.pm = g * RM + r / RN; u.pn = g * RN + r % RN; return true;
    }
};

__device__ __forceinline__ unsigned cvt_pk_bf16(float lo, float hi) { unsigned r; asm volatile("v_cvt_pk_bf16_f32 %0, %1, %2" : "=v"(r) : "v"(lo), "v"(hi)); return r; }

template <class Epi, class Sched, bool ALIGN_EPI = false, bool SP2 = true>
__device__ __forceinline__ void gemm_phase(PG8_LAS unsigned char* lds, const Gemm g, const Sched S, const Epi E) {
    const int tid = threadIdx.x, wid = __builtin_amdgcn_readfirstlane(tid >> 6), lane = tid & 63, wr = wid >> 2, wc = wid & 3, fr = lane & 15, fq = lane >> 4;
    const int nt1 = g.K / BK, nt = (g.K + g.K2) / BK;
    unsigned voffA[2], voffB[2];
#pragma unroll
    for (int i = 0; i < 2; ++i) { int R, C; stage_rc(tid * 16 + i * 8192, R, C); const int Rb = Epi::PERM ? ((R & ~31) + perm32(R & 31)) : R;
        voffA[i] = (unsigned)(R * g.lda + C) * 2u; voffB[i] = (unsigned)(Rb * g.ldb + C) * 2u; }
    const size_t kstep = (size_t)(BK * 2);
    const size_t hstepA = (size_t)HALF * g.lda * 2, hstepB = (size_t)HALF * g.ldb * 2;
    const size_t tstepA = 2 * hstepA, tstepB = 2 * hstepB;
    const unsigned ldsw = (unsigned)wid * 1024u;
    const int aoff = lds_byte(wr * 64 + fr, fq * 8), boff = lds_byte(wc * 32 + fr, fq * 8);
#define PG8_SA(b, h) (((b) * 2 + (h)) * HTB)
#define PG8_SB(b, h) ((4 + (b) * 2 + (h)) * HTB)
#define PG8_STAGE(bufoff, gbase, voff) do { _Pragma("unroll") for (int _i = 0; _i < 2; ++_i) \
        __builtin_amdgcn_global_load_lds((const unsigned*)((const char*)(gbase) + (voff)[_i]), (PG8_LAS unsigned*)(lds + (bufoff) + ldsw + _i * 8192), 16, 0, 0); } while (0)
#define PG8_LDA(dst, b, h) do { _Pragma("unroll") for (int m = 0; m < 4; ++m) _Pragma("unroll") for (int k = 0; k < 2; ++k) dst[m][k] = *(const PG8_LAS bf16x8*)(lds + PG8_SA(b, h) + aoff + m * 2048 + k * 1024); } while (0)
#define PG8_LDB(dst, b, h) do { _Pragma("unroll") for (int n = 0; n < 2; ++n) _Pragma("unroll") for (int k = 0; k < 2; ++k) dst[n][k] = *(const PG8_LAS bf16x8*)(lds + PG8_SB(b, h) + boff + n * 2048 + k * 1024); } while (0)
#define PG8_MMA(ai, bj, At, Bt) do { __builtin_amdgcn_s_setprio(1); _Pragma("unroll") for (int m = 0; m < 4; ++m) _Pragma("unroll") for (int n = 0; n < 2; ++n) _Pragma("unroll") for (int k = 0; k < 2; ++k) \
        acc[ai][bj][m][n] = __builtin_amdgcn_mfma_f32_16x16x32_bf16(Bt[n][k], At[m][k], acc[ai][bj][m][n], 0, 0, 0); __builtin_amdgcn_s_setprio(0); } while (0)
#define PG8_WAIT_V(n) asm volatile("s_waitcnt vmcnt(" #n ")" ::: "memory")
#define PG8_WAIT_L(n) asm volatile("s_waitcnt lgkmcnt(" #n ")" ::: "memory")
#define PG8_BAR __builtin_amdgcn_s_barrier()
#define PG8_SCHED __builtin_amdgcn_sched_barrier(0)
    Unit cur, nxt; int ui = 0;
    if (!S.next(0, cur)) return;
    f32x4 acc[2][2][4][2];
#pragma unroll
    for (int a = 0; a < 2; ++a)
#pragma unroll
        for (int b = 0; b < 2; ++b)
#pragma unroll
            for (int m = 0; m < 4; ++m)
#pragma unroll
                for (int n = 0; n < 2; ++n) acc[a][b][m][n] = (f32x4){0.f, 0.f, 0.f, 0.f};
    bf16x8 At[4][2], B0[2][2], B1[2][2];
    const char* cA = (const char*)g.A + (size_t)cur.pm * tstepA; const char* cB = (const char*)g.Bt + (size_t)cur.pn * tstepB;
    const char* cA2 = (const char*)g.A2 + (size_t)cur.pm * tstepA; const char* cB2 = (const char*)g.Bt2 + (size_t)cur.pn * tstepB;
    {
        PG8_STAGE(PG8_SB(0, 0), cB, voffB); PG8_STAGE(PG8_SB(0, 1), cB + hstepB, voffB); PG8_STAGE(PG8_SA(0, 0), cA, voffA); PG8_STAGE(PG8_SA(0, 1), cA + hstepA, voffA);
        if (wr == 1) PG8_BAR;
        PG8_WAIT_V(2); PG8_BAR;
        PG8_STAGE(PG8_SB(1, 0), cB + kstep, voffB); PG8_STAGE(PG8_SA(1, 0), cA + kstep, voffA); PG8_STAGE(PG8_SB(1, 1), cB + hstepB + kstep, voffB);
        PG8_WAIT_V(6); PG8_BAR;
    }
    for (;;) {
        const bool has_next = S.next(ui + 1, nxt);
        const char* nA = has_next ? (const char*)g.A + (size_t)nxt.pm * tstepA : cA; const char* nB = has_next ? (const char*)g.Bt + (size_t)nxt.pn * tstepB : cB;
        for (int t = 0; t < nt; t += 2) {
            const bool last = (t == nt - 2);
            if constexpr (Epi::HAS_MID) { if (t == nt1) E.mid(acc, cur, wr, wc, fr, fq); }
            const char* a0 = (t < nt1) ? cA + (size_t)t * kstep : cA2 + (size_t)(t - nt1) * kstep;
            const char* a1 = a0 + kstep;
            const char* a2 = last ? nA : ((t + 2 < nt1) ? cA + (size_t)(t + 2) * kstep : cA2 + (size_t)(t + 2 - nt1) * kstep);
            const char* b2 = last ? nB : ((t + 2 < nt1) ? cB + (size_t)(t + 2) * kstep : cB2 + (size_t)(t + 2 - nt1) * kstep);
            const char* a3 = a2 + kstep; const char* b3 = b2 + kstep;
            PG8_LDB(B0, 0, 0); PG8_LDB(B1, 0, 1); PG8_SCHED; PG8_LDA(At, 0, 0); PG8_STAGE(PG8_SA(1, 1), a1 + hstepA, voffA);
            PG8_WAIT_V(8); PG8_WAIT_L(0); PG8_BAR; PG8_MMA(0, 0, At, B0); PG8_MMA(0, 1, At, B1); PG8_BAR; PG8_SCHED;
            PG8_LDA(At, 0, 1); PG8_STAGE(PG8_SB(0, 0), b2, voffB); PG8_STAGE(PG8_SB(0, 1), b2 + hstepB, voffB); PG8_STAGE(PG8_SA(0, 0), a2, voffA);
            PG8_WAIT_V(8); PG8_WAIT_L(0); PG8_BAR; PG8_MMA(1, 0, At, B0); PG8_MMA(1, 1, At, B1); PG8_BAR; PG8_SCHED;
            PG8_LDB(B0, 1, 0); PG8_LDB(B1, 1, 1); PG8_SCHED; PG8_LDA(At, 1, 0); PG8_STAGE(PG8_SA(0, 1), a2 + hstepA, voffA);
            PG8_WAIT_V(8); PG8_WAIT_L(0); PG8_BAR; PG8_MMA(0, 0, At, B0); PG8_MMA(0, 1, At, B1); PG8_BAR; PG8_SCHED;
            PG8_LDA(At, 1, 1); PG8_STAGE(PG8_SB(1, 0), b3, voffB); PG8_STAGE(PG8_SB(1, 1), b3 + hstepB, voffB); PG8_STAGE(PG8_SA(1, 0), a3, voffA);
            PG8_WAIT_V(8); PG8_WAIT_L(0); PG8_BAR; PG8_MMA(1, 0, At, B0); PG8_MMA(1, 1, At, B1); PG8_BAR; PG8_SCHED;
        }
        if constexpr (ALIGN_EPI) { if (wr == 0) PG8_BAR; }
        if constexpr (!Epi::AFTER_DRAIN) { E(acc, cur, wr, wc, fr, fq); }
        if (!has_next) break;
#pragma unroll
        for (int a = 0; a < 2; ++a)
#pragma unroll
            for (int b = 0; b < 2; ++b)
#pragma unroll
                for (int m = 0; m < 4; ++m)
#pragma unroll
                    for (int n = 0; n < 2; ++n) acc[a][b][m][n] = (f32x4){0.f, 0.f, 0.f, 0.f};
        cur = nxt; cA = nA; cB = nB; ++ui;
        cA2 = (const char*)g.A2 + (size_t)cur.pm * tstepA; cB2 = (const char*)g.Bt2 + (size_t)cur.pn * tstepB;
        if constexpr (ALIGN_EPI) { if (wr == 1) PG8_BAR; }
    }
    PG8_WAIT_V(0);
    if constexpr (!ALIGN_EPI) { if (wr == 0) PG8_BAR; }
    PG8_BAR;
    if constexpr (Epi::AFTER_DRAIN) { E.fused(acc, cur, wr, wc, fr, fq, lds, wid, lane); }
#undef PG8_SA
#undef PG8_SB
#undef PG8_STAGE
#undef PG8_LDA
#undef PG8_LDB
#undef PG8_MMA
#undef PG8_WAIT_V
#undef PG8_WAIT_L
#undef PG8_BAR
#undef PG8_SCHED
}

__device__ __forceinline__ float row_rnorm(const float* rowss, int row) {
    const f32x4* p = (const f32x4*)(rowss + (size_t)row * 32);
    f32x4 t = p[0];
#pragma unroll
    for (int i = 1; i < 8; ++i) t += p[i];
    return __builtin_amdgcn_rsqf(((t[0] + t[1]) + (t[2] + t[3])) * (1.0f / 1024.0f) + EPS);
}

__device__ __forceinline__ void stage_rnorm(const float* rowss, int pm, int wr, int lane, PG8_LAS float* rn) {
    const int sub = lane >> 3, chunk = lane & 7;
#pragma unroll
    for (int it = 0; it < 16; ++it) {
        const int loc = it * 8 + sub;
        const int row = pm * BM + (loc >> 6) * HALF + wr * 64 + (loc & 63);
        const f32x4 t = *(const f32x4*)(rowss + (size_t)row * 32 + chunk * 4);
        float sm = (t[0] + t[1]) + (t[2] + t[3]);
        sm += __shfl_xor(sm, 1); sm += __shfl_xor(sm, 2); sm += __shfl_xor(sm, 4);
        if (chunk == 0) rn[loc] = __builtin_amdgcn_rsqf(sm * (1.0f / 1024.0f) + EPS);
    }
    asm volatile("s_waitcnt lgkmcnt(0)" ::: "memory");
}

template <bool NORM> struct EpiSwiGLU {
    static constexpr bool PERM = true, AFTER_DRAIN = false, HAS_MID = false;
    bf16_t* O; const float* rowss; const float* bias; PG8_LAS float* rnb;
    __device__ __forceinline__ void operator()(const f32x4 (&acc)[2][2][4][2], const Unit& u, int wr, int wc, int fr, int fq) const {
        const int row0 = u.pm * BM + wr * 64 + fr, b = u.pm >> 5;
        const int colB0 = u.pn * BM + wc * 32 + 8 * fq, ocol0 = u.pn * 128 + wc * 32 + 8 * fq;
        f32x4 bg[2], bu[2];
#pragma unroll
        for (int n = 0; n < 2; ++n) { bg[n] = NORM ? *(const f32x4*)(bias + (size_t)b * NGU + colB0 + 4 * n) : (f32x4){0.f, 0.f, 0.f, 0.f}; bu[n] = NORM ? *(const f32x4*)(bias + (size_t)b * NGU + colB0 + 128 + 4 * n) : (f32x4){0.f, 0.f, 0.f, 0.f}; }
        PG8_LAS float* rn = rnb + (wr * 4 + wc) * 128;
        if (NORM) stage_rnorm(rowss, u.pm, wr, fq * 16 + fr, rn);
#pragma unroll
        for (int ai = 0; ai < 2; ++ai)
#pragma unroll
            for (int m = 0; m < 4; ++m) {
                const int row = row0 + ai * HALF + m * 16;
                const float r = NORM ? rn[ai * 64 + m * 16 + fr] : 1.0f;
                float o[8];
#pragma unroll
                for (int n = 0; n < 2; ++n) {
                    f32x4 gv = acc[ai][0][m][n], uv = acc[ai][1][m][n];
                    if (NORM) { gv = gv * r + bg[n]; uv = uv * r + bu[n]; }
#pragma unroll
                    for (int j = 0; j < 4; ++j) o[4 * n + j] = siluf_(gv[j]) * uv[j];
                }
                u32x4 w; w.x = cvt_pk_bf16(o[0], o[1]); w.y = cvt_pk_bf16(o[2], o[3]); w.z = cvt_pk_bf16(o[4], o[5]); w.w = cvt_pk_bf16(o[6], o[7]);
                *(u32x4*)(O + (size_t)row * FF + ocol0) = w;
            }
    }
};

template <bool XS, int TAG> struct EpiResid {
    static constexpr bool PERM = true, AFTER_DRAIN = false, HAS_MID = false;
    const bf16_t* xin; bf16_t* xout; const float* gate; bf16_t* xs; const float* cs; float* rowss; float gscale;
    __device__ __forceinline__ void operator()(const f32x4 (&acc)[2][2][4][2], const Unit& u, int wr, int wc, int fr, int fq) const {
        const int row0 = u.pm * BM + wr * 64 + fr, b = u.pm >> 5, col0 = u.pn * BM + wc * 32 + 8 * fq;
        const float gsc = gscale;
#pragma unroll
        for (int bj = 0; bj < 2; ++bj) {
            const int c = col0 + bj * HALF;
            u32x4 xr[1][2][4];
#pragma unroll
            for (int ai = 0; ai < 2; ++ai)
#pragma unroll
                for (int m = 0; m < 4; ++m) xr[0][ai][m] = *(const u32x4*)(xin + (size_t)(row0 + ai * HALF + m * 16) * D + c);
            asm volatile("" ::: "memory");
            const f32x4 g0 = *(const f32x4*)(gate + (size_t)b * NADA + c), g1 = *(const f32x4*)(gate + (size_t)b * NADA + c + 4);
            const float gv[8] = {g0[0] * gsc, g0[1] * gsc, g0[2] * gsc, g0[3] * gsc, g1[0] * gsc, g1[1] * gsc, g1[2] * gsc, g1[3] * gsc};
            float cv[8];
            if (XS) { const f32x4 c0 = *(const f32x4*)(cs + (size_t)b * D + c), c1 = *(const f32x4*)(cs + (size_t)b * D + c + 4);
                cv[0] = c0[0]; cv[1] = c0[1]; cv[2] = c0[2]; cv[3] = c0[3]; cv[4] = c1[0]; cv[5] = c1[1]; cv[6] = c1[2]; cv[7] = c1[3]; }
#pragma unroll
            for (int ai = 0; ai < 2; ++ai)
#pragma unroll
                for (int m = 0; m < 4; ++m) {
                    const int row = row0 + ai * HALF + m * 16; const size_t off = (size_t)row * D + c;
                    const u32x4 a = xr[0][ai][m];
                    const f32x4 a0 = acc[ai][bj][m][0], a1 = acc[ai][bj][m][1];
                    float v[8] = {bflo(a.x) + gv[0] * a0[0], bfhi(a.x) + gv[1] * a0[1], bflo(a.y) + gv[2] * a0[2], bfhi(a.y) + gv[3] * a0[3],
                                  bflo(a.z) + gv[4] * a1[0], bfhi(a.z) + gv[5] * a1[1], bflo(a.w) + gv[6] * a1[2], bfhi(a.w) + gv[7] * a1[3]};
                    float ss = 0.f;
#pragma unroll
                    for (int j = 0; j < 8; ++j) ss += v[j] * v[j];
                    u32x4 w; w.x = cvt_pk_bf16(v[0], v[1]); w.y = cvt_pk_bf16(v[2], v[3]); w.z = cvt_pk_bf16(v[4], v[5]); w.w = cvt_pk_bf16(v[6], v[7]);
                    *(u32x4*)(xout + off) = w;
                    if (XS) { u32x4 w2; w2.x = cvt_pk_bf16(v[0] * cv[0], v[1] * cv[1]); w2.y = cvt_pk_bf16(v[2] * cv[2], v[3] * cv[3]); w2.z = cvt_pk_bf16(v[4] * cv[4], v[5] * cv[5]); w2.w = cvt_pk_bf16(v[6] * cv[6], v[7] * cv[7]);
                        *(u32x4*)(xs + off) = w2; }
                    ss += __shfl_xor(ss, 16); ss += __shfl_xor(ss, 32);
                    if (fq == 0) rowss[(size_t)row * 32 + (u.pn * 4 + wc) * 2 + bj] = ss;
                }
            asm volatile("" ::: "memory");
        }
    }
};

struct EpiIn {
    static constexpr bool PERM = true, AFTER_DRAIN = false, HAS_MID = false;
    const float* rowss; const float* bias; bf16_t* q; bf16_t* k; bf16_t* v; bf16_t* ssmA; unsigned char* sga; unsigned char* sgs; float* kmeanp; PG8_LAS float* rnb;
    __device__ __forceinline__ void operator()(const f32x4 (&acc)[2][2][4][2], const Unit& u, int wr, int wc, int fr, int fq) const {
        const int row0 = u.pm * BM + wr * 64 + fr, b = u.pm >> 5, nb = u.pm & 31;
        const int c0 = u.pn * BM + wc * 32 + 8 * fq;
        const int region = u.pn >> 1;
        f32x4 bv[2][2];
#pragma unroll
        for (int bj = 0; bj < 2; ++bj)
#pragma unroll
            for (int n = 0; n < 2; ++n) bv[bj][n] = *(const f32x4*)(bias + (size_t)b * NIN + c0 + bj * HALF + 4 * n);
        float cs[2][8];
#pragma unroll
        for (int bj = 0; bj < 2; ++bj)
#pragma unroll
            for (int j = 0; j < 8; ++j) cs[bj][j] = 0.f;
        PG8_LAS float* rn = rnb + (wr * 4 + wc) * 128;
        stage_rnorm(rowss, u.pm, wr, fq * 16 + fr, rn);
#pragma unroll
        for (int ai = 0; ai < 2; ++ai)
#pragma unroll
            for (int m = 0; m < 4; ++m) {
                const int row = row0 + ai * HALF + m * 16;
                const float r = rn[ai * 64 + m * 16 + fr];
#pragma unroll
                for (int bj = 0; bj < 2; ++bj) {
                    const f32x4 v0 = acc[ai][bj][m][0] * r + bv[bj][0], v1 = acc[ai][bj][m][1] * r + bv[bj][1];
                    float o[8] = {v0[0], v0[1], v0[2], v0[3], v1[0], v1[1], v1[2], v1[3]};
                    const int c = c0 + bj * HALF;
                    bf16_t* dst;
                    if (region == 0) {
#pragma unroll
                        for (int j = 0; j < 8; ++j) o[j] *= QSCALE;
                        dst = q + (size_t)row * AW + c;
                    } else if (region == 1) {
#pragma unroll
                        for (int j = 0; j < 8; ++j) cs[bj][j] += o[j];
                        dst = k + (size_t)row * AW + (c - 512);
                    } else if (region == 2) {
                        dst = v + (size_t)row * AW + (c - 1024);
                    } else if (region == 3) {
                        const int cc = c - 1536, gidx = cc >> 4, ch = cc & 15, t = row & (SEQ - 1);
                        dst = ssmA + ((size_t)(gidx * 1024 + b * NCH + (t >> 5)) * KSSM + (t & 31) * SC + ch);
                    } else {
                        unsigned qv[8];
#pragma unroll
                        for (int j = 0; j < 8; ++j) { const unsigned t_ = (unsigned)(sigmoidf_(o[j]) * 256.0f); qv[j] = t_ > 255u ? 255u : t_; }
                        v2u w8; w8.x = qv[0] | (qv[1] << 8) | (qv[2] << 16) | (qv[3] << 24); w8.y = qv[4] | (qv[5] << 8) | (qv[6] << 16) | (qv[7] << 24);
                        unsigned char* g8 = (region < 6) ? sga + (size_t)row * D + (c - 2048) : sgs + (size_t)row * D + (c - 3072);
                        *(v2u*)g8 = w8;
                        continue;
                    }
                    u32x4 w; w.x = cvt_pk_bf16(o[0], o[1]); w.y = cvt_pk_bf16(o[2], o[3]); w.z = cvt_pk_bf16(o[4], o[5]); w.w = cvt_pk_bf16(o[6], o[7]);
                    *(u32x4*)dst = w;
                }
            }
        if (region == 1) {
#pragma unroll
            for (int bj = 0; bj < 2; ++bj)
#pragma unroll
                for (int j = 0; j < 8; ++j) { float s = cs[bj][j]; s += __shfl_xor(s, 1); s += __shfl_xor(s, 2); s += __shfl_xor(s, 4); s += __shfl_xor(s, 8); cs[bj][j] = s; }
            if (fr == 0) {
#pragma unroll
                for (int bj = 0; bj < 2; ++bj) {
                    float* dstp = kmeanp + ((size_t)((b * NBLK + nb) * 2 + wr) * AW + (c0 + bj * HALF - 512));
                    *(f32x4*)dstp = (f32x4){cs[bj][0], cs[bj][1], cs[bj][2], cs[bj][3]}; *(f32x4*)(dstp + 4) = (f32x4){cs[bj][4], cs[bj][5], cs[bj][6], cs[bj][7]};
                }
            }
        }
    }
};

struct EpiGlu {
    static constexpr bool PERM = true, AFTER_DRAIN = false, HAS_MID = false;
    const bf16_t* y1; const float* bglu; bf16_t* yssm;
    __device__ __forceinline__ void operator()(const f32x4 (&acc)[2][2][4][2], const Unit& u, int wr, int wc, int fr, int fq) const {
        const int row0 = u.pm * BM + wr * 64 + fr, c0 = u.pn * BM + wc * 32 + 8 * fq;
        f32x4 bv[2][2];
#pragma unroll
        for (int bj = 0; bj < 2; ++bj)
#pragma unroll
            for (int n = 0; n < 2; ++n) bv[bj][n] = *(const f32x4*)(bglu + c0 + bj * HALF + 4 * n);
#pragma unroll
        for (int ai = 0; ai < 2; ++ai)
#pragma unroll
            for (int m = 0; m < 4; ++m) {
                const int row = row0 + ai * HALF + m * 16;
#pragma unroll
                for (int bj = 0; bj < 2; ++bj) {
                    const size_t off = (size_t)row * SW + c0 + bj * HALF;
                    const u32x4 yv = *(const u32x4*)(y1 + off);
                    const f32x4 z0 = acc[ai][bj][m][0] + bv[bj][0], z1 = acc[ai][bj][m][1] + bv[bj][1];
                    float o[8];
                    o[0] = bflo(yv.x) * sigmoidf_(z0[0]); o[1] = bfhi(yv.x) * sigmoidf_(z0[1]); o[2] = bflo(yv.y) * sigmoidf_(z0[2]); o[3] = bfhi(yv.y) * sigmoidf_(z0[3]);
                    o[4] = bflo(yv.z) * sigmoidf_(z1[0]); o[5] = bfhi(yv.z) * sigmoidf_(z1[1]); o[6] = bflo(yv.w) * sigmoidf_(z1[2]); o[7] = bfhi(yv.w) * sigmoidf_(z1[3]);
                    u32x4 w; w.x = cvt_pk_bf16(o[0], o[1]); w.y = cvt_pk_bf16(o[2], o[3]); w.z = cvt_pk_bf16(o[4], o[5]); w.w = cvt_pk_bf16(o[6], o[7]);
                    *(u32x4*)(yssm + off) = w;
                }
            }
    }
};

__device__ __forceinline__ float gq(unsigned w, int i) { return (float)((w >> (8 * i)) & 255u) + 0.5f; }
struct EpiMerge {
    static constexpr bool PERM = true, AFTER_DRAIN = false, HAS_MID = true;
    const unsigned char* sga; const unsigned char* sgs; bf16_t* merged;
    __device__ __forceinline__ void mid(f32x4 (&acc)[2][2][4][2], const Unit& u, int wr, int wc, int fr, int fq) const {
        int row0 = u.pm * BM + wr * 64 + fr, c0 = u.pn * BM + wc * 32 + 8 * fq;
        asm volatile("" : "+v"(row0), "+v"(c0));
        v2u av[2][4][2], sv[2][4][2];
#pragma unroll
        for (int ai = 0; ai < 2; ++ai)
#pragma unroll
            for (int m = 0; m < 4; ++m)
#pragma unroll
                for (int bj = 0; bj < 2; ++bj) { const size_t off = (size_t)(row0 + ai * HALF + m * 16) * D + c0 + bj * HALF; av[ai][m][bj] = *(const v2u*)(sga + off); sv[ai][m][bj] = *(const v2u*)(sgs + off); }
        asm volatile("" ::: "memory");
#pragma unroll
        for (int ai = 0; ai < 2; ++ai)
#pragma unroll
            for (int m = 0; m < 4; ++m)
#pragma unroll
                for (int bj = 0; bj < 2; ++bj) {
                    const v2u a = av[ai][m][bj], sq = sv[ai][m][bj];
                    f32x4 r0, r1;
#pragma unroll
                    for (int j = 0; j < 4; ++j) { r0[j] = gq(a.x, j) * fast_rcp(gq(sq.x, j)); r1[j] = gq(a.y, j) * fast_rcp(gq(sq.y, j)); }
                    acc[ai][bj][m][0] *= r0; acc[ai][bj][m][1] *= r1;
                }
    }
    __device__ __forceinline__ void operator()(const f32x4 (&acc)[2][2][4][2], const Unit& u, int wr, int wc, int fr, int fq) const {
        const int row0 = u.pm * BM + wr * 64 + fr, c0 = u.pn * BM + wc * 32 + 8 * fq;
        v2u sv[2][4][2];
#pragma unroll
        for (int ai = 0; ai < 2; ++ai)
#pragma unroll
            for (int m = 0; m < 4; ++m)
#pragma unroll
                for (int bj = 0; bj < 2; ++bj) sv[ai][m][bj] = *(const v2u*)(sgs + (size_t)(row0 + ai * HALF + m * 16) * D + c0 + bj * HALF);
        asm volatile("" ::: "memory");
        const float sc = 1.0f / 256.0f;
#pragma unroll
        for (int ai = 0; ai < 2; ++ai)
#pragma unroll
            for (int m = 0; m < 4; ++m)
#pragma unroll
                for (int bj = 0; bj < 2; ++bj) {
                    const size_t off = (size_t)(row0 + ai * HALF + m * 16) * D + c0 + bj * HALF;
                    const v2u sq = sv[ai][m][bj];
                    const f32x4 v0 = acc[ai][bj][m][0] * sc, v1 = acc[ai][bj][m][1] * sc;
                    u32x4 w; w.x = cvt_pk_bf16(v0[0] * gq(sq.x, 0), v0[1] * gq(sq.x, 1)); w.y = cvt_pk_bf16(v0[2] * gq(sq.x, 2), v0[3] * gq(sq.x, 3));
                    w.z = cvt_pk_bf16(v1[0] * gq(sq.y, 0), v1[1] * gq(sq.y, 1)); w.w = cvt_pk_bf16(v1[2] * gq(sq.y, 2), v1[3] * gq(sq.y, 3));
                    *(u32x4*)(merged + off) = w;
                }
    }
};

struct EpiSsmState {
    static constexpr bool PERM = false, AFTER_DRAIN = true, HAS_MID = false;
    bf16_t* ssmA; const float* lam_re; const float* lam_im; const float* log_dt;
    __device__ __forceinline__ void fused(f32x4 (&acc)[2][2][4][2], const Unit& u, int wr, int wc, int fr, int fq, PG8_LAS unsigned char* lds, int wid, int lane) const {
        PG8_LAS float* X = (PG8_LAS float*)lds;
        PG8_LAS float* Eb = (PG8_LAS float*)(lds + 135168);
#pragma unroll
        for (int ai = 0; ai < 2; ++ai)
#pragma unroll
            for (int m = 0; m < 4; ++m)
#pragma unroll
                for (int n = 0; n < 2; ++n) *(PG8_LAS f32x4*)(X + (ai * HALF + wr * 64 + m * 16 + fr) * 132 + wc * 32 + n * 16 + 4 * fq) = acc[ai][0][m][n];
        asm volatile("s_waitcnt lgkmcnt(0)" ::: "memory"); __builtin_amdgcn_s_barrier(); asm volatile("" ::: "memory");
        const int g = u.pn, p = lane, seg = wid;
        const float lr = lam_re[g * SP + p], li = lam_im[g * SP + p], dt = __expf(log_dt[g]);
        float ar, ai_; { float sn, cs; __sincosf(li * dt, &sn, &cs); const float mg = __expf(lr * dt); ar = mg * cs; ai_ = mg * sn; }
        float sr = ar, si = ai_;
#pragma unroll
        for (int q = 0; q < 5; ++q) { const float t0 = sr * sr - si * si, t1 = 2.f * sr * si; sr = t0; si = t1; }
        const float aLr = sr, aLi = si;
#pragma unroll
        for (int q = 0; q < 5; ++q) { const float t0 = sr * sr - si * si, t1 = 2.f * sr * si; sr = t0; si = t1; }
        const float aSr = sr, aSi = si;
        const PG8_LAS float* Xs = X + (seg * 32) * 132 + p;
        float er = 0.f, ei = 0.f;
#pragma unroll 8
        for (int r = 0; r < 32; ++r) { const float xr = Xs[r * 132], xi = Xs[r * 132 + 64]; const float nr = aLr * er - aLi * ei + xr, ni = aLr * ei + aLi * er + xi; er = nr; ei = ni; }
        Eb[(seg * 64 + p) * 2] = er; Eb[(seg * 64 + p) * 2 + 1] = ei;
        asm volatile("s_waitcnt lgkmcnt(0)" ::: "memory"); __builtin_amdgcn_s_barrier(); asm volatile("" ::: "memory");
        float cr = 0.f, ci = 0.f;
        for (int s2 = 0; s2 < seg; ++s2) { const float xr = Eb[(s2 * 64 + p) * 2], xi = Eb[(s2 * 64 + p) * 2 + 1]; const float nr = aSr * cr - aSi * ci + xr, ni = aSr * ci + aSi * cr + xi; cr = nr; ci = ni; }
        bf16_t* dst = ssmA + ((size_t)(u.pm * BM + seg * 32) * KSSM + 512 + p);
#pragma unroll 8
        for (int r = 0; r < 32; ++r) {
            dst[(size_t)r * KSSM] = (bf16_t)f2bf(cr); dst[(size_t)r * KSSM + 64] = (bf16_t)f2bf(ci);
            const float xr = Xs[r * 132], xi = Xs[r * 132 + 64]; const float nr = aLr * cr - aLi * ci + xr, ni = aLr * ci + aLi * cr + xi; cr = nr; ci = ni;
        }
        asm volatile("s_waitcnt lgkmcnt(0)" ::: "memory"); __builtin_amdgcn_s_barrier(); asm volatile("" ::: "memory");
    }
};

struct EpiSsmMain {
    static constexpr bool PERM = true, AFTER_DRAIN = false, HAS_MID = false;
    const bf16_t* ssmA; const float* dsk; bf16_t* y1;
    __device__ __forceinline__ void operator()(const f32x4 (&acc)[2][2][4][2], const Unit& u, int wr, int wc, int fr, int fq) const {
        const int g = u.pn >> 1, b = u.pm & 3, cbase = (u.pn & 1) * BM + wc * 32 + 8 * fq;
        const int rloc0 = wr * 64 + fr;
#pragma unroll
        for (int bj = 0; bj < 2; ++bj) {
            const int c = cbase + bj * HALF, s = c >> 4, ch0 = c & 15;
            const f32x4 d0 = *(const f32x4*)(dsk + g * SC + ch0), d1 = *(const f32x4*)(dsk + g * SC + ch0 + 4);
#pragma unroll
            for (int ai = 0; ai < 2; ++ai)
#pragma unroll
                for (int m = 0; m < 4; ++m) {
                    const int rloc = rloc0 + ai * HALF + m * 16;
                    const u32x4 uv = *(const u32x4*)(ssmA + (size_t)(u.pm * BM + rloc) * KSSM + c);
                    const f32x4 v0 = acc[ai][bj][m][0], v1 = acc[ai][bj][m][1];
                    float o[8];
                    o[0] = v0[0] + d0[0] * bflo(uv.x); o[1] = v0[1] + d0[1] * bfhi(uv.x); o[2] = v0[2] + d0[2] * bflo(uv.y); o[3] = v0[3] + d0[3] * bfhi(uv.y);
                    o[4] = v1[0] + d1[0] * bflo(uv.z); o[5] = v1[1] + d1[1] * bfhi(uv.z); o[6] = v1[2] + d1[2] * bflo(uv.w); o[7] = v1[3] + d1[3] * bfhi(uv.w);
#pragma unroll
                    for (int j = 0; j < 8; ++j) o[j] = gelu_tanh(o[j]);
                    u32x4 w; w.x = cvt_pk_bf16(o[0], o[1]); w.y = cvt_pk_bf16(o[2], o[3]); w.z = cvt_pk_bf16(o[4], o[5]); w.w = cvt_pk_bf16(o[6], o[7]);
                    *(u32x4*)(y1 + (size_t)(b * SEQ + rloc * SL + s) * SW + g * SC + ch0) = w;
                }
        }
    }
};
}


#define XB_TMO      128
#define XB_XCNT(j)  (256  + 64 * (j))
#define XB_XSUB(j)  (1280 + 64 * (j))
#define XB_XGEN(j)  (2304 + 64 * (j))
#define XB_TOP      3328
#define XB_TOPGEN   3392
#define XCD_BAR_WORDS 3456
#define XB_SPIN_CAP (1u << 20)

__device__ __forceinline__ unsigned xb_ld(unsigned* p)              { return __hip_atomic_load(p, __ATOMIC_RELAXED, __HIP_MEMORY_SCOPE_AGENT); }
__device__ __forceinline__ unsigned xb_add(unsigned* p, unsigned v) { return __hip_atomic_fetch_add(p, v, __ATOMIC_RELAXED, __HIP_MEMORY_SCOPE_AGENT); }
__device__ __forceinline__ unsigned xb_xcc_id() { return (unsigned)__builtin_amdgcn_s_getreg((3 << 11) | 20) & 0xFu; }
#define XB_SPIN(cond, bar) do { unsigned _sp = 0; while (cond) { __builtin_amdgcn_s_sleep(1); \
    if ((++_sp & 255u) == 0u) { if (xb_ld(&(bar)[XB_TMO])) break; if (_sp > XB_SPIN_CAP) { atomicAdd(&(bar)[XB_TMO], 1u); break; } } } } while (0)

struct XcdBarrier { unsigned* bar; unsigned x; volatile LAS unsigned* st; };
__device__ __forceinline__ XcdBarrier xcd_barrier_post(unsigned* bar, volatile LAS unsigned* st) {
    XcdBarrier b; b.bar = bar; b.x = xb_xcc_id(); b.st = st;
    if (threadIdx.x == 0) (void)xb_add(&bar[XB_XCNT(b.x)], 1u);
    return b;
}
__device__ __forceinline__ void xcd_barrier_complete(unsigned* bar, unsigned x, unsigned& nloc, unsigned& nx) {
    const unsigned G = gridDim.x * gridDim.y * gridDim.z;
    unsigned sum, cnt, mine, sp = 0u;
    for (;;) {
        sum = 0u; cnt = 0u; mine = 0u;
#pragma unroll
        for (unsigned j = 0; j < 16; ++j) { const unsigned c = xb_ld(&bar[XB_XCNT(j)]); sum += c; cnt += (c > 0u) ? 1u : 0u; mine = (j == x) ? c : mine; }
        if (sum == G) break;
        __builtin_amdgcn_s_sleep(1);
        if ((++sp & 255u) == 0u) { if (xb_ld(&bar[XB_TMO])) break; if (sp > XB_SPIN_CAP) { atomicAdd(&bar[XB_TMO], 1u); break; } }
    }
    nloc = mine > 0u ? mine : 1u; nx = cnt > 0u ? cnt : 1u;
}
__device__ __forceinline__ void xcd_barrier(const XcdBarrier& b) {
    asm volatile("s_waitcnt vmcnt(0)" ::: "memory");
    __syncthreads();
    if (threadIdx.x == 0) {
        unsigned* bar = b.bar;
        __builtin_amdgcn_s_waitcnt(0);
        unsigned nloc = b.st[0], nx = b.st[1];
        if (nloc == 0u) { xcd_barrier_complete(bar, b.x, nloc, nx); b.st[0] = nloc; b.st[1] = nx; }
        const unsigned old = xb_add(&bar[XB_XSUB(b.x)], 1u);
        const unsigned gen = old / nloc;
        if (old + 1u == (gen + 1u) * nloc) {
            __builtin_amdgcn_fence(__ATOMIC_RELEASE, "agent");
            asm volatile("s_waitcnt vmcnt(0)" ::: "memory");
            const unsigned og = xb_add(&bar[XB_TOP], 1u);
            const unsigned tg = og / nx;
            if (og + 1u == (tg + 1u) * nx) xb_add(&bar[XB_TOPGEN], 1u);
            else XB_SPIN(xb_ld(&bar[XB_TOPGEN]) == tg, bar);
            __builtin_amdgcn_fence(__ATOMIC_ACQUIRE, "agent");
            xb_add(&bar[XB_XGEN(b.x)], 1u);
            asm volatile("s_waitcnt vmcnt(0)" ::: "memory");
        } else {
            XB_SPIN(xb_ld(&bar[XB_XGEN(b.x)]) == gen, bar);
            __builtin_amdgcn_fence(__ATOMIC_ACQUIRE, "agent");
            asm volatile("s_waitcnt vmcnt(0)" ::: "memory");
        }
    }
    __syncthreads();
}

struct Frame {
    LAS unsigned char* lds;
    volatile LAS unsigned* MISC;
    gu32* ctl;
    int tid, lane, wave, vcu, G;
    unsigned char* ws;
    const float* in[26];
    float* out;
};
enum { IN_X = 0, IN_C, IN_WADA, IN_BADA, IN_NFFN1, IN_WFFN1IN, IN_WFFN1OUT, IN_NMIX, IN_WIN, IN_LAMRE, IN_LAMIM, IN_LOGDT, IN_BRE, IN_BIM, IN_CRE, IN_CIM, IN_SSMD,
       IN_WGLU, IN_BGLU, IN_WBRATT, IN_WBRSSM, IN_WOUT, IN_NFFN2, IN_WFFN2IN, IN_WFFN2OUT, IN_NFINAL };

__device__ __forceinline__ int gu_row(int n) { return n < FF ? ((n >> 7) << 8) + (n & 127) : (((n - FF) >> 7) << 8) + 128 + ((n - FF) & 127); }
__device__ __forceinline__ void p0_transpose_item(const float* W, int K, int N, bf16* WT, int mode, LAS float* scr, int item, int lane) {
    const int nblk = N / 32, kb = item / nblk, nb = item % nblk, k0 = 64 * kb, n0 = 32 * nb;
    const int r0 = mode ? gu_row(n0) : n0;
#pragma unroll 8
    for (int i = 0; i < 32; ++i) { const int kk = 2 * i + (lane >> 5); scr[kk * 33 + (lane & 31)] = W[(size_t)(k0 + kk) * N + n0 + (lane & 31)]; }
    LDS_WAIT(); asm volatile("" ::: "memory");
    const int c = lane & 7;
#pragma unroll
    for (int j = 0; j < 4; ++j) { const int n = (lane >> 3) + 8 * j; const LAS float* s = scr + (8 * c) * 33 + n;
        v4u o; o.x = pk2(s[0 * 33], s[1 * 33]); o.y = pk2(s[2 * 33], s[3 * 33]); o.z = pk2(s[4 * 33], s[5 * 33]); o.w = pk2(s[6 * 33], s[7 * 33]);
        *(GAS v4u*)(WT + (size_t)(r0 + n) * K + k0 + 8 * c) = o; }
    LDS_WAIT(); asm volatile("" ::: "memory");
}

__device__ __forceinline__ void ssm_lane_params(const Frame& F, int g, int p, float& lr_dt, float& li_dt, float& fr, float& fi) {
    const float lr = F.in[IN_LAMRE][g * SP + p], li = F.in[IN_LAMIM][g * SP + p], dt = __expf(F.in[IN_LOGDT][g]);
    lr_dt = lr * dt; li_dt = li * dt;
    float sn, cs; __sincosf(li_dt, &sn, &cs); const float mg = __expf(lr_dt);
    const float nr = mg * cs - 1.0f, ni = mg * sn, den = lr * lr + li * li;
    fr = (nr * lr + ni * li) / den; fi = (ni * lr - nr * li) / den;
}
__device__ __forceinline__ void cpow(float lr_dt, float li_dt, float n, float& pr, float& pi) { float sn, cs; __sincosf(li_dt * n, &sn, &cs); const float mg = __expf(lr_dt * n); pr = mg * cs; pi = mg * sn; }

__device__ __forceinline__ void p0_ssm_kmat_item(const Frame& F, int item, LAS float* scr) {
    const int g = item / 63, lag = item % 63 - 31, lane = F.lane;
    bf16* Bm = (bf16*)(F.ws + WS_BM) + (size_t)g * 512 * KSSM;
    const int co = lane >> 2, ci0 = (lane & 3) * 4;
    float k0 = 0.f, k1 = 0.f, k2 = 0.f, k3 = 0.f;
    if (lag >= 0) {
        LAS float* Dre = scr; LAS float* Dim = scr + 1024; LAS float* Cre = scr + 2048; LAS float* Cim = scr + 3072;
        float lr_dt, li_dt, fr, fi; ssm_lane_params(F, g, lane, lr_dt, li_dt, fr, fi);
        float pr, pi; cpow(lr_dt, li_dt, (float)lag, pr, pi);
#pragma unroll
        for (int c = 0; c < 16; c += 4) {
            f32x4 dr, di, cr4, ci4;
#pragma unroll
            for (int e = 0; e < 4; ++e) {
                const float br = F.in[IN_BRE][(g * SP + lane) * SC + c + e], bi = F.in[IN_BIM][(g * SP + lane) * SC + c + e];
                const float bbr = fr * br - fi * bi, bbi = fr * bi + fi * br;
                dr[e] = pr * bbr - pi * bbi; di[e] = pr * bbi + pi * bbr;
                cr4[e] = F.in[IN_CRE][(g * SC + c + e) * SP + lane]; ci4[e] = F.in[IN_CIM][(g * SC + c + e) * SP + lane];
            }
            *(LAS f32x4*)(Dre + lane * 16 + c) = dr; *(LAS f32x4*)(Dim + lane * 16 + c) = di; *(LAS f32x4*)(Cre + lane * 16 + c) = cr4; *(LAS f32x4*)(Cim + lane * 16 + c) = ci4;
        }
        LDS_WAIT(); asm volatile("" ::: "memory");
#pragma unroll 4
        for (int p = 0; p < 64; ++p) {
            const float cr = Cre[p * 16 + co], cim = Cim[p * 16 + co];
            const f32x4 dr = *(const LAS f32x4*)(Dre + p * 16 + ci0), di = *(const LAS f32x4*)(Dim + p * 16 + ci0);
            k0 += cr * dr[0] - cim * di[0]; k1 += cr * dr[1] - cim * di[1]; k2 += cr * dr[2] - cim * di[2]; k3 += cr * dr[3] - cim * di[3];
        }
        LDS_WAIT(); asm volatile("" ::: "memory");
    }
    const unsigned long long w = (unsigned long long)pk2(k0, k1) | ((unsigned long long)pk2(k2, k3) << 32);
    const int alag = lag < 0 ? -lag : lag;
    for (int i = 0; i < 32 - alag; ++i) { const int sI = lag >= 0 ? i + lag : i, tI = lag >= 0 ? i : i + alag;
        *(GAS unsigned long long*)(Bm + (size_t)(sI * 16 + co) * KSSM + tI * 16 + ci0) = w; }
}
__device__ __forceinline__ void p0_ssm_vs_item(const Frame& F, int item) {
    const int g = item >> 5, s = item & 31, p = F.lane;
    float lr_dt, li_dt, fr, fi; ssm_lane_params(F, g, p, lr_dt, li_dt, fr, fi);
    {
        float pr, pi; cpow(lr_dt, li_dt, (float)(s + 1), pr, pi);
        bf16* Bm = (bf16*)(F.ws + WS_BM) + (size_t)g * 512 * KSSM;
#pragma unroll
        for (int co = 0; co < 16; ++co) {
            const float cr = F.in[IN_CRE][(g * SC + co) * SP + p], ci = F.in[IN_CIM][(g * SC + co) * SP + p];
            bf16* row = Bm + (size_t)(s * 16 + co) * KSSM + 512;
            row[p] = (bf16)f2bf(cr * pr - ci * pi); row[64 + p] = (bf16)f2bf(-(cr * pi + ci * pr));
        }
    }
    {
        float pr, pi; cpow(lr_dt, li_dt, (float)(31 - s), pr, pi);
        bf16* Bs = (bf16*)(F.ws + WS_BS) + (size_t)g * 256 * 512;
        unsigned wr_[8], wi_[8];
#pragma unroll
        for (int c = 0; c < 16; c += 2) {
            float vr[2], vi[2];
#pragma unroll
            for (int e = 0; e < 2; ++e) { const float br = F.in[IN_BRE][(g * SP + p) * SC + c + e], bi = F.in[IN_BIM][(g * SP + p) * SC + c + e];
                const float bbr = fr * br - fi * bi, bbi = fr * bi + fi * br; vr[e] = pr * bbr - pi * bbi; vi[e] = pr * bbi + pi * bbr; }
            wr_[c >> 1] = pk2(vr[0], vr[1]); wi_[c >> 1] = pk2(vi[0], vi[1]);
        }
        GAS v4u* d0 = (GAS v4u*)(Bs + (size_t)p * 512 + s * 16); GAS v4u* d1 = (GAS v4u*)(Bs + (size_t)(64 + p) * 512 + s * 16);
        GAS v4u* z0 = (GAS v4u*)(Bs + (size_t)(128 + p) * 512 + s * 16); GAS v4u* z1 = (GAS v4u*)(Bs + (size_t)(192 + p) * 512 + s * 16);
        d0[0] = (v4u){wr_[0], wr_[1], wr_[2], wr_[3]}; d0[1] = (v4u){wr_[4], wr_[5], wr_[6], wr_[7]};
        d1[0] = (v4u){wi_[0], wi_[1], wi_[2], wi_[3]}; d1[1] = (v4u){wi_[4], wi_[5], wi_[6], wi_[7]};
        z0[0] = (v4u){0u, 0u, 0u, 0u}; z0[1] = (v4u){0u, 0u, 0u, 0u}; z1[0] = (v4u){0u, 0u, 0u, 0u}; z1[1] = (v4u){0u, 0u, 0u, 0u};
    }
}

__device__ __forceinline__ void p0_prologue(Frame& F) {
    LAS float* sl = (LAS float*)(F.lds + SILU_OFF);
    for (int i = F.tid; i < BATCH * D; i += NWAVES * 64) sl[i] = siluf_(F.in[IN_C][i]);
    __syncthreads();
    LAS float* scr = (LAS float*)(F.lds + RING_OFF + F.wave * 16384);
    const int gw = F.vcu * NWAVES + F.wave, NGW = F.G * NWAVES;
    bf16* ws16 = (bf16*)F.ws;
    constexpr int I_ADA = NADA / 64;
    constexpr int I_UP = (D / 64) * (NGU / 32), I_DN = (FF / 64) * (D / 32), I_IN = (D / 64) * (NIN / 32), I_GLU = (SW / 64) * (SW / 32), I_BR = (AW / 64) * (D / 32), I_OUT = (D / 64) * (D / 32);
    constexpr int I_KM = SG * 63, I_VS = SG * 32;
    constexpr int NITEMS = I_ADA + I_KM + I_VS + 2 * I_UP + 2 * I_DN + I_IN + I_GLU + 2 * I_BR + I_OUT;
    for (int it = gw; it < NITEMS; it += NGW) {
        int r = it;
        if (r < I_ADA) {
            const int n = r * 64 + F.lane; const float* W = F.in[IN_WADA] + n;
            float a0 = 0.f, a1 = 0.f, a2 = 0.f, a3 = 0.f;
#pragma unroll 2
            for (int k = 0; k < D; k += 4) {
                const f32x4 s0 = *(const LAS f32x4*)(sl + k), s1 = *(const LAS f32x4*)(sl + D + k), s2 = *(const LAS f32x4*)(sl + 2 * D + k), s3 = *(const LAS f32x4*)(sl + 3 * D + k);
#pragma unroll
                for (int i = 0; i < 4; ++i) { const float w = W[(size_t)(k + i) * NADA]; a0 += s0[i] * w; a1 += s1[i] * w; a2 += s2[i] * w; a3 += s3[i] * w; }
            }
            float* ada = (float*)(F.ws + WS_ADA); const float bb = F.in[IN_BADA][n];
            ada[n] = a0 + bb; ada[NADA + n] = a1 + bb; ada[2 * NADA + n] = a2 + bb; ada[3 * NADA + n] = a3 + bb;
            continue;
        }
        r -= I_ADA;
        if (r < I_KM) { p0_ssm_kmat_item(F, r, scr); continue; } r -= I_KM;
        if (r < I_VS) { p0_ssm_vs_item(F, r); continue; } r -= I_VS;
        if (r < I_UP) { p0_transpose_item(F.in[IN_WFFN1IN], D, NGU, ws16 + WS_W1T / 2, 1, scr, r, F.lane); continue; } r -= I_UP;
        if (r < I_UP) { p0_transpose_item(F.in[IN_WFFN2IN], D, NGU, ws16 + WS_W3T / 2, 1, scr, r, F.lane); continue; } r -= I_UP;
        if (r < I_DN) { p0_transpose_item(F.in[IN_WFFN1OUT], FF, D, ws16 + WS_W2T / 2, 0, scr, r, F.lane); continue; } r -= I_DN;
        if (r < I_DN) { p0_transpose_item(F.in[IN_WFFN2OUT], FF, D, ws16 + WS_W4T / 2, 0, scr, r, F.lane); continue; } r -= I_DN;
        if (r < I_IN) { p0_transpose_item(F.in[IN_WIN], D, NIN, ws16 + WS_WINT / 2, 0, scr, r, F.lane); continue; } r -= I_IN;
        if (r < I_GLU) { p0_transpose_item(F.in[IN_WGLU], SW, SW, ws16 + WS_WGLU / 2, 0, scr, r, F.lane); continue; } r -= I_GLU;
        if (r < I_BR) { p0_transpose_item(F.in[IN_WBRATT], AW, D, ws16 + WS_WBRA / 2, 0, scr, r, F.lane); continue; } r -= I_BR;
        if (r < I_BR) { p0_transpose_item(F.in[IN_WBRSSM], SW, D, ws16 + WS_WBRS / 2, 0, scr, r, F.lane); continue; } r -= I_BR;
        p0_transpose_item(F.in[IN_WOUT], D, D, ws16 + WS_WOUT / 2, 0, scr, r, F.lane);
    }
}

__device__ __forceinline__ void p1_phase(Frame& F) {
    const int gw = F.vcu * NWAVES + F.wave, NGW = F.G * NWAVES;
    const float* ada = (const float*)(F.ws + WS_ADA);
    for (int i = gw * 64 + F.lane; i < 2 * BATCH * D; i += NGW * 64) {
        const int which = i / (BATCH * D), r = i % (BATCH * D), b = r / D, c = r % D;
        const float gwt = which ? F.in[IN_NFFN2][c] : F.in[IN_NMIX][c];
        const float sc = ada[b * NADA + (which ? 7 : 4) * D + c];
        ((float*)(F.ws + (which ? WS_CS3 : WS_CS2)))[r] = gwt * (1.0f + sc);
    }
    for (int it = gw; it < NIN + NGU; it += NGW) {
        const bool second = it >= NIN; const int n = second ? it - NIN : it;
        const bf16* wrow = (const bf16*)(F.ws + (second ? WS_W3T : WS_WINT)) + (size_t)n * D;
        const float* sh = ada + (second ? 6 : 3) * D;
        float a[4] = {0.f, 0.f, 0.f, 0.f};
#pragma unroll
        for (int j = 0; j < 2; ++j) {
            const int k = 8 * F.lane + 512 * j;
            const v4u w = *(const GAS v4u*)(wrow + k);
            const float wf[8] = {bflo(w.x), bfhi(w.x), bflo(w.y), bfhi(w.y), bflo(w.z), bfhi(w.z), bflo(w.w), bfhi(w.w)};
#pragma unroll
            for (int b = 0; b < 4; ++b) { const f32x4 s0 = *(const f32x4*)(sh + b * NADA + k), s1 = *(const f32x4*)(sh + b * NADA + k + 4);
                a[b] += wf[0] * s0[0] + wf[1] * s0[1] + wf[2] * s0[2] + wf[3] * s0[3] + wf[4] * s1[0] + wf[5] * s1[1] + wf[6] * s1[2] + wf[7] * s1[3]; }
        }
#pragma unroll
        for (int b = 0; b < 4; ++b) a[b] = wave_sum(a[b]);
        if (F.lane == 0) { float* dst = (float*)(F.ws + (second ? WS_BIAS3 : WS_BIAS2)); const int N = second ? NGU : NIN;
#pragma unroll
            for (int b = 0; b < 4; ++b) dst[b * N + n] = a[b]; }
    }
    bf16* h1 = (bf16*)F.out;
    for (int m0 = gw * 4; m0 < T; m0 += NGW * 4) {
        const int b = m0 / SEQ;
        f32x4 v[4][4]; float rstd[4];
#pragma unroll
        for (int q = 0; q < 4; ++q) { const GAS f32x4* xr = (const GAS f32x4*)(F.in[IN_X] + (size_t)(m0 + q) * D) + F.lane;
#pragma unroll
            for (int j = 0; j < 4; ++j) v[q][j] = xr[64 * j]; }
#pragma unroll
        for (int q = 0; q < 4; ++q) { float s = 0.f;
#pragma unroll
            for (int j = 0; j < 4; ++j) s += (v[q][j].x * v[q][j].x + v[q][j].y * v[q][j].y) + (v[q][j].z * v[q][j].z + v[q][j].w * v[q][j].w);
            rstd[q] = __builtin_amdgcn_rsqf(wave_sum(s) * (1.f / D) + EPS); }
#pragma unroll
        for (int j = 0; j < 4; ++j) {
            const int c = 4 * F.lane + 256 * j;
            const f32x4 g = *(const f32x4*)(F.in[IN_NFFN1] + c), sh = *(const f32x4*)(ada + b * NADA + c), sc = *(const f32x4*)(ada + b * NADA + D + c);
            const f32x4 gs = g * (sc + 1.0f);
#pragma unroll
            for (int q = 0; q < 4; ++q) { const f32x4 h = v[q][j] * rstd[q] * gs + sh;
                ((GAS unsigned long long*)(h1 + (size_t)(m0 + q) * D))[F.lane + 64 * j] = (unsigned long long)pk2(h.x, h.y) | ((unsigned long long)pk2(h.z, h.w) << 32);
                ((GAS unsigned long long*)(h1 + (size_t)(T + m0 + q) * D))[F.lane + 64 * j] = (unsigned long long)pk2(v[q][j].x, v[q][j].y) | ((unsigned long long)pk2(v[q][j].z, v[q][j].w) << 32); }
        }
    }
}

__device__ __forceinline__ void final_norm_phase(Frame& F) {
    const int gw = F.vcu * NWAVES + F.wave, NGW = F.G * NWAVES;
    const float* rowss = (const float*)(F.ws + WS_ROWSS);
    const bf16* x3 = (const bf16*)(F.ws + WS_X3);
    const int c0 = 8 * F.lane;
    f32x4 g[2][2];
#pragma unroll
    for (int j = 0; j < 2; ++j) { g[j][0] = *(const f32x4*)(F.in[IN_NFINAL] + c0 + 512 * j); g[j][1] = *(const f32x4*)(F.in[IN_NFINAL] + c0 + 512 * j + 4); }
    for (int m0 = gw * 4; m0 < T; m0 += NGW * 4) {
        float r[4]; v4u xv[4][2];
#pragma unroll
        for (int q = 0; q < 4; ++q) { r[q] = pg8::row_rnorm(rowss, m0 + q);
#pragma unroll
            for (int j = 0; j < 2; ++j) xv[q][j] = *(const GAS v4u*)(x3 + (size_t)(m0 + q) * D + c0 + 512 * j); }
#pragma unroll
        for (int q = 0; q < 4; ++q)
#pragma unroll
            for (int j = 0; j < 2; ++j) {
                const v4u a = xv[q][j]; GAS f32x4* o = (GAS f32x4*)(F.out + (size_t)(m0 + q) * D + c0 + 512 * j);
                o[0] = (f32x4){bflo(a.x), bfhi(a.x), bflo(a.y), bfhi(a.y)} * r[q] * g[j][0];
                o[1] = (f32x4){bflo(a.z), bfhi(a.z), bflo(a.w), bfhi(a.w)} * r[q] * g[j][1];
            }
    }
}

__device__ __forceinline__ void gating_phase(Frame& F, int rep) {
    LAS float* km = (LAS float*)(F.lds + RING_OFF);
    const float* kmeanp = (const float*)(F.ws + WS_KMEANP);
    const bf16* q = (const bf16*)(F.ws + WS_Q);
    unsigned* sel = (unsigned*)(F.ws + WS_SEL);
    constexpr int NITEM = BATCH * NH * (NBLK - 1);
    LAS unsigned* qslot = (LAS unsigned*)(F.lds + 32768);
    for (;;) {
        __syncthreads();
        if (F.tid == 0) qslot[0] = __hip_atomic_fetch_add((unsigned*)(F.ctl + CW_QUEUE + 128 + 64 * rep), 1u, RLX_AGENT);
        __syncthreads();
        const int it = (int)qslot[0];
        if (it >= NITEM) break;
        const int i = 31 - (it >> 5), h = it & 7, b = (it >> 3) & 3;
        for (int e = F.tid; e < i * 64; e += NWAVES * 64) { const int n = e >> 6, d = e & 63;
            km[e] = (kmeanp[(size_t)((b * NBLK + n) * 2 + 0) * AW + h * HD + d] + kmeanp[(size_t)((b * NBLK + n) * 2 + 1) * AW + h * HD + d]) * (1.0f / 256.0f); }
        __syncthreads();
        const int ql = F.lane & 31, half = F.lane >> 5, t = i * MBLK + F.wave * 32 + ql;
        const bf16* qrow = q + (size_t)(b * SEQ + t) * AW + h * HD;
        float qf[64];
#pragma unroll
        for (int c = 0; c < 8; ++c) { const v4u w = *(const GAS v4u*)(qrow + 8 * c);
            qf[8 * c + 0] = bflo(w.x); qf[8 * c + 1] = bfhi(w.x); qf[8 * c + 2] = bflo(w.y); qf[8 * c + 3] = bfhi(w.y); qf[8 * c + 4] = bflo(w.z); qf[8 * c + 5] = bfhi(w.z); qf[8 * c + 6] = bflo(w.w); qf[8 * c + 7] = bfhi(w.w); }
        float v0 = -3e38f, v1 = -3e38f, v2 = -3e38f; int i0 = 255, i1 = 255, i2 = 255;
        for (int n = half; n < i; n += 2) {
            const LAS f32x4* kr = (const LAS f32x4*)(km + n * 64);
            float dot = 0.f;
#pragma unroll
            for (int c = 0; c < 16; ++c) { const f32x4 kv = kr[c]; dot += qf[4 * c] * kv[0] + qf[4 * c + 1] * kv[1] + qf[4 * c + 2] * kv[2] + qf[4 * c + 3] * kv[3]; }
            if (dot > v0) { v2 = v1; i2 = i1; v1 = v0; i1 = i0; v0 = dot; i0 = n; }
            else if (dot > v1) { v2 = v1; i2 = i1; v1 = dot; i1 = n; }
            else if (dot > v2) { v2 = dot; i2 = n; }
        }
        const float ov[3] = {__shfl_xor(v0, 32), __shfl_xor(v1, 32), __shfl_xor(v2, 32)};
        const int oi[3] = {__shfl_xor(i0, 32), __shfl_xor(i1, 32), __shfl_xor(i2, 32)};
#pragma unroll
        for (int k = 0; k < 3; ++k) {
            const float d = ov[k]; const int n = oi[k];
            if (d > v0 || (d == v0 && n < i0)) { v2 = v1; i2 = i1; v1 = v0; i1 = i0; v0 = d; i0 = n; }
            else if (d > v1 || (d == v1 && n < i1)) { v2 = v1; i2 = i1; v1 = d; i1 = n; }
            else if (d > v2 || (d == v2 && n < i2)) { v2 = d; i2 = n; }
        }
        if (half == 0) sel[(size_t)(b * NH + h) * SEQ + t] = (unsigned)i0 | ((unsigned)i1 << 8) | ((unsigned)i2 << 16);
    }
}

namespace att {
typedef float f32x16 __attribute__((ext_vector_type(16)));
typedef short s16x4 __attribute__((ext_vector_type(4)));
typedef short v4i16_t __attribute__((ext_vector_type(4)));
typedef __bf16 bf16x2_t __attribute__((ext_vector_type(2)));
constexpr int ATT_K = 0, ATT_V = 32768, ATT_LIST = 65536, ATT_WS = 81920, ATT_OST = 83968, ATT_CNT = 116736;
__device__ __forceinline__ int crow(int r, int hi) { return (r & 3) + 8 * (r >> 2) + 4 * hi; }
__device__ __forceinline__ unsigned cvtpk(float lo, float hi) { f32x2 v = {lo, hi}; bf16x2_t b = __builtin_convertvector(v, bf16x2_t); return __builtin_bit_cast(unsigned, b); }
__device__ __forceinline__ s16x4 vtr(const LAS unsigned char* p) { return __builtin_bit_cast(s16x4, __builtin_amdgcn_ds_read_tr16_b64_v4i16((LAS v4i16_t*)p)); }
__device__ __forceinline__ float swapmax(float m) { auto rr = __builtin_amdgcn_permlane32_swap(__float_as_uint(m), __float_as_uint(m), false, false); return fmaxf(__uint_as_float(rr[0]), __uint_as_float(rr[1])); }
__device__ __forceinline__ float swapsum(float m) { auto rr = __builtin_amdgcn_permlane32_swap(__float_as_uint(m), __float_as_uint(m), false, false); return __uint_as_float(rr[0]) + __uint_as_float(rr[1]); }

__device__ __forceinline__ void load_kv(Frame& F, int b, int h, int j) {
    const bf16* K = (const bf16*)(F.ws + WS_K); const bf16* V = (const bf16*)(F.ws + WS_V);
    const size_t row0 = (size_t)(b * SEQ + j * MBLK);
#pragma unroll
    for (int kt = 0; kt < 4; ++kt) {
        const bf16* ksrc = K + (row0 + kt * 64 + F.lane) * AW + h * HD + F.wave * 8;
        __builtin_amdgcn_global_load_lds((const unsigned*)ksrc, (LAS unsigned*)(F.lds + ATT_K + kt * 8192 + F.wave * 1024), 16, 0, 0);
        const bf16* vsrc = V + (row0 + kt * 64 + 16 * (F.wave & 3) + (F.lane >> 2)) * AW + h * HD + (F.wave >> 2) * 32 + (F.lane & 3) * 8;
        __builtin_amdgcn_global_load_lds((const unsigned*)vsrc, (LAS unsigned*)(F.lds + ATT_V + kt * 8192 + F.wave * 1024), 16, 0, 0);
    }
}

template <bool CAUSAL>
__device__ __forceinline__ void attn_tile(Frame& F, const bf16x8 (&qr)[4], int reli, float slope2, int nkt, f32x16 (&o)[2], float& m_out, float& l_out) {
    const int lane = F.lane, r32 = lane & 31, hi = lane >> 5;
    LAS float* wsf = (LAS float*)(F.lds + ATT_WS + F.wave * 256);
    float m = -1e30f, l = 0.f;
#pragma unroll
    for (int r = 0; r < 16; ++r) { o[0][r] = 0.f; o[1][r] = 0.f; }
    const float base0 = slope2 * (float)(4 * hi - reli);
    for (int kt = 0; kt < nkt; ++kt) {
        const LAS unsigned char* Ks = F.lds + ATT_K + kt * 8192 + hi * 1024 + r32 * 16;
        f32x16 p0, p1;
        const float bkt = base0 + slope2 * (float)(64 * kt);
#pragma unroll
        for (int r = 0; r < 16; ++r) { p0[r] = bkt + slope2 * (float)((r & 3) + 8 * (r >> 2)); p1[r] = p0[r] + slope2 * 32.0f; }
#pragma unroll
        for (int d0 = 0; d0 < 4; ++d0) {
            const bf16x8 a0 = *(const LAS bf16x8*)(Ks + d0 * 2048), a1 = *(const LAS bf16x8*)(Ks + d0 * 2048 + 512);
            p0 = __builtin_amdgcn_mfma_f32_32x32x16_bf16(a0, qr[d0], p0, 0, 0, 0);
            p1 = __builtin_amdgcn_mfma_f32_32x32x16_bf16(a1, qr[d0], p1, 0, 0, 0);
        }
        if (CAUSAL) {
#pragma unroll
            for (int r = 0; r < 16; ++r) { const int kp = 64 * kt + crow(r, hi); if (kp > reli) p0[r] = -1e30f; if (kp + 32 > reli) p1[r] = -1e30f; }
        }
        float mt = fmaxf(p0[0], p1[0]);
#pragma unroll
        for (int r = 1; r < 16; ++r) mt = fmaxf(mt, fmaxf(p0[r], p1[r]));
        mt = swapmax(mt);
        const float mnew = fmaxf(m, mt), alpha = fast_exp2(m - mnew); m = mnew;
        float rs = 0.f;
#pragma unroll
        for (int r = 0; r < 16; ++r) { p0[r] = fast_exp2(p0[r] - mnew); p1[r] = fast_exp2(p1[r] - mnew); rs += p0[r] + p1[r]; }
        l = l * alpha + rs;
        if (hi == 0) wsf[r32] = alpha;
        asm volatile("s_waitcnt lgkmcnt(0)" ::: "memory");
#pragma unroll
        for (int r = 0; r < 16; ++r) { const float a = wsf[crow(r, hi)]; o[0][r] *= a; o[1][r] *= a; }
        asm volatile("" ::: "memory");
        v4u pw0, pw1, pw2, pw3;
        pw0.x = cvtpk(p0[0], p0[1]); pw0.y = cvtpk(p0[2], p0[3]); pw0.z = cvtpk(p0[4], p0[5]); pw0.w = cvtpk(p0[6], p0[7]);
        pw1.x = cvtpk(p0[8], p0[9]); pw1.y = cvtpk(p0[10], p0[11]); pw1.z = cvtpk(p0[12], p0[13]); pw1.w = cvtpk(p0[14], p0[15]);
        pw2.x = cvtpk(p1[0], p1[1]); pw2.y = cvtpk(p1[2], p1[3]); pw2.z = cvtpk(p1[4], p1[5]); pw2.w = cvtpk(p1[6], p1[7]);
        pw3.x = cvtpk(p1[8], p1[9]); pw3.y = cvtpk(p1[10], p1[11]); pw3.z = cvtpk(p1[12], p1[13]); pw3.w = cvtpk(p1[14], p1[15]);
        const LAS unsigned char* vp = F.lds + ATT_V + kt * 8192 + ((lane >> 4) & 1) * 32 + (lane & 3) * 8 + (4 * hi + ((lane & 15) >> 2)) * 64;
#pragma unroll
        for (int d0 = 0; d0 < 2; ++d0) {
#define ATT_PV(ks, pw) { const s16x4 lo = vtr(vp + d0 * 4096 + (ks) * 1024), hh = vtr(vp + d0 * 4096 + (ks) * 1024 + 512); \
            const bf16x8 vf = (bf16x8){lo[0], lo[1], lo[2], lo[3], hh[0], hh[1], hh[2], hh[3]}; \
            o[d0] = __builtin_amdgcn_mfma_f32_32x32x16_bf16(__builtin_bit_cast(bf16x8, pw), vf, o[d0], 0, 0, 0); }
            ATT_PV(0, pw0) ATT_PV(1, pw1) ATT_PV(2, pw2) ATT_PV(3, pw3)
#undef ATT_PV
        }
    }
    m_out = m; l_out = swapsum(l);
}

__device__ __forceinline__ void stage_o(Frame& F, const f32x16 (&o)[2], float l) {
    const int lane = F.lane, r32 = lane & 31, hi = lane >> 5;
    LAS float* wsf = (LAS float*)(F.lds + ATT_WS + F.wave * 256);
    LAS bf16* stg = (LAS bf16*)(F.lds + ATT_OST + F.wave * 4096);
    if (hi == 0) wsf[32 + r32] = l;
    asm volatile("s_waitcnt lgkmcnt(0)" ::: "memory");
#pragma unroll
    for (int r = 0; r < 16; ++r) { const int orow = crow(r, hi); const float rl = fast_rcp(wsf[32 + orow]);
        stg[orow * 64 + r32] = (bf16)f2bf(o[0][r] * rl); stg[orow * 64 + 32 + r32] = (bf16)f2bf(o[1][r] * rl); }
    asm volatile("s_waitcnt lgkmcnt(0)" ::: "memory");
}

__device__ __forceinline__ void gathered_phase(Frame& F, int rep) {
    const bf16* Q = (const bf16*)(F.ws + WS_Q);
    const unsigned* sel = (const unsigned*)(F.ws + WS_SEL);
    bf16* part = (bf16*)(F.ws + WS_PART); float* lseb = (float*)(F.ws + WS_LSE);
    LAS unsigned short* list = (LAS unsigned short*)(F.lds + ATT_LIST);
    LAS unsigned* cnt = (LAS unsigned*)(F.lds + ATT_CNT);
    constexpr int NITEM = BATCH * NH * (NBLK - 1);
    const int lane = F.lane, r32 = lane & 31, hi = lane >> 5;
    for (;;) {
        __syncthreads();
        if (F.tid == 0) { cnt[1] = __hip_atomic_fetch_add((unsigned*)(F.ctl + CW_QUEUE + 64 * rep), 1u, RLX_AGENT); cnt[0] = 0u; }
        __syncthreads();
        const int item = (int)cnt[1];
        if (item >= NITEM) break;
        const int j = item >> 5, bh = item & 31, b = bh >> 3, h = bh & 7;
        load_kv(F, b, h, j);
        const unsigned* selrow = sel + (size_t)bh * SEQ;
        const int tstart = (j + 1) * MBLK, nk = (SEQ - tstart + NWAVES * 64 - 1) / (NWAVES * 64);
        unsigned sw[16];
#pragma unroll
        for (int k = 0; k < 16; ++k) { const int t = tstart + k * NWAVES * 64 + F.tid; sw[k] = (k < nk && t < SEQ) ? selrow[t] : 0xffffffffu; }
#pragma unroll
        for (int k = 0; k < 16; ++k) if (k < nk) {
            const int t = tstart + k * NWAVES * 64 + F.tid;
            const int own = t >> 8, nv = own < 3 ? own : 3;
            int slot = -1;
            if ((int)(sw[k] & 255u) == j && nv > 0) slot = 0; else if ((int)((sw[k] >> 8) & 255u) == j && nv > 1) slot = 1; else if ((int)((sw[k] >> 16) & 255u) == j && nv > 2) slot = 2;
            const bool match = t < SEQ && slot >= 0;
            const unsigned long long bal = __ballot(match);
            const int tot = __popcll(bal), pre = __popcll(bal & ((1ull << lane) - 1ull));
            unsigned base = 0u;
            if (lane == 0 && tot) base = __hip_atomic_fetch_add(cnt, (unsigned)tot, __ATOMIC_RELAXED, __HIP_MEMORY_SCOPE_WORKGROUP);
            base = (unsigned)__builtin_amdgcn_readfirstlane((int)base);
            if (match) list[base + pre] = (unsigned short)(t | (slot << 13));
        }
        asm volatile("s_waitcnt vmcnt(0) lgkmcnt(0)" ::: "memory");
        __syncthreads();
        const int n = (int)cnt[0];
        const int ntile = (n + 31) >> 5;
        const float slope2 = exp2f(-(float)(h + 1)) * LOG2E;
        bf16x8 qn[4]; unsigned en = 0u;
        if (F.wave < ntile) { const int idx = F.wave * 32 + r32; en = list[idx < n ? idx : n - 1];
            const bf16* qrow = Q + (size_t)(b * SEQ + (int)(en & 0x1fffu)) * AW + h * HD;
#pragma unroll
            for (int d0 = 0; d0 < 4; ++d0) qn[d0] = *(const GAS bf16x8*)(qrow + d0 * 16 + hi * 8); }
        for (int tile = F.wave; tile < ntile; tile += NWAVES) {
            const int idx = tile * 32 + r32;
            const unsigned e = en; const int t = (int)(e & 0x1fffu);
            bf16x8 qr[4];
#pragma unroll
            for (int d0 = 0; d0 < 4; ++d0) qr[d0] = qn[d0];
            if (tile + NWAVES < ntile) { const int idx2 = (tile + NWAVES) * 32 + r32; en = list[idx2 < n ? idx2 : n - 1];
                const bf16* qrow = Q + (size_t)(b * SEQ + (int)(en & 0x1fffu)) * AW + h * HD;
#pragma unroll
                for (int d0 = 0; d0 < 4; ++d0) qn[d0] = *(const GAS bf16x8*)(qrow + d0 * 16 + hi * 8); }
            f32x16 o[2]; float m, l;
            attn_tile<false>(F, qr, t - j * MBLK, slope2, 4, o, m, l);
            if (hi == 0 && idx < n) lseb[((size_t)(b * SEQ + t) * NH + h) * 3 + (e >> 13)] = m + __log2f(l);
            stage_o(F, o, l);
            const LAS bf16* stg = (const LAS bf16*)(F.lds + ATT_OST + F.wave * 4096);
#pragma unroll
            for (int i = 0; i < 4; ++i) { const int row = i * 8 + (lane >> 3), ch = lane & 7, ri = tile * 32 + row;
                if (ri < n) { const unsigned er = list[ri]; const v4u v = *(const LAS v4u*)(stg + row * 64 + ch * 8);
                    *(GAS v4u*)(part + ((size_t)(b * SEQ + (int)(er & 0x1fffu)) * 3 + (er >> 13)) * AW + h * HD + ch * 8) = v; } }
            asm volatile("s_waitcnt lgkmcnt(0)" ::: "memory");
        }
    }
}

__device__ __forceinline__ void own_phase(Frame& F) {
    const bf16* Q = (const bf16*)(F.ws + WS_Q);
    const bf16* part = (const bf16*)(F.ws + WS_PART); const float* lseb = (const float*)(F.ws + WS_LSE);
    bf16* yatt = (bf16*)(F.ws + WS_YATT);
    constexpr int NITEM = BATCH * NH * NBLK;
    const int lane = F.lane, r32 = lane & 31, hi = lane >> 5;
    for (int it = F.vcu; it < NITEM; it += F.G) {
        const int i = it & 31, bh = it >> 5, b = bh >> 3, h = bh & 7;
        __syncthreads();
        load_kv(F, b, h, i);
        const float slope2 = exp2f(-(float)(h + 1)) * LOG2E;
        const int reli = F.wave * 32 + r32, t = i * MBLK + reli;
        bf16x8 qr[4];
        { const bf16* qrow = Q + (size_t)(b * SEQ + t) * AW + h * HD;
#pragma unroll
          for (int d0 = 0; d0 < 4; ++d0) qr[d0] = *(const GAS bf16x8*)(qrow + d0 * 16 + hi * 8); }
        asm volatile("s_waitcnt vmcnt(0)" ::: "memory");
        __syncthreads();
        f32x16 o[2]; float m, l;
        attn_tile<true>(F, qr, reli, slope2, (F.wave >> 1) + 1, o, m, l);
        LAS float* wsf = (LAS float*)(F.lds + ATT_WS + F.wave * 256);
        if (hi == 0) wsf[r32] = m + __log2f(l);
        stage_o(F, o, l);
        const LAS bf16* stg = (const LAS bf16*)(F.lds + ATT_OST + F.wave * 4096);
        const int nv = i < 3 ? i : 3;
#pragma unroll
        for (int k = 0; k < 4; ++k) {
            const int row = k * 8 + (lane >> 3), ch = lane & 7, tr = i * MBLK + F.wave * 32 + row;
            const v4u ov = *(const LAS v4u*)(stg + row * 64 + ch * 8);
            const float lown = wsf[row];
            float ls[3]; float M = lown;
#pragma unroll
            for (int s2 = 0; s2 < 3; ++s2) { ls[s2] = (s2 < nv) ? lseb[((size_t)(b * SEQ + tr) * NH + h) * 3 + s2] : -1e30f; M = fmaxf(M, ls[s2]); }
            float wown = fast_exp2(lown - M), W = wown;
            float a[8] = {bflo(ov.x) * wown, bfhi(ov.x) * wown, bflo(ov.y) * wown, bfhi(ov.y) * wown, bflo(ov.z) * wown, bfhi(ov.z) * wown, bflo(ov.w) * wown, bfhi(ov.w) * wown};
#pragma unroll
            for (int s2 = 0; s2 < 3; ++s2) if (s2 < nv) {
                const float w = fast_exp2(ls[s2] - M); W += w;
                const v4u pv = *(const GAS v4u*)(part + ((size_t)(b * SEQ + tr) * 3 + s2) * AW + h * HD + ch * 8);
                a[0] += w * bflo(pv.x); a[1] += w * bfhi(pv.x); a[2] += w * bflo(pv.y); a[3] += w * bfhi(pv.y); a[4] += w * bflo(pv.z); a[5] += w * bfhi(pv.z); a[6] += w * bflo(pv.w); a[7] += w * bfhi(pv.w);
            }
            const float rw = fast_rcp(W);
            v4u outv; outv.x = pk2(a[0] * rw, a[1] * rw); outv.y = pk2(a[2] * rw, a[3] * rw); outv.z = pk2(a[4] * rw, a[5] * rw); outv.w = pk2(a[6] * rw, a[7] * rw);
            *(GAS v4u*)(yatt + (size_t)(b * SEQ + tr) * AW + h * HD + ch * 8) = outv;
        }
        asm volatile("s_waitcnt lgkmcnt(0)" ::: "memory");
    }
}
}

struct Args { const float* in[26]; float* out; unsigned char* ws; int ph_lo, ph_hi, li, pad; };

__global__ void __launch_bounds__(NWAVES * 64, 2) hybrid_fwd(Args args) {
    extern __shared__ __attribute__((aligned(16))) unsigned char lds[];
    Frame F;
    F.lds = (LAS unsigned char*)lds;
    F.MISC = (volatile LAS unsigned*)(F.lds + MISC_OFF);
    F.tid = threadIdx.x; F.lane = F.tid & 63; F.wave = __builtin_amdgcn_readfirstlane(F.tid >> 6);
    F.G = gridDim.x; { const int bx = blockIdx.x; F.vcu = (F.G % 8 == 0) ? (bx % 8) * (F.G / 8) + bx / 8 : bx; }
    F.ws = args.ws; F.ctl = (gu32*)(args.ws + WS_CTL); F.out = args.out;
#pragma unroll
    for (int i = 0; i < 26; ++i) F.in[i] = args.in[i];
    for (int u = F.tid; u < 64; u += NWAVES * 64) ((LAS unsigned*)(F.lds + MISC_OFF))[u] = 0u;
    __syncthreads();
    XcdBarrier bar; bar.bar = (unsigned*)(F.ctl + CW_BAR); bar.x = 0; bar.st = nullptr;
    if (MK_N_LAUNCHES == 1) bar = xcd_barrier_post((unsigned*)(F.ctl + CW_BAR), F.MISC + 8);
#define GRID_BAR() do { if (MK_N_LAUNCHES == 1) xcd_barrier(bar); } while (0)
#ifndef DUP_MASK
#define DUP_MASK 0
#endif
#define NREP(k) (((DUP_MASK >> (k)) & 1) ? 2 : 1)
    const int lo = args.ph_lo, hi = args.ph_hi;
#define IN(k) (lo <= (k) && (k) < hi)
#define BOTH(k) (IN(k) && IN((k) + 1))
    unsigned char* ws = args.ws;
    const float* ada = (const float*)(ws + WS_ADA);
    float* rowss = (float*)(ws + WS_ROWSS);
    const int bx = (int)blockIdx.x;

    if (IN(0)) { _Pragma("unroll") for (int rep = 0; rep < NREP(0); ++rep) { if (rep) GRID_BAR(); p0_prologue(F); } if (BOTH(0)) GRID_BAR(); }
    if (IN(1)) { _Pragma("unroll") for (int rep = 0; rep < NREP(1); ++rep) { if (rep) GRID_BAR(); p1_phase(F); } if (BOTH(1)) GRID_BAR(); }
    if (IN(2)) { _Pragma("unroll") for (int rep = 0; rep < NREP(2); ++rep) { if (rep) GRID_BAR();
        pg8::Gemm g{(const bf16*)F.out, (const bf16*)(ws + WS_W1T), D, D, D, nullptr, nullptr, 0}; pg8::StaticOrder S; S.init(T, NGU, F.G, bx);
        pg8::EpiSwiGLU<false> E{(bf16*)(ws + WS_ACT), nullptr, nullptr, (LAS float*)(F.lds + RN_OFF)};
        pg8::gemm_phase<pg8::EpiSwiGLU<false>, pg8::StaticOrder, true>(F.lds + RING_OFF, g, S, E);
        } if (BOTH(2)) GRID_BAR();
    }
    if (IN(3)) { _Pragma("unroll") for (int rep = 0; rep < NREP(3); ++rep) { if (rep) GRID_BAR();
        pg8::Gemm g{(const bf16*)(ws + WS_ACT), (const bf16*)(ws + WS_W2T), FF, FF, FF, nullptr, nullptr, 0}; pg8::StaticOrder S; S.init(T, D, F.G, bx);
        pg8::EpiResid<true, 0> E{(const bf16*)F.out + (size_t)T * D, (bf16*)F.out, ada + 2 * D, (bf16*)(ws + WS_X1S), (const float*)(ws + WS_CS2), rowss, 0.5f};
        pg8::gemm_phase<pg8::EpiResid<true, 0>, pg8::StaticOrder, true>(F.lds + RING_OFF, g, S, E);
        } if (BOTH(3)) GRID_BAR();
    }
    if (IN(4)) { _Pragma("unroll") for (int rep = 0; rep < NREP(4); ++rep) { if (rep) GRID_BAR();
        pg8::Gemm g{(const bf16*)(ws + WS_X1S), (const bf16*)(ws + WS_WINT), D, D, D, nullptr, nullptr, 0}; pg8::StaticOrder S; S.init(T, NIN, F.G, bx);
        pg8::EpiIn E{rowss, (const float*)(ws + WS_BIAS2), (bf16*)(ws + WS_Q), (bf16*)(ws + WS_K), (bf16*)(ws + WS_V), (bf16*)(ws + WS_SSMA), (unsigned char*)(ws + WS_SGA), (unsigned char*)(ws + WS_SGS), (float*)(ws + WS_KMEANP), (LAS float*)(F.lds + RN_OFF)};
        pg8::gemm_phase<pg8::EpiIn, pg8::StaticOrder, true>(F.lds + RING_OFF, g, S, E);
        } if (BOTH(4)) GRID_BAR();
    }
    if (IN(5)) { _Pragma("unroll") for (int rep = 0; rep < NREP(5); ++rep) { if (rep) GRID_BAR();
        {
            pg8::Gemm g{(const bf16*)(ws + WS_SSMA), (const bf16*)(ws + WS_BS), KSSM, 512, 512, nullptr, nullptr, 0}; pg8::BlockDiagOrder S; S.init(SG, 4, 1, F.G, bx);
            pg8::EpiSsmState E{(bf16*)(ws + WS_SSMA), F.in[IN_LAMRE], F.in[IN_LAMIM], F.in[IN_LOGDT]};
            pg8::gemm_phase<pg8::EpiSsmState, pg8::BlockDiagOrder, false>(F.lds + RING_OFF, g, S, E);
        }
        gating_phase(F, rep);
        } if (BOTH(5)) GRID_BAR();
    }
    if (IN(6)) { _Pragma("unroll") for (int rep = 0; rep < NREP(6); ++rep) { if (rep) GRID_BAR();
        {
            pg8::Gemm g{(const bf16*)(ws + WS_SSMA), (const bf16*)(ws + WS_BM), KSSM, KSSM, KSSM, nullptr, nullptr, 0}; pg8::BlockDiagOrder S; S.init(SG, 4, 2, F.G, bx);
            pg8::EpiSsmMain E{(const bf16*)(ws + WS_SSMA), F.in[IN_SSMD], (bf16*)(ws + WS_Y1)};
            pg8::gemm_phase<pg8::EpiSsmMain, pg8::BlockDiagOrder, true>(F.lds + RING_OFF, g, S, E);
        }
        att::gathered_phase(F, rep);
        } if (BOTH(6)) GRID_BAR();
    }
    if (IN(7)) { _Pragma("unroll") for (int rep = 0; rep < NREP(7); ++rep) { if (rep) GRID_BAR();
        pg8::Gemm g{(const bf16*)(ws + WS_Y1), (const bf16*)(ws + WS_WGLU), SW, SW, SW, nullptr, nullptr, 0}; pg8::StaticOrder S; S.init(T, SW, F.G, bx);
        pg8::EpiGlu E{(const bf16*)(ws + WS_Y1), F.in[IN_BGLU], (bf16*)(ws + WS_YSSM)};
        pg8::gemm_phase<pg8::EpiGlu, pg8::StaticOrder, true>(F.lds + RING_OFF, g, S, E);
        att::own_phase(F);
        } if (BOTH(7)) GRID_BAR();
    }
    if (IN(8)) { _Pragma("unroll") for (int rep = 0; rep < NREP(8); ++rep) { if (rep) GRID_BAR();
        pg8::Gemm g{(const bf16*)(ws + WS_YATT), (const bf16*)(ws + WS_WBRA), AW, AW, AW, (const bf16*)(ws + WS_YSSM), (const bf16*)(ws + WS_WBRS), SW}; pg8::StaticOrder S; S.init(T, D, F.G, bx);
        pg8::EpiMerge E{(const unsigned char*)(ws + WS_SGA), (const unsigned char*)(ws + WS_SGS), (bf16*)(ws + WS_MERGED)};
        pg8::gemm_phase<pg8::EpiMerge, pg8::StaticOrder, true>(F.lds + RING_OFF, g, S, E);
        } if (BOTH(8)) GRID_BAR();
    }
    if (IN(9)) { _Pragma("unroll") for (int rep = 0; rep < NREP(9); ++rep) { if (rep) GRID_BAR();
        pg8::Gemm g{(const bf16*)(ws + WS_MERGED), (const bf16*)(ws + WS_WOUT), D, D, D, nullptr, nullptr, 0}; pg8::StaticOrder S; S.init(T, D, F.G, bx);
        pg8::EpiResid<true, 1> E{(const bf16*)F.out, (bf16*)F.out + (size_t)T * D, ada + 5 * D, (bf16*)(ws + WS_X2S), (const float*)(ws + WS_CS3), rowss, 1.0f};
        pg8::gemm_phase<pg8::EpiResid<true, 1>, pg8::StaticOrder, true>(F.lds + RING_OFF, g, S, E);
        } if (BOTH(9)) GRID_BAR();
    }
    if (IN(10)) { _Pragma("unroll") for (int rep = 0; rep < NREP(10); ++rep) { if (rep) GRID_BAR();
        pg8::Gemm g{(const bf16*)(ws + WS_X2S), (const bf16*)(ws + WS_W3T), D, D, D, nullptr, nullptr, 0}; pg8::StaticOrder S; S.init(T, NGU, F.G, bx);
        pg8::EpiSwiGLU<true> E{(bf16*)(ws + WS_ACT), rowss, (const float*)(ws + WS_BIAS3), (LAS float*)(F.lds + RN_OFF)};
        pg8::gemm_phase<pg8::EpiSwiGLU<true>, pg8::StaticOrder, true>(F.lds + RING_OFF, g, S, E);
        } if (BOTH(10)) GRID_BAR();
    }
    if (IN(11)) { _Pragma("unroll") for (int rep = 0; rep < NREP(11); ++rep) { if (rep) GRID_BAR();
        pg8::Gemm g{(const bf16*)(ws + WS_ACT), (const bf16*)(ws + WS_W4T), FF, FF, FF, nullptr, nullptr, 0}; pg8::StaticOrder S; S.init(T, D, F.G, bx);
        pg8::EpiResid<false, 2> E{(const bf16*)F.out + (size_t)T * D, (bf16*)(ws + WS_X3), ada + 8 * D, nullptr, nullptr, rowss, 0.5f};
        pg8::gemm_phase<pg8::EpiResid<false, 2>, pg8::StaticOrder, true>(F.lds + RING_OFF, g, S, E);
        } if (BOTH(11)) GRID_BAR();
    }
    if (IN(12)) { _Pragma("unroll") for (int rep = 0; rep < NREP(12); ++rep) { if (rep) GRID_BAR(); final_norm_phase(F); }  }
#undef IN
#undef BOTH
}

extern "C" void kernel_launch(void* const* d_in, const int* in_sizes, int n_in, void* d_out, int out_size, void* d_ws, size_t ws_size, hipStream_t stream) {
    static int grid = 0;
    if (grid == 0) {
        if (n_in != 26 || in_sizes[0] != T * D || out_size != T * D || ws_size < WS_END) { fprintf(stderr, "kernel_launch: unexpected shapes (n_in %d, in0 %d, out %d, ws %zu < %zu); nothing launched\n", n_in, n_in > 0 ? in_sizes[0] : -1, out_size, ws_size, (size_t)WS_END); grid = -1; return; }
        int dev = 0, cus = 0;
        if (hipGetDevice(&dev) != hipSuccess || hipDeviceGetAttribute(&cus, hipDeviceAttributeMultiprocessorCount, dev) != hipSuccess) { grid = -1; return; }
        if (hipFuncSetAttribute((const void*)hybrid_fwd, hipFuncAttributeMaxDynamicSharedMemorySize, LDS_BYTES) != hipSuccess) { fprintf(stderr, "kernel_launch: hipFuncSetAttribute failed\n"); grid = -1; return; }
        (void)hipGetLastError();
        grid = cus;
    }
    if (grid < 0) return;
    if (hipMemsetAsync((char*)d_ws + WS_CTL, 0, CTL_ZERO_BYTES, stream) != hipSuccess) return;
    Args a{};
    for (int i = 0; i < 26; ++i) a.in[i] = (const float*)d_in[i];
    a.out = (float*)d_out; a.ws = (unsigned char*)d_ws;
    for (int li = 0; li < MK_N_LAUNCHES; ++li) {
        a.ph_lo = (MK_N_LAUNCHES == 1) ? 0 : li; a.ph_hi = (MK_N_LAUNCHES == 1) ? N_PHASES : li + 1; a.li = li;
        hipLaunchKernelGGL(hybrid_fwd, dim3(grid), dim3(NWAVES * 64), LDS_BYTES, stream, a);
    }
}
```

```cpp
#include <hip/hip_runtime.h>
#include <hip/hip_bf16.h>
#include <cstdio>
#include <cstdint>

#ifndef MK_N_LAUNCHES
#define MK_N_LAUNCHES 1
#endif

constexpr int BATCH = 4, SEQ = 8192, T = BATCH * SEQ, D = 1024, FF = 2816, NGU = 2 * FF, NIN = 4096, AW = 512, SW = 512, NH = 8, HD = 64;
constexpr int NBLK = 32, MBLK = 256;
constexpr int SG = 32, SC = 16, SP = 64, SL = 32, NCH = SEQ / SL, KSSM = SC * SL + 2 * SP;
constexpr int NADA = 9 * D;
constexpr float EPS = 1e-6f;
constexpr float LOG2E = 1.4426950408889634f;
constexpr float QSCALE = 0.125f * LOG2E;
constexpr int N_PHASES = 13;

constexpr size_t MiB = 1u << 20;
constexpr size_t WS_CTL = 0, CTL_ZERO_BYTES = 1 * MiB;
constexpr size_t WS_ADA = 1 * MiB;
constexpr size_t WS_CS2 = WS_ADA + 147456;
constexpr size_t WS_CS3 = WS_CS2 + 16384;
constexpr size_t WS_BIAS2 = WS_CS3 + 16384;
constexpr size_t WS_BIAS3 = WS_BIAS2 + 65536;
constexpr size_t WS_KMEANP = 1 * MiB + 512 * 1024;
constexpr size_t WS_SEL = 2 * MiB;
constexpr size_t WS_LSE = 498 * MiB;
constexpr size_t WS_ROWSS = 4 * MiB;
constexpr size_t WS_WINT = 8 * MiB, WS_WGLU = 16 * MiB, WS_WBRA = 17 * MiB, WS_WBRS = 18 * MiB, WS_WOUT = 19 * MiB;
constexpr size_t WS_W1T = 21 * MiB, WS_W2T = 32 * MiB, WS_W3T = 37 * MiB + 512 * 1024, WS_W4T = 48 * MiB + 512 * 1024;
constexpr size_t WS_BM = 54 * MiB, WS_BS = 74 * MiB;
constexpr size_t WS_ARENA = 82 * MiB;
constexpr size_t WS_SGA = WS_ARENA, WS_SGS = WS_ARENA + 32 * MiB;
constexpr size_t WS_Q = WS_ARENA + 128 * MiB, WS_K = WS_ARENA + 160 * MiB, WS_V = WS_ARENA + 192 * MiB;
constexpr size_t WS_PART = WS_ARENA + 224 * MiB;
constexpr size_t WS_Y1 = WS_ARENA + 320 * MiB;
constexpr size_t WS_SSMA = WS_ARENA + 352 * MiB;
constexpr size_t WS_YSSM = WS_ARENA + 352 * MiB, WS_YATT = WS_ARENA + 384 * MiB;
constexpr size_t WS_X1S = WS_ARENA + 224 * MiB, WS_ACT = WS_ARENA, WS_MERGED = WS_ARENA + 128 * MiB, WS_X2S = WS_ARENA + 224 * MiB;
constexpr size_t WS_X3 = WS_ARENA + 224 * MiB;
constexpr size_t WS_END = WS_ARENA + 416 * MiB + 3 * MiB;
static_assert(WS_BIAS3 + 90112 <= WS_KMEANP && WS_W4T + (size_t)D * FF * 2 <= WS_BM && WS_BM + (size_t)SG * 512 * KSSM * 2 <= WS_BS && WS_BS + (size_t)SG * 256 * 512 * 2 <= WS_ARENA, "ws map");
static_assert((size_t)SG * 1024 * KSSM * 2 <= 40 * MiB && (size_t)T * FF * 2 <= 176 * MiB, "ws map 2");
constexpr int CW_BAR = 4096;
constexpr int CW_QUEUE = 256;

constexpr int RING_OFF = 0, RING_BYTES = 131072;
constexpr int SILU_OFF = 131072;
constexpr int RN_OFF = 147456;
constexpr int LDS_BYTES = 163840;
constexpr int MISC_OFF = LDS_BYTES - 256;

#define GAS __attribute__((address_space(1)))
#define LAS __attribute__((address_space(3)))
typedef unsigned short bf16;
typedef unsigned v4u __attribute__((ext_vector_type(4)));
typedef unsigned v2u __attribute__((ext_vector_type(2)));
typedef float f32x4 __attribute__((ext_vector_type(4)));
typedef float f32x2 __attribute__((ext_vector_type(2)));
typedef short bf16x8 __attribute__((ext_vector_type(8)));
typedef GAS unsigned gu32;
#define RLX_AGENT __ATOMIC_RELAXED, __HIP_MEMORY_SCOPE_AGENT
#define LDS_WAIT() asm volatile("s_waitcnt lgkmcnt(0)" ::: "memory")
#define VM_WAIT() asm volatile("s_waitcnt vmcnt(0)" ::: "memory")
constexpr int NWAVES = 8;

__device__ __forceinline__ unsigned f2bf(float f) { unsigned u = __builtin_bit_cast(unsigned, f); return (u + 0x7fffu + ((u >> 16) & 1u)) >> 16; }
__device__ __forceinline__ unsigned pk2(float lo, float hi) { return f2bf(lo) | (f2bf(hi) << 16); }
__device__ __forceinline__ float bf2f(unsigned short h) { return __builtin_bit_cast(float, (unsigned)h << 16); }
__device__ __forceinline__ float bflo(unsigned w) { return __builtin_bit_cast(float, w << 16); }
__device__ __forceinline__ float bfhi(unsigned w) { return __builtin_bit_cast(float, w & 0xffff0000u); }
__device__ __forceinline__ float fast_exp2(float x) { return __builtin_amdgcn_exp2f(x); }
__device__ __forceinline__ float fast_rcp(float x) { return __builtin_amdgcn_rcpf(x); }
__device__ __forceinline__ float sigmoidf_(float x) { return fast_rcp(1.0f + fast_exp2(-LOG2E * x)); }
__device__ __forceinline__ float siluf_(float x) { return x * sigmoidf_(x); }
__device__ __forceinline__ float gelu_tanh(float v) { const float u = 1.5957691216057308f * (v + 0.044715f * v * v * v); return v * fast_rcp(1.0f + fast_exp2(-LOG2E * u)); }
__device__ __forceinline__ float wave_sum(float v) {
#pragma unroll
    for (int o = 1; o < 64; o <<= 1) v += __shfl_xor(v, o);
    return v;
}
__device__ __forceinline__ float wave_max(float v) {
#pragma unroll
    for (int o = 1; o < 64; o <<= 1) v = fmaxf(v, __shfl_xor(v, o));
    return v;
}

namespace pg8 {
#define PG8_LAS __attribute__((address_space(3)))
typedef unsigned short bf16_t;
typedef short bf16x8 __attribute__((ext_vector_type(8)));
typedef float f32x4 __attribute__((ext_vector_type(4)));
typedef unsigned u32x4 __attribute__((ext_vector_type(4)));
constexpr int BM = 256, BK = 64, HALF = 128, HTB = HALF * BK * 2, STAGE_BYTES = 8 * HTB, NXCD = 8, WGM = 8;

__host__ __device__ __forceinline__ int lds_byte(int r, int c) { const int st = (r >> 4) * 2 + (c >> 5), rr = r & 15, cc = c & 31, ob = rr * 64 + cc * 2; return st * 1024 + (ob ^ (((ob >> 9) & 1) << 5)); }
__host__ __device__ __forceinline__ void stage_rc(int b, int& R, int& C) { const int st = b / 1024, sb = b % 1024, swz = sb ^ (((sb >> 9) & 1) << 5); R = (st >> 1) * 16 + swz / 64; C = (st & 1) * 32 + (swz % 64) / 2; }
__host__ __device__ __forceinline__ int perm32(int rho) { const int n = rho >> 4, i = rho & 15; return 8 * (i >> 2) + 4 * n + (i & 3); }

struct Unit { int pm, pn; };
struct Gemm { const bf16_t* A; const bf16_t* Bt; int lda, ldb, K; const bf16_t* A2; const bf16_t* Bt2; int K2; };

struct StaticOrder {
    int nM, nN, nwg, G, c;
    __host__ __device__ void init(int M, int N, int G_, int c_) { nM = M / BM; nN = N / BM; nwg = nM * nN; G = G_; c = c_; }
    __host__ __device__ bool next(int i, Unit& u) const {
        const long L = (long)i * G + c; if (L >= nwg) return false;
        int wgid = (int)L; { const int q = nwg / NXCD, r = nwg % NXCD, xcd = wgid % NXCD, off = wgid / NXCD; wgid = (xcd < r ? xcd * (q + 1) : r * (q + 1) + (xcd - r) * q) + off; }
        const int nig = WGM * nN, gid = wgid / nig, fm = gid * WGM, gsz = (nM - fm) < WGM ? (nM - fm) : WGM;
        u.pm = fm + ((wgid % nig) % gsz); u.pn = (wgid % nig) / gsz; return true;
    }
};
struct BlockDiagOrder {
    int RM, RN, n, G, c, first;
    __host__ __device__ void init(int ngroups, int RM_, int RN_, int G_, int c_, int first_ = 0) { RM = RM_; RN = RN_; n = ngroups * RM_ * RN_; G = G_; c = c_; first = first_; }
    __host__ __device__ bool next(int i, Unit& u) const {
        const int L = i * G + c; if (L >= n || (first && i > 0)) return false;
        const int g = L / (RM * RN), r = L % (RM * RN); u.pm = g * RM + r / RN; u.pn = g * RN + r % RN; return true;
    }
};

__device__ __forceinline__ unsigned cvt_pk_bf16(float lo, float hi) { unsigned r; asm volatile("v_cvt_pk_bf16_f32 %0, %1, %2" : "=v"(r) : "v"(lo), "v"(hi)); return r; }

template <class Epi, class Sched, bool ALIGN_EPI = false, bool SP2 = true>
__device__ __forceinline__ void gemm_phase(PG8_LAS unsigned char* lds, const Gemm g, const Sched S, const Epi E) {
    const int tid = threadIdx.x, wid = __builtin_amdgcn_readfirstlane(tid >> 6), lane = tid & 63, wr = wid >> 2, wc = wid & 3, fr = lane & 15, fq = lane >> 4;
    const int nt1 = g.K / BK, nt = (g.K + g.K2) / BK;
    unsigned voffA[2], voffB[2];
#pragma unroll
    for (int i = 0; i < 2; ++i) { int R, C; stage_rc(tid * 16 + i * 8192, R, C); const int Rb = Epi::PERM ? ((R & ~31) + perm32(R & 31)) : R;
        voffA[i] = (unsigned)(R * g.lda + C) * 2u; voffB[i] = (unsigned)(Rb * g.ldb + C) * 2u; }
    const size_t kstep = (size_t)(BK * 2);
    const size_t hstepA = (size_t)HALF * g.lda * 2, hstepB = (size_t)HALF * g.ldb * 2;
    const size_t tstepA = 2 * hstepA, tstepB = 2 * hstepB;
    const unsigned ldsw = (unsigned)wid * 1024u;
    const int aoff = lds_byte(wr * 64 + fr, fq * 8), boff = lds_byte(wc * 32 + fr, fq * 8);
#define PG8_SA(b, h) (((b) * 2 + (h)) * HTB)
#define PG8_SB(b, h) ((4 + (b) * 2 + (h)) * HTB)
#define PG8_STAGE(bufoff, gbase, voff) do { _Pragma("unroll") for (int _i = 0; _i < 2; ++_i) \
        __builtin_amdgcn_global_load_lds((const unsigned*)((const char*)(gbase) + (voff)[_i]), (PG8_LAS unsigned*)(lds + (bufoff) + ldsw + _i * 8192), 16, 0, 0); } while (0)
#define PG8_LDA(dst, b, h) do { _Pragma("unroll") for (int m = 0; m < 4; ++m) _Pragma("unroll") for (int k = 0; k < 2; ++k) dst[m][k] = *(const PG8_LAS bf16x8*)(lds + PG8_SA(b, h) + aoff + m * 2048 + k * 1024); } while (0)
#define PG8_LDB(dst, b, h) do { _Pragma("unroll") for (int n = 0; n < 2; ++n) _Pragma("unroll") for (int k = 0; k < 2; ++k) dst[n][k] = *(const PG8_LAS bf16x8*)(lds + PG8_SB(b, h) + boff + n * 2048 + k * 1024); } while (0)
#define PG8_MMA(ai, bj, At, Bt) do { __builtin_amdgcn_s_setprio(1); _Pragma("unroll") for (int m = 0; m < 4; ++m) _Pragma("unroll") for (int n = 0; n < 2; ++n) _Pragma("unroll") for (int k = 0; k < 2; ++k) \
        acc[ai][bj][m][n] = __builtin_amdgcn_mfma_f32_16x16x32_bf16(Bt[n][k], At[m][k], acc[ai][bj][m][n], 0, 0, 0); __builtin_amdgcn_s_setprio(0); } while (0)
#define PG8_WAIT_V(n) asm volatile("s_waitcnt vmcnt(" #n ")" ::: "memory")
#define PG8_WAIT_L(n) asm volatile("s_waitcnt lgkmcnt(" #n ")" ::: "memory")
#define PG8_BAR __builtin_amdgcn_s_barrier()
#define PG8_SCHED __builtin_amdgcn_sched_barrier(0)
    Unit cur, nxt; int ui = 0;
    if (!S.next(0, cur)) return;
    f32x4 acc[2][2][4][2];
#pragma unroll
    for (int a = 0; a < 2; ++a)
#pragma unroll
        for (int b = 0; b < 2; ++b)
#pragma unroll
            for (int m = 0; m < 4; ++m)
#pragma unroll
                for (int n = 0; n < 2; ++n) acc[a][b][m][n] = (f32x4){0.f, 0.f, 0.f, 0.f};
    bf16x8 At[4][2], B0[2][2], B1[2][2];
    const char* cA = (const char*)g.A + (size_t)cur.pm * tstepA; const char* cB = (const char*)g.Bt + (size_t)cur.pn * tstepB;
    const char* cA2 = (const char*)g.A2 + (size_t)cur.pm * tstepA; const char* cB2 = (const char*)g.Bt2 + (size_t)cur.pn * tstepB;
    {
        PG8_STAGE(PG8_SB(0, 0), cB, voffB); PG8_STAGE(PG8_SB(0, 1), cB + hstepB, voffB); PG8_STAGE(PG8_SA(0, 0), cA, voffA); PG8_STAGE(PG8_SA(0, 1), cA + hstepA, voffA);
        if (wr == 1) PG8_BAR;
        PG8_WAIT_V(2); PG8_BAR;
        PG8_STAGE(PG8_SB(1, 0), cB + kstep, voffB); PG8_STAGE(PG8_SA(1, 0), cA + kstep, voffA); PG8_STAGE(PG8_SB(1, 1), cB + hstepB + kstep, voffB);
        PG8_WAIT_V(6); PG8_BAR;
    }
    for (;;) {
        const bool has_next = S.next(ui + 1, nxt);
        const char* nA = has_next ? (const char*)g.A + (size_t)nxt.pm * tstepA : cA; const char* nB = has_next ? (const char*)g.Bt + (size_t)nxt.pn * tstepB : cB;
        for (int t = 0; t < nt; t += 2) {
            const bool last = (t == nt - 2);
            if constexpr (Epi::HAS_MID) { if (t == nt1) E.mid(acc, cur, wr, wc, fr, fq); }
            const char* a0 = (t < nt1) ? cA + (size_t)t * kstep : cA2 + (size_t)(t - nt1) * kstep;
            const char* a1 = a0 + kstep;
            const char* a2 = last ? nA : ((t + 2 < nt1) ? cA + (size_t)(t + 2) * kstep : cA2 + (size_t)(t + 2 - nt1) * kstep);
            const char* b2 = last ? nB : ((t + 2 < nt1) ? cB + (size_t)(t + 2) * kstep : cB2 + (size_t)(t + 2 - nt1) * kstep);
            const char* a3 = a2 + kstep; const char* b3 = b2 + kstep;
            PG8_LDB(B0, 0, 0); PG8_LDB(B1, 0, 1); PG8_SCHED; PG8_LDA(At, 0, 0); PG8_STAGE(PG8_SA(1, 1), a1 + hstepA, voffA);
            PG8_WAIT_V(8); PG8_WAIT_L(0); PG8_BAR; PG8_MMA(0, 0, At, B0); PG8_MMA(0, 1, At, B1); PG8_BAR; PG8_SCHED;
            PG8_LDA(At, 0, 1); PG8_STAGE(PG8_SB(0, 0), b2, voffB); PG8_STAGE(PG8_SB(0, 1), b2 + hstepB, voffB); PG8_STAGE(PG8_SA(0, 0), a2, voffA);
            PG8_WAIT_V(8); PG8_WAIT_L(0); PG8_BAR; PG8_MMA(1, 0, At, B0); PG8_MMA(1, 1, At, B1); PG8_BAR; PG8_SCHED;
            PG8_LDB(B0, 1, 0); PG8_LDB(B1, 1, 1); PG8_SCHED; PG8_LDA(At, 1, 0); PG8_STAGE(PG8_SA(0, 1), a2 + hstepA, voffA);
            PG8_WAIT_V(8); PG8_WAIT_L(0); PG8_BAR; PG8_MMA(0, 0, At, B0); PG8_MMA(0, 1, At, B1); PG8_BAR; PG8_SCHED;
            PG8_LDA(At, 1, 1); PG8_STAGE(PG8_SB(1, 0), b3, voffB); PG8_STAGE(PG8_SB(1, 1), b3 + hstepB, voffB); PG8_STAGE(PG8_SA(1, 0), a3, voffA);
            PG8_WAIT_V(8); PG8_WAIT_L(0); PG8_BAR; PG8_MMA(1, 0, At, B0); PG8_MMA(1, 1, At, B1); PG8_BAR; PG8_SCHED;
        }
        if constexpr (ALIGN_EPI) { if (wr == 0) PG8_BAR; }
        if constexpr (!Epi::AFTER_DRAIN) { E(acc, cur, wr, wc, fr, fq); }
        if (!has_next) break;
#pragma unroll
        for (int a = 0; a < 2; ++a)
#pragma unroll
            for (int b = 0; b < 2; ++b)
#pragma unroll
                for (int m = 0; m < 4; ++m)
#pragma unroll
                    for (int n = 0; n < 2; ++n) acc[a][b][m][n] = (f32x4){0.f, 0.f, 0.f, 0.f};
        cur = nxt; cA = nA; cB = nB; ++ui;
        cA2 = (const char*)g.A2 + (size_t)cur.pm * tstepA; cB2 = (const char*)g.Bt2 + (size_t)cur.pn * tstepB;
        if constexpr (ALIGN_EPI) { if (wr == 1) PG8_BAR; }
    }
    PG8_WAIT_V(0);
    if constexpr (!ALIGN_EPI) { if (wr == 0) PG8_BAR; }
    PG8_BAR;
    if constexpr (Epi::AFTER_DRAIN) { E.fused(acc, cur, wr, wc, fr, fq, lds, wid, lane); }
#undef PG8_SA
#undef PG8_SB
#undef PG8_STAGE
#undef PG8_LDA
#undef PG8_LDB
#undef PG8_MMA
#undef PG8_WAIT_V
#undef PG8_WAIT_L
#undef PG8_BAR
#undef PG8_SCHED
}

__device__ __forceinline__ float row_rnorm(const float* rowss, int row) {
    const f32x4* p = (const f32x4*)(rowss + (size_t)row * 32);
    f32x4 t = p[0];
#pragma unroll
    for (int i = 1; i < 8; ++i) t += p[i];
    return __builtin_amdgcn_rsqf(((t[0] + t[1]) + (t[2] + t[3])) * (1.0f / 1024.0f) + EPS);
}

__device__ __forceinline__ void stage_rnorm(const float* rowss, int pm, int wr, int lane, PG8_LAS float* rn) {
    const int sub = lane >> 3, chunk = lane & 7;
#pragma unroll
    for (int it = 0; it < 16; ++it) {
        const int loc = it * 8 + sub;
        const int row = pm * BM + (loc >> 6) * HALF + wr * 64 + (loc & 63);
        const f32x4 t = *(const f32x4*)(rowss + (size_t)row * 32 + chunk * 4);
        float sm = (t[0] + t[1]) + (t[2] + t[3]);
        sm += __shfl_xor(sm, 1); sm += __shfl_xor(sm, 2); sm += __shfl_xor(sm, 4);
        if (chunk == 0) rn[loc] = __builtin_amdgcn_rsqf(sm * (1.0f / 1024.0f) + EPS);
    }
    asm volatile("s_waitcnt lgkmcnt(0)" ::: "memory");
}

template <bool NORM> struct EpiSwiGLU {
    static constexpr bool PERM = true, AFTER_DRAIN = false, HAS_MID = false;
    bf16_t* O; const float* rowss; const float* bias; PG8_LAS float* rnb;
    __device__ __forceinline__ void operator()(const f32x4 (&acc)[2][2][4][2], const Unit& u, int wr, int wc, int fr, int fq) const {
        const int row0 = u.pm * BM + wr * 64 + fr, b = u.pm >> 5;
        const int colB0 = u.pn * BM + wc * 32 + 8 * fq, ocol0 = u.pn * 128 + wc * 32 + 8 * fq;
        f32x4 bg[2], bu[2];
#pragma unroll
        for (int n = 0; n < 2; ++n) { bg[n] = NORM ? *(const f32x4*)(bias + (size_t)b * NGU + colB0 + 4 * n) : (f32x4){0.f, 0.f, 0.f, 0.f}; bu[n] = NORM ? *(const f32x4*)(bias + (size_t)b * NGU + colB0 + 128 + 4 * n) : (f32x4){0.f, 0.f, 0.f, 0.f}; }
        PG8_LAS float* rn = rnb + (wr * 4 + wc) * 128;
        if (NORM) stage_rnorm(rowss, u.pm, wr, fq * 16 + fr, rn);
#pragma unroll
        for (int ai = 0; ai < 2; ++ai)
#pragma unroll
            for (int m = 0; m < 4; ++m) {
                const int row = row0 + ai * HALF + m * 16;
                const float r = NORM ? rn[ai * 64 + m * 16 + fr] : 1.0f;
                float o[8];
#pragma unroll
                for (int n = 0; n < 2; ++n) {
                    f32x4 gv = acc[ai][0][m][n], uv = acc[ai][1][m][n];
                    if (NORM) { gv = gv * r + bg[n]; uv = uv * r + bu[n]; }
#pragma unroll
                    for (int j = 0; j < 4; ++j) o[4 * n + j] = siluf_(gv[j]) * uv[j];
                }
                u32x4 w; w.x = cvt_pk_bf16(o[0], o[1]); w.y = cvt_pk_bf16(o[2], o[3]); w.z = cvt_pk_bf16(o[4], o[5]); w.w = cvt_pk_bf16(o[6], o[7]);
                *(u32x4*)(O + (size_t)row * FF + ocol0) = w;
            }
    }
};

template <bool XS, int TAG> struct EpiResid {
    static constexpr bool PERM = true, AFTER_DRAIN = false, HAS_MID = false;
    const bf16_t* xin; bf16_t* xout; const float* gate; bf16_t* xs; const float* cs; float* rowss; float gscale;
    __device__ __forceinline__ void operator()(const f32x4 (&acc)[2][2][4][2], const Unit& u, int wr, int wc, int fr, int fq) const {
        const int row0 = u.pm * BM + wr * 64 + fr, b = u.pm >> 5, col0 = u.pn * BM + wc * 32 + 8 * fq;
        const float gsc = gscale;
#pragma unroll
        for (int bj = 0; bj < 2; ++bj) {
            const int c = col0 + bj * HALF;
            u32x4 xr[1][2][4];
#pragma unroll
            for (int ai = 0; ai < 2; ++ai)
#pragma unroll
                for (int m = 0; m < 4; ++m) xr[0][ai][m] = *(const u32x4*)(xin + (size_t)(row0 + ai * HALF + m * 16) * D + c);
            asm volatile("" ::: "memory");
            const f32x4 g0 = *(const f32x4*)(gate + (size_t)b * NADA + c), g1 = *(const f32x4*)(gate + (size_t)b * NADA + c + 4);
            const float gv[8] = {g0[0] * gsc, g0[1] * gsc, g0[2] * gsc, g0[3] * gsc, g1[0] * gsc, g1[1] * gsc, g1[2] * gsc, g1[3] * gsc};
            float cv[8];
            if (XS) { const f32x4 c0 = *(const f32x4*)(cs + (size_t)b * D + c), c1 = *(const f32x4*)(cs + (size_t)b * D + c + 4);
                cv[0] = c0[0]; cv[1] = c0[1]; cv[2] = c0[2]; cv[3] = c0[3]; cv[4] = c1[0]; cv[5] = c1[1]; cv[6] = c1[2]; cv[7] = c1[3]; }
#pragma unroll
            for (int ai = 0; ai < 2; ++ai)
#pragma unroll
                for (int m = 0; m < 4; ++m) {
                    const int row = row0 + ai * HALF + m * 16; const size_t off = (size_t)row * D + c;
                    const u32x4 a = xr[0][ai][m];
                    const f32x4 a0 = acc[ai][bj][m][0], a1 = acc[ai][bj][m][1];
                    float v[8] = {bflo(a.x) + gv[0] * a0[0], bfhi(a.x) + gv[1] * a0[1], bflo(a.y) + gv[2] * a0[2], bfhi(a.y) + gv[3] * a0[3],
                                  bflo(a.z) + gv[4] * a1[0], bfhi(a.z) + gv[5] * a1[1], bflo(a.w) + gv[6] * a1[2], bfhi(a.w) + gv[7] * a1[3]};
                    float ss = 0.f;
#pragma unroll
                    for (int j = 0; j < 8; ++j) ss += v[j] * v[j];
                    u32x4 w; w.x = cvt_pk_bf16(v[0], v[1]); w.y = cvt_pk_bf16(v[2], v[3]); w.z = cvt_pk_bf16(v[4], v[5]); w.w = cvt_pk_bf16(v[6], v[7]);
                    *(u32x4*)(xout + off) = w;
                    if (XS) { u32x4 w2; w2.x = cvt_pk_bf16(v[0] * cv[0], v[1] * cv[1]); w2.y = cvt_pk_bf16(v[2] * cv[2], v[3] * cv[3]); w2.z = cvt_pk_bf16(v[4] * cv[4], v[5] * cv[5]); w2.w = cvt_pk_bf16(v[6] * cv[6], v[7] * cv[7]);
                        *(u32x4*)(xs + off) = w2; }
                    ss += __shfl_xor(ss, 16); ss += __shfl_xor(ss, 32);
                    if (fq == 0) rowss[(size_t)row * 32 + (u.pn * 4 + wc) * 2 + bj] = ss;
                }
            asm volatile("" ::: "memory");
        }
    }
};

struct EpiIn {
    static constexpr bool PERM = true, AFTER_DRAIN = false, HAS_MID = false;
    const float* rowss; const float* bias; bf16_t* q; bf16_t* k; bf16_t* v; bf16_t* ssmA; unsigned char* sga; unsigned char* sgs; float* kmeanp; PG8_LAS float* rnb;
    __device__ __forceinline__ void operator()(const f32x4 (&acc)[2][2][4][2], const Unit& u, int wr, int wc, int fr, int fq) const {
        const int row0 = u.pm * BM + wr * 64 + fr, b = u.pm >> 5, nb = u.pm & 31;
        const int c0 = u.pn * BM + wc * 32 + 8 * fq;
        const int region = u.pn >> 1;
        f32x4 bv[2][2];
#pragma unroll
        for (int bj = 0; bj < 2; ++bj)
#pragma unroll
            for (int n = 0; n < 2; ++n) bv[bj][n] = *(const f32x4*)(bias + (size_t)b * NIN + c0 + bj * HALF + 4 * n);
        float cs[2][8];
#pragma unroll
        for (int bj = 0; bj < 2; ++bj)
#pragma unroll
            for (int j = 0; j < 8; ++j) cs[bj][j] = 0.f;
        PG8_LAS float* rn = rnb + (wr * 4 + wc) * 128;
        stage_rnorm(rowss, u.pm, wr, fq * 16 + fr, rn);
#pragma unroll
        for (int ai = 0; ai < 2; ++ai)
#pragma unroll
            for (int m = 0; m < 4; ++m) {
                const int row = row0 + ai * HALF + m * 16;
                const float r = rn[ai * 64 + m * 16 + fr];
#pragma unroll
                for (int bj = 0; bj < 2; ++bj) {
                    const f32x4 v0 = acc[ai][bj][m][0] * r + bv[bj][0], v1 = acc[ai][bj][m][1] * r + bv[bj][1];
                    float o[8] = {v0[0], v0[1], v0[2], v0[3], v1[0], v1[1], v1[2], v1[3]};
                    const int c = c0 + bj * HALF;
                    bf16_t* dst;
                    if (region == 0) {
#pragma unroll
                        for (int j = 0; j < 8; ++j) o[j] *= QSCALE;
                        dst = q + (size_t)row * AW + c;
                    } else if (region == 1) {
#pragma unroll
                        for (int j = 0; j < 8; ++j) cs[bj][j] += o[j];
                        dst = k + (size_t)row * AW + (c - 512);
                    } else if (region == 2) {
                        dst = v + (size_t)row * AW + (c - 1024);
                    } else if (region == 3) {
                        const int cc = c - 1536, gidx = cc >> 4, ch = cc & 15, t = row & (SEQ - 1);
                        dst = ssmA + ((size_t)(gidx * 1024 + b * NCH + (t >> 5)) * KSSM + (t & 31) * SC + ch);
                    } else {
                        unsigned qv[8];
#pragma unroll
                        for (int j = 0; j < 8; ++j) { const unsigned t_ = (unsigned)(sigmoidf_(o[j]) * 256.0f); qv[j] = t_ > 255u ? 255u : t_; }
                        v2u w8; w8.x = qv[0] | (qv[1] << 8) | (qv[2] << 16) | (qv[3] << 24); w8.y = qv[4] | (qv[5] << 8) | (qv[6] << 16) | (qv[7] << 24);
                        unsigned char* g8 = (region < 6) ? sga + (size_t)row * D + (c - 2048) : sgs + (size_t)row * D + (c - 3072);
                        *(v2u*)g8 = w8;
                        continue;
                    }
                    u32x4 w; w.x = cvt_pk_bf16(o[0], o[1]); w.y = cvt_pk_bf16(o[2], o[3]); w.z = cvt_pk_bf16(o[4], o[5]); w.w = cvt_pk_bf16(o[6], o[7]);
                    *(u32x4*)dst = w;
                }
            }
        if (region == 1) {
#pragma unroll
            for (int bj = 0; bj < 2; ++bj)
#pragma unroll
                for (int j = 0; j < 8; ++j) { float s = cs[bj][j]; s += __shfl_xor(s, 1); s += __shfl_xor(s, 2); s += __shfl_xor(s, 4); s += __shfl_xor(s, 8); cs[bj][j] = s; }
            if (fr == 0) {
#pragma unroll
                for (int bj = 0; bj < 2; ++bj) {
                    float* dstp = kmeanp + ((size_t)((b * NBLK + nb) * 2 + wr) * AW + (c0 + bj * HALF - 512));
                    *(f32x4*)dstp = (f32x4){cs[bj][0], cs[bj][1], cs[bj][2], cs[bj][3]}; *(f32x4*)(dstp + 4) = (f32x4){cs[bj][4], cs[bj][5], cs[bj][6], cs[bj][7]};
                }
            }
        }
    }
};

struct EpiGlu {
    static constexpr bool PERM = true, AFTER_DRAIN = false, HAS_MID = false;
    const bf16_t* y1; const float* bglu; bf16_t* yssm;
    __device__ __forceinline__ void operator()(const f32x4 (&acc)[2][2][4][2], const Unit& u, int wr, int wc, int fr, int fq) const {
        const int row0 = u.pm * BM + wr * 64 + fr, c0 = u.pn * BM + wc * 32 + 8 * fq;
        f32x4 bv[2][2];
#pragma unroll
        for (int bj = 0; bj < 2; ++bj)
#pragma unroll
            for (int n = 0; n < 2; ++n) bv[bj][n] = *(const f32x4*)(bglu + c0 + bj * HALF + 4 * n);
#pragma unroll
        for (int ai = 0; ai < 2; ++ai)
#pragma unroll
            for (int m = 0; m < 4; ++m) {
                const int row = row0 + ai * HALF + m * 16;
#pragma unroll
                for (int bj = 0; bj < 2; ++bj) {
                    const size_t off = (size_t)row * SW + c0 + bj * HALF;
                    const u32x4 yv = *(const u32x4*)(y1 + off);
                    const f32x4 z0 = acc[ai][bj][m][0] + bv[bj][0], z1 = acc[ai][bj][m][1] + bv[bj][1];
                    float o[8];
                    o[0] = bflo(yv.x) * sigmoidf_(z0[0]); o[1] = bfhi(yv.x) * sigmoidf_(z0[1]); o[2] = bflo(yv.y) * sigmoidf_(z0[2]); o[3] = bfhi(yv.y) * sigmoidf_(z0[3]);
                    o[4] = bflo(yv.z) * sigmoidf_(z1[0]); o[5] = bfhi(yv.z) * sigmoidf_(z1[1]); o[6] = bflo(yv.w) * sigmoidf_(z1[2]); o[7] = bfhi(yv.w) * sigmoidf_(z1[3]);
                    u32x4 w; w.x = cvt_pk_bf16(o[0], o[1]); w.y = cvt_pk_bf16(o[2], o[3]); w.z = cvt_pk_bf16(o[4], o[5]); w.w = cvt_pk_bf16(o[6], o[7]);
                    *(u32x4*)(yssm + off) = w;
                }
            }
    }
};

__device__ __forceinline__ float gq(unsigned w, int i) { return (float)((w >> (8 * i)) & 255u) + 0.5f; }
struct EpiMerge {
    static constexpr bool PERM = true, AFTER_DRAIN = false, HAS_MID = true;
    const unsigned char* sga; const unsigned char* sgs; bf16_t* merged;
    __device__ __forceinline__ void mid(f32x4 (&acc)[2][2][4][2], const Unit& u, int wr, int wc, int fr, int fq) const {
        int row0 = u.pm * BM + wr * 64 + fr, c0 = u.pn * BM + wc * 32 + 8 * fq;
        asm volatile("" : "+v"(row0), "+v"(c0));
        v2u av[2][4][2], sv[2][4][2];
#pragma unroll
        for (int ai = 0; ai < 2; ++ai)
#pragma unroll
            for (int m = 0; m < 4; ++m)
#pragma unroll
                for (int bj = 0; bj < 2; ++bj) { const size_t off = (size_t)(row0 + ai * HALF + m * 16) * D + c0 + bj * HALF; av[ai][m][bj] = *(const v2u*)(sga + off); sv[ai][m][bj] = *(const v2u*)(sgs + off); }
        asm volatile("" ::: "memory");
#pragma unroll
        for (int ai = 0; ai < 2; ++ai)
#pragma unroll
            for (int m = 0; m < 4; ++m)
#pragma unroll
                for (int bj = 0; bj < 2; ++bj) {
                    const v2u a = av[ai][m][bj], sq = sv[ai][m][bj];
                    f32x4 r0, r1;
#pragma unroll
                    for (int j = 0; j < 4; ++j) { r0[j] = gq(a.x, j) * fast_rcp(gq(sq.x, j)); r1[j] = gq(a.y, j) * fast_rcp(gq(sq.y, j)); }
                    acc[ai][bj][m][0] *= r0; acc[ai][bj][m][1] *= r1;
                }
    }
    __device__ __forceinline__ void operator()(const f32x4 (&acc)[2][2][4][2], const Unit& u, int wr, int wc, int fr, int fq) const {
        const int row0 = u.pm * BM + wr * 64 + fr, c0 = u.pn * BM + wc * 32 + 8 * fq;
        v2u sv[2][4][2];
#pragma unroll
        for (int ai = 0; ai < 2; ++ai)
#pragma unroll
            for (int m = 0; m < 4; ++m)
#pragma unroll
                for (int bj = 0; bj < 2; ++bj) sv[ai][m][bj] = *(const v2u*)(sgs + (size_t)(row0 + ai * HALF + m * 16) * D + c0 + bj * HALF);
        asm volatile("" ::: "memory");
        const float sc = 1.0f / 256.0f;
#pragma unroll
        for (int ai = 0; ai < 2; ++ai)
#pragma unroll
            for (int m = 0; m < 4; ++m)
#pragma unroll
                for (int bj = 0; bj < 2; ++bj) {
                    const size_t off = (size_t)(row0 + ai * HALF + m * 16) * D + c0 + bj * HALF;
                    const v2u sq = sv[ai][m][bj];
                    const f32x4 v0 = acc[ai][bj][m][0] * sc, v1 = acc[ai][bj][m][1] * sc;
                    u32x4 w; w.x = cvt_pk_bf16(v0[0] * gq(sq.x, 0), v0[1] * gq(sq.x, 1)); w.y = cvt_pk_bf16(v0[2] * gq(sq.x, 2), v0[3] * gq(sq.x, 3));
                    w.z = cvt_pk_bf16(v1[0] * gq(sq.y, 0), v1[1] * gq(sq.y, 1)); w.w = cvt_pk_bf16(v1[2] * gq(sq.y, 2), v1[3] * gq(sq.y, 3));
                    *(u32x4*)(merged + off) = w;
                }
    }
};

struct EpiSsmState {
    static constexpr bool PERM = false, AFTER_DRAIN = true, HAS_MID = false;
    bf16_t* ssmA; const float* lam_re; const float* lam_im; const float* log_dt;
    __device__ __forceinline__ void fused(f32x4 (&acc)[2][2][4][2], const Unit& u, int wr, int wc, int fr, int fq, PG8_LAS unsigned char* lds, int wid, int lane) const {
        PG8_LAS float* X = (PG8_LAS float*)lds;
        PG8_LAS float* Eb = (PG8_LAS float*)(lds + 135168);
#pragma unroll
        for (int ai = 0; ai < 2; ++ai)
#pragma unroll
            for (int m = 0; m < 4; ++m)
#pragma unroll
                for (int n = 0; n < 2; ++n) *(PG8_LAS f32x4*)(X + (ai * HALF + wr * 64 + m * 16 + fr) * 132 + wc * 32 + n * 16 + 4 * fq) = acc[ai][0][m][n];
        asm volatile("s_waitcnt lgkmcnt(0)" ::: "memory"); __builtin_amdgcn_s_barrier(); asm volatile("" ::: "memory");
        const int g = u.pn, p = lane, seg = wid;
        const float lr = lam_re[g * SP + p], li = lam_im[g * SP + p], dt = __expf(log_dt[g]);
        float ar, ai_; { float sn, cs; __sincosf(li * dt, &sn, &cs); const float mg = __expf(lr * dt); ar = mg * cs; ai_ = mg * sn; }
        float sr = ar, si = ai_;
#pragma unroll
        for (int q = 0; q < 5; ++q) { const float t0 = sr * sr - si * si, t1 = 2.f * sr * si; sr = t0; si = t1; }
        const float aLr = sr, aLi = si;
#pragma unroll
        for (int q = 0; q < 5; ++q) { const float t0 = sr * sr - si * si, t1 = 2.f * sr * si; sr = t0; si = t1; }
        const float aSr = sr, aSi = si;
        const PG8_LAS float* Xs = X + (seg * 32) * 132 + p;
        float er = 0.f, ei = 0.f;
#pragma unroll 8
        for (int r = 0; r < 32; ++r) { const float xr = Xs[r * 132], xi = Xs[r * 132 + 64]; const float nr = aLr * er - aLi * ei + xr, ni = aLr * ei + aLi * er + xi; er = nr; ei = ni; }
        Eb[(seg * 64 + p) * 2] = er; Eb[(seg * 64 + p) * 2 + 1] = ei;
        asm volatile("s_waitcnt lgkmcnt(0)" ::: "memory"); __builtin_amdgcn_s_barrier(); asm volatile("" ::: "memory");
        float cr = 0.f, ci = 0.f;
        for (int s2 = 0; s2 < seg; ++s2) { const float xr = Eb[(s2 * 64 + p) * 2], xi = Eb[(s2 * 64 + p) * 2 + 1]; const float nr = aSr * cr - aSi * ci + xr, ni = aSr * ci + aSi * cr + xi; cr = nr; ci = ni; }
        bf16_t* dst = ssmA + ((size_t)(u.pm * BM + seg * 32) * KSSM + 512 + p);
#pragma unroll 8
        for (int r = 0; r < 32; ++r) {
            dst[(size_t)r * KSSM] = (bf16_t)f2bf(cr); dst[(size_t)r * KSSM + 64] = (bf16_t)f2bf(ci);
            const float xr = Xs[r * 132], xi = Xs[r * 132 + 64]; const float nr = aLr * cr - aLi * ci + xr, ni = aLr * ci + aLi * cr + xi; cr = nr; ci = ni;
        }
        asm volatile("s_waitcnt lgkmcnt(0)" ::: "memory"); __builtin_amdgcn_s_barrier(); asm volatile("" ::: "memory");
    }
};

struct EpiSsmMain {
    static constexpr bool PERM = true, AFTER_DRAIN = false, HAS_MID = false;
    const bf16_t* ssmA; const float* dsk; bf16_t* y1;
    __device__ __forceinline__ void operator()(const f32x4 (&acc)[2][2][4][2], const Unit& u, int wr, int wc, int fr, int fq) const {
        const int g = u.pn >> 1, b = u.pm & 3, cbase = (u.pn & 1) * BM + wc * 32 + 8 * fq;
        const int rloc0 = wr * 64 + fr;
#pragma unroll
        for (int bj = 0; bj < 2; ++bj) {
            const int c = cbase + bj * HALF, s = c >> 4, ch0 = c & 15;
            const f32x4 d0 = *(const f32x4*)(dsk + g * SC + ch0), d1 = *(const f32x4*)(dsk + g * SC + ch0 + 4);
#pragma unroll
            for (int ai = 0; ai < 2; ++ai)
#pragma unroll
                for (int m = 0; m < 4; ++m) {
                    const int rloc = rloc0 + ai * HALF + m * 16;
                    const u32x4 uv = *(const u32x4*)(ssmA + (size_t)(u.pm * BM + rloc) * KSSM + c);
                    const f32x4 v0 = acc[ai][bj][m][0], v1 = acc[ai][bj][m][1];
                    float o[8];
                    o[0] = v0[0] + d0[0] * bflo(uv.x); o[1] = v0[1] + d0[1] * bfhi(uv.x); o[2] = v0[2] + d0[2] * bflo(uv.y); o[3] = v0[3] + d0[3] * bfhi(uv.y);
                    o[4] = v1[0] + d1[0] * bflo(uv.z); o[5] = v1[1] + d1[1] * bfhi(uv.z); o[6] = v1[2] + d1[2] * bflo(uv.w); o[7] = v1[3] + d1[3] * bfhi(uv.w);
#pragma unroll
                    for (int j = 0; j < 8; ++j) o[j] = gelu_tanh(o[j]);
                    u32x4 w; w.x = cvt_pk_bf16(o[0], o[1]); w.y = cvt_pk_bf16(o[2], o[3]); w.z = cvt_pk_bf16(o[4], o[5]); w.w = cvt_pk_bf16(o[6], o[7]);
                    *(u32x4*)(y1 + (size_t)(b * SEQ + rloc * SL + s) * SW + g * SC + ch0) = w;
                }
        }
    }
};
}


#define XB_TMO      128
#define XB_XCNT(j)  (256  + 64 * (j))
#define XB_XSUB(j)  (1280 + 64 * (j))
#define XB_XGEN(j)  (2304 + 64 * (j))
#define XB_TOP      3328
#define XB_TOPGEN   3392
#define XCD_BAR_WORDS 3456
#define XB_SPIN_CAP (1u << 20)

__device__ __forceinline__ unsigned xb_ld(unsigned* p)              { return __hip_atomic_load(p, __ATOMIC_RELAXED, __HIP_MEMORY_SCOPE_AGENT); }
__device__ __forceinline__ unsigned xb_add(unsigned* p, unsigned v) { return __hip_atomic_fetch_add(p, v, __ATOMIC_RELAXED, __HIP_MEMORY_SCOPE_AGENT); }
__device__ __forceinline__ unsigned xb_xcc_id() { return (unsigned)__builtin_amdgcn_s_getreg((3 << 11) | 20) & 0xFu; }
#define XB_SPIN(cond, bar) do { unsigned _sp = 0; while (cond) { __builtin_amdgcn_s_sleep(1); \
    if ((++_sp & 255u) == 0u) { if (xb_ld(&(bar)[XB_TMO])) break; if (_sp > XB_SPIN_CAP) { atomicAdd(&(bar)[XB_TMO], 1u); break; } } } } while (0)

struct XcdBarrier { unsigned* bar; unsigned x; volatile LAS unsigned* st; };
__device__ __forceinline__ XcdBarrier xcd_barrier_post(unsigned* bar, volatile LAS unsigned* st) {
    XcdBarrier b; b.bar = bar; b.x = xb_xcc_id(); b.st = st;
    if (threadIdx.x == 0) (void)xb_add(&bar[XB_XCNT(b.x)], 1u);
    return b;
}
__device__ __forceinline__ void xcd_barrier_complete(unsigned* bar, unsigned x, unsigned& nloc, unsigned& nx) {
    const unsigned G = gridDim.x * gridDim.y * gridDim.z;
    unsigned sum, cnt, mine, sp = 0u;
    for (;;) {
        sum = 0u; cnt = 0u; mine = 0u;
#pragma unroll
        for (unsigned j = 0; j < 16; ++j) { const unsigned c = xb_ld(&bar[XB_XCNT(j)]); sum += c; cnt += (c > 0u) ? 1u : 0u; mine = (j == x) ? c : mine; }
        if (sum == G) break;
        __builtin_amdgcn_s_sleep(1);
        if ((++sp & 255u) == 0u) { if (xb_ld(&bar[XB_TMO])) break; if (sp > XB_SPIN_CAP) { atomicAdd(&bar[XB_TMO], 1u); break; } }
    }
    nloc = mine > 0u ? mine : 1u; nx = cnt > 0u ? cnt : 1u;
}
__device__ __forceinline__ void xcd_barrier(const XcdBarrier& b) {
    asm volatile("s_waitcnt vmcnt(0)" ::: "memory");
    __syncthreads();
    if (threadIdx.x == 0) {
        unsigned* bar = b.bar;
        __builtin_amdgcn_s_waitcnt(0);
        unsigned nloc = b.st[0], nx = b.st[1];
        if (nloc == 0u) { xcd_barrier_complete(bar, b.x, nloc, nx); b.st[0] = nloc; b.st[1] = nx; }
        const unsigned old = xb_add(&bar[XB_XSUB(b.x)], 1u);
        const unsigned gen = old / nloc;
        if (old + 1u == (gen + 1u) * nloc) {
            __builtin_amdgcn_fence(__ATOMIC_RELEASE, "agent");
            asm volatile("s_waitcnt vmcnt(0)" ::: "memory");
            const unsigned og = xb_add(&bar[XB_TOP], 1u);
            const unsigned tg = og / nx;
            if (og + 1u == (tg + 1u) * nx) xb_add(&bar[XB_TOPGEN], 1u);
            else XB_SPIN(xb_ld(&bar[XB_TOPGEN]) == tg, bar);
            __builtin_amdgcn_fence(__ATOMIC_ACQUIRE, "agent");
            xb_add(&bar[XB_XGEN(b.x)], 1u);
            asm volatile("s_waitcnt vmcnt(0)" ::: "memory");
        } else {
            XB_SPIN(xb_ld(&bar[XB_XGEN(b.x)]) == gen, bar);
            __builtin_amdgcn_fence(__ATOMIC_ACQUIRE, "agent");
            asm volatile("s_waitcnt vmcnt(0)" ::: "memory");
        }
    }
    __syncthreads();
}

struct Frame {
    LAS unsigned char* lds;
    volatile LAS unsigned* MISC;
    gu32* ctl;
    int tid, lane, wave, vcu, G;
    unsigned char* ws;
    const float* in[26];
    float* out;
};
enum { IN_X = 0, IN_C, IN_WADA, IN_BADA, IN_NFFN1, IN_WFFN1IN, IN_WFFN1OUT, IN_NMIX, IN_WIN, IN_LAMRE, IN_LAMIM, IN_LOGDT, IN_BRE, IN_BIM, IN_CRE, IN_CIM, IN_SSMD,
       IN_WGLU, IN_BGLU, IN_WBRATT, IN_WBRSSM, IN_WOUT, IN_NFFN2, IN_WFFN2IN, IN_WFFN2OUT, IN_NFINAL };

__device__ __forceinline__ int gu_row(int n) { return n < FF ? ((n >> 7) << 8) + (n & 127) : (((n - FF) >> 7) << 8) + 128 + ((n - FF) & 127); }
__device__ __forceinline__ void p0_transpose_item(const float* W, int K, int N, bf16* WT, int mode, LAS float* scr, int item, int lane) {
    const int nblk = N / 32, kb = item / nblk, nb = item % nblk, k0 = 64 * kb, n0 = 32 * nb;
    const int r0 = mode ? gu_row(n0) : n0;
#pragma unroll 8
    for (int i = 0; i < 32; ++i) { const int kk = 2 * i + (lane >> 5); scr[kk * 33 + (lane & 31)] = W[(size_t)(k0 + kk) * N + n0 + (lane & 31)]; }
    LDS_WAIT(); asm volatile("" ::: "memory");
    const int c = lane & 7;
#pragma unroll
    for (int j = 0; j < 4; ++j) { const int n = (lane >> 3) + 8 * j; const LAS float* s = scr + (8 * c) * 33 + n;
        v4u o; o.x = pk2(s[0 * 33], s[1 * 33]); o.y = pk2(s[2 * 33], s[3 * 33]); o.z = pk2(s[4 * 33], s[5 * 33]); o.w = pk2(s[6 * 33], s[7 * 33]);
        *(GAS v4u*)(WT + (size_t)(r0 + n) * K + k0 + 8 * c) = o; }
    LDS_WAIT(); asm volatile("" ::: "memory");
}

__device__ __forceinline__ void ssm_lane_params(const Frame& F, int g, int p, float& lr_dt, float& li_dt, float& fr, float& fi) {
    const float lr = F.in[IN_LAMRE][g * SP + p], li = F.in[IN_LAMIM][g * SP + p], dt = __expf(F.in[IN_LOGDT][g]);
    lr_dt = lr * dt; li_dt = li * dt;
    float sn, cs; __sincosf(li_dt, &sn, &cs); const float mg = __expf(lr_dt);
    const float nr = mg * cs - 1.0f, ni = mg * sn, den = lr * lr + li * li;
    fr = (nr * lr + ni * li) / den; fi = (ni * lr - nr * li) / den;
}
__device__ __forceinline__ void cpow(float lr_dt, float li_dt, float n, float& pr, float& pi) { float sn, cs; __sincosf(li_dt * n, &sn, &cs); const float mg = __expf(lr_dt * n); pr = mg * cs; pi = mg * sn; }

__device__ __forceinline__ void p0_ssm_kmat_item(const Frame& F, int item, LAS float* scr) {
    const int g = item / 63, lag = item % 63 - 31, lane = F.lane;
    bf16* Bm = (bf16*)(F.ws + WS_BM) + (size_t)g * 512 * KSSM;
    const int co = lane >> 2, ci0 = (lane & 3) * 4;
    float k0 = 0.f, k1 = 0.f, k2 = 0.f, k3 = 0.f;
    if (lag >= 0) {
        LAS float* Dre = scr; LAS float* Dim = scr + 1024; LAS float* Cre = scr + 2048; LAS float* Cim = scr + 3072;
        float lr_dt, li_dt, fr, fi; ssm_lane_params(F, g, lane, lr_dt, li_dt, fr, fi);
        float pr, pi; cpow(lr_dt, li_dt, (float)lag, pr, pi);
#pragma unroll
        for (int c = 0; c < 16; c += 4) {
            f32x4 dr, di, cr4, ci4;
#pragma unroll
            for (int e = 0; e < 4; ++e) {
                const float br = F.in[IN_BRE][(g * SP + lane) * SC + c + e], bi = F.in[IN_BIM][(g * SP + lane) * SC + c + e];
                const float bbr = fr * br - fi * bi, bbi = fr * bi + fi * br;
                dr[e] = pr * bbr - pi * bbi; di[e] = pr * bbi + pi * bbr;
                cr4[e] = F.in[IN_CRE][(g * SC + c + e) * SP + lane]; ci4[e] = F.in[IN_CIM][(g * SC + c + e) * SP + lane];
            }
            *(LAS f32x4*)(Dre + lane * 16 + c) = dr; *(LAS f32x4*)(Dim + lane * 16 + c) = di; *(LAS f32x4*)(Cre + lane * 16 + c) = cr4; *(LAS f32x4*)(Cim + lane * 16 + c) = ci4;
        }
        LDS_WAIT(); asm volatile("" ::: "memory");
#pragma unroll 4
        for (int p = 0; p < 64; ++p) {
            const float cr = Cre[p * 16 + co], cim = Cim[p * 16 + co];
            const f32x4 dr = *(const LAS f32x4*)(Dre + p * 16 + ci0), di = *(const LAS f32x4*)(Dim + p * 16 + ci0);
            k0 += cr * dr[0] - cim * di[0]; k1 += cr * dr[1] - cim * di[1]; k2 += cr * dr[2] - cim * di[2]; k3 += cr * dr[3] - cim * di[3];
        }
        LDS_WAIT(); asm volatile("" ::: "memory");
    }
    const unsigned long long w = (unsigned long long)pk2(k0, k1) | ((unsigned long long)pk2(k2, k3) << 32);
    const int alag = lag < 0 ? -lag : lag;
    for (int i = 0; i < 32 - alag; ++i) { const int sI = lag >= 0 ? i + lag : i, tI = lag >= 0 ? i : i + alag;
        *(GAS unsigned long long*)(Bm + (size_t)(sI * 16 + co) * KSSM + tI * 16 + ci0) = w; }
}
__device__ __forceinline__ void p0_ssm_vs_item(const Frame& F, int item) {
    const int g = item >> 5, s = item & 31, p = F.lane;
    float lr_dt, li_dt, fr, fi; ssm_lane_params(F, g, p, lr_dt, li_dt, fr, fi);
    {
        float pr, pi; cpow(lr_dt, li_dt, (float)(s + 1), pr, pi);
        bf16* Bm = (bf16*)(F.ws + WS_BM) + (size_t)g * 512 * KSSM;
#pragma unroll
        for (int co = 0; co < 16; ++co) {
            const float cr = F.in[IN_CRE][(g * SC + co) * SP + p], ci = F.in[IN_CIM][(g * SC + co) * SP + p];
            bf16* row = Bm + (size_t)(s * 16 + co) * KSSM + 512;
            row[p] = (bf16)f2bf(cr * pr - ci * pi); row[64 + p] = (bf16)f2bf(-(cr * pi + ci * pr));
        }
    }
    {
        float pr, pi; cpow(lr_dt, li_dt, (float)(31 - s), pr, pi);
        bf16* Bs = (bf16*)(F.ws + WS_BS) + (size_t)g * 256 * 512;
        unsigned wr_[8], wi_[8];
#pragma unroll
        for (int c = 0; c < 16; c += 2) {
            float vr[2], vi[2];
#pragma unroll
            for (int e = 0; e < 2; ++e) { const float br = F.in[IN_BRE][(g * SP + p) * SC + c + e], bi = F.in[IN_BIM][(g * SP + p) * SC + c + e];
                const float bbr = fr * br - fi * bi, bbi = fr * bi + fi * br; vr[e] = pr * bbr - pi * bbi; vi[e] = pr * bbi + pi * bbr; }
            wr_[c >> 1] = pk2(vr[0], vr[1]); wi_[c >> 1] = pk2(vi[0], vi[1]);
        }
        GAS v4u* d0 = (GAS v4u*)(Bs + (size_t)p * 512 + s * 16); GAS v4u* d1 = (GAS v4u*)(Bs + (size_t)(64 + p) * 512 + s * 16);
        GAS v4u* z0 = (GAS v4u*)(Bs + (size_t)(128 + p) * 512 + s * 16); GAS v4u* z1 = (GAS v4u*)(Bs + (size_t)(192 + p) * 512 + s * 16);
        d0[0] = (v4u){wr_[0], wr_[1], wr_[2], wr_[3]}; d0[1] = (v4u){wr_[4], wr_[5], wr_[6], wr_[7]};
        d1[0] = (v4u){wi_[0], wi_[1], wi_[2], wi_[3]}; d1[1] = (v4u){wi_[4], wi_[5], wi_[6], wi_[7]};
        z0[0] = (v4u){0u, 0u, 0u, 0u}; z0[1] = (v4u){0u, 0u, 0u, 0u}; z1[0] = (v4u){0u, 0u, 0u, 0u}; z1[1] = (v4u){0u, 0u, 0u, 0u};
    }
}

__device__ __forceinline__ void p0_prologue(Frame& F) {
    LAS float* sl = (LAS float*)(F.lds + SILU_OFF);
    for (int i = F.tid; i < BATCH * D; i += NWAVES * 64) sl[i] = siluf_(F.in[IN_C][i]);
    __syncthreads();
    LAS float* scr = (LAS float*)(F.lds + RING_OFF + F.wave * 16384);
    const int gw = F.vcu * NWAVES + F.wave, NGW = F.G * NWAVES;
    bf16* ws16 = (bf16*)F.ws;
    constexpr int I_ADA = NADA / 64;
    constexpr int I_UP = (D / 64) * (NGU / 32), I_DN = (FF / 64) * (D / 32), I_IN = (D / 64) * (NIN / 32), I_GLU = (SW / 64) * (SW / 32), I_BR = (AW / 64) * (D / 32), I_OUT = (D / 64) * (D / 32);
    constexpr int I_KM = SG * 63, I_VS = SG * 32;
    constexpr int NITEMS = I_ADA + I_KM + I_VS + 2 * I_UP + 2 * I_DN + I_IN + I_GLU + 2 * I_BR + I_OUT;
    for (int it = gw; it < NITEMS; it += NGW) {
        int r = it;
        if (r < I_ADA) {
            const int n = r * 64 + F.lane; const float* W = F.in[IN_WADA] + n;
            float a0 = 0.f, a1 = 0.f, a2 = 0.f, a3 = 0.f;
#pragma unroll 2
            for (int k = 0; k < D; k += 4) {
                const f32x4 s0 = *(const LAS f32x4*)(sl + k), s1 = *(const LAS f32x4*)(sl + D + k), s2 = *(const LAS f32x4*)(sl + 2 * D + k), s3 = *(const LAS f32x4*)(sl + 3 * D + k);
#pragma unroll
                for (int i = 0; i < 4; ++i) { const float w = W[(size_t)(k + i) * NADA]; a0 += s0[i] * w; a1 += s1[i] * w; a2 += s2[i] * w; a3 += s3[i] * w; }
            }
            float* ada = (float*)(F.ws + WS_ADA); const float bb = F.in[IN_BADA][n];
            ada[n] = a0 + bb; ada[NADA + n] = a1 + bb; ada[2 * NADA + n] = a2 + bb; ada[3 * NADA + n] = a3 + bb;
            continue;
        }
        r -= I_ADA;
        if (r < I_KM) { p0_ssm_kmat_item(F, r, scr); continue; } r -= I_KM;
        if (r < I_VS) { p0_ssm_vs_item(F, r); continue; } r -= I_VS;
        if (r < I_UP) { p0_transpose_item(F.in[IN_WFFN1IN], D, NGU, ws16 + WS_W1T / 2, 1, scr, r, F.lane); continue; } r -= I_UP;
        if (r < I_UP) { p0_transpose_item(F.in[IN_WFFN2IN], D, NGU, ws16 + WS_W3T / 2, 1, scr, r, F.lane); continue; } r -= I_UP;
        if (r < I_DN) { p0_transpose_item(F.in[IN_WFFN1OUT], FF, D, ws16 + WS_W2T / 2, 0, scr, r, F.lane); continue; } r -= I_DN;
        if (r < I_DN) { p0_transpose_item(F.in[IN_WFFN2OUT], FF, D, ws16 + WS_W4T / 2, 0, scr, r, F.lane); continue; } r -= I_DN;
        if (r < I_IN) { p0_transpose_item(F.in[IN_WIN], D, NIN, ws16 + WS_WINT / 2, 0, scr, r, F.lane); continue; } r -= I_IN;
        if (r < I_GLU) { p0_transpose_item(F.in[IN_WGLU], SW, SW, ws16 + WS_WGLU / 2, 0, scr, r, F.lane); continue; } r -= I_GLU;
        if (r < I_BR) { p0_transpose_item(F.in[IN_WBRATT], AW, D, ws16 + WS_WBRA / 2, 0, scr, r, F.lane); continue; } r -= I_BR;
        if (r < I_BR) { p0_transpose_item(F.in[IN_WBRSSM], SW, D, ws16 + WS_WBRS / 2, 0, scr, r, F.lane); continue; } r -= I_BR;
        p0_transpose_item(F.in[IN_WOUT], D, D, ws16 + WS_WOUT / 2, 0, scr, r, F.lane);
    }
}

__device__ __forceinline__ void p1_phase(Frame& F) {
    const int gw = F.vcu * NWAVES + F.wave, NGW = F.G * NWAVES;
    const float* ada = (const float*)(F.ws + WS_ADA);
    for (int i = gw * 64 + F.lane; i < 2 * BATCH * D; i += NGW * 64) {
        const int which = i / (BATCH * D), r = i % (BATCH * D), b = r / D, c = r % D;
        const float gwt = which ? F.in[IN_NFFN2][c] : F.in[IN_NMIX][c];
        const float sc = ada[b * NADA + (which ? 7 : 4) * D + c];
        ((float*)(F.ws + (which ? WS_CS3 : WS_CS2)))[r] = gwt * (1.0f + sc);
    }
    for (int it = gw; it < NIN + NGU; it += NGW) {
        const bool second = it >= NIN; const int n = second ? it - NIN : it;
        const bf16* wrow = (const bf16*)(F.ws + (second ? WS_W3T : WS_WINT)) + (size_t)n * D;
        const float* sh = ada + (second ? 6 : 3) * D;
        float a[4] = {0.f, 0.f, 0.f, 0.f};
#pragma unroll
        for (int j = 0; j < 2; ++j) {
            const int k = 8 * F.lane + 512 * j;
            const v4u w = *(const GAS v4u*)(wrow + k);
            const float wf[8] = {bflo(w.x), bfhi(w.x), bflo(w.y), bfhi(w.y), bflo(w.z), bfhi(w.z), bflo(w.w), bfhi(w.w)};
#pragma unroll
            for (int b = 0; b < 4; ++b) { const f32x4 s0 = *(const f32x4*)(sh + b * NADA + k), s1 = *(const f32x4*)(sh + b * NADA + k + 4);
                a[b] += wf[0] * s0[0] + wf[1] * s0[1] + wf[2] * s0[2] + wf[3] * s0[3] + wf[4] * s1[0] + wf[5] * s1[1] + wf[6] * s1[2] + wf[7] * s1[3]; }
        }
#pragma unroll
        for (int b = 0; b < 4; ++b) a[b] = wave_sum(a[b]);
        if (F.lane == 0) { float* dst = (float*)(F.ws + (second ? WS_BIAS3 : WS_BIAS2)); const int N = second ? NGU : NIN;
#pragma unroll
            for (int b = 0; b < 4; ++b) dst[b * N + n] = a[b]; }
    }
    bf16* h1 = (bf16*)F.out;
    for (int m0 = gw * 4; m0 < T; m0 += NGW * 4) {
        const int b = m0 / SEQ;
        f32x4 v[4][4]; float rstd[4];
#pragma unroll
        for (int q = 0; q < 4; ++q) { const GAS f32x4* xr = (const GAS f32x4*)(F.in[IN_X] + (size_t)(m0 + q) * D) + F.lane;
#pragma unroll
            for (int j = 0; j < 4; ++j) v[q][j] = xr[64 * j]; }
#pragma unroll
        for (int q = 0; q < 4; ++q) { float s = 0.f;
#pragma unroll
            for (int j = 0; j < 4; ++j) s += (v[q][j].x * v[q][j].x + v[q][j].y * v[q][j].y) + (v[q][j].z * v[q][j].z + v[q][j].w * v[q][j].w);
            rstd[q] = __builtin_amdgcn_rsqf(wave_sum(s) * (1.f / D) + EPS); }
#pragma unroll
        for (int j = 0; j < 4; ++j) {
            const int c = 4 * F.lane + 256 * j;
            const f32x4 g = *(const f32x4*)(F.in[IN_NFFN1] + c), sh = *(const f32x4*)(ada + b * NADA + c), sc = *(const f32x4*)(ada + b * NADA + D + c);
            const f32x4 gs = g * (sc + 1.0f);
#pragma unroll
            for (int q = 0; q < 4; ++q) { const f32x4 h = v[q][j] * rstd[q] * gs + sh;
                ((GAS unsigned long long*)(h1 + (size_t)(m0 + q) * D))[F.lane + 64 * j] = (unsigned long long)pk2(h.x, h.y) | ((unsigned long long)pk2(h.z, h.w) << 32);
                ((GAS unsigned long long*)(h1 + (size_t)(T + m0 + q) * D))[F.lane + 64 * j] = (unsigned long long)pk2(v[q][j].x, v[q][j].y) | ((unsigned long long)pk2(v[q][j].z, v[q][j].w) << 32); }
        }
    }
}

__device__ __forceinline__ void final_norm_phase(Frame& F) {
    const int gw = F.vcu * NWAVES + F.wave, NGW = F.G * NWAVES;
    const float* rowss = (const float*)(F.ws + WS_ROWSS);
    const bf16* x3 = (const bf16*)(F.ws + WS_X3);
    const int c0 = 8 * F.lane;
    f32x4 g[2][2];
#pragma unroll
    for (int j = 0; j < 2; ++j) { g[j][0] = *(const f32x4*)(F.in[IN_NFINAL] + c0 + 512 * j); g[j][1] = *(const f32x4*)(F.in[IN_NFINAL] + c0 + 512 * j + 4); }
    for (int m0 = gw * 4; m0 < T; m0 += NGW * 4) {
        float r[4]; v4u xv[4][2];
#pragma unroll
        for (int q = 0; q < 4; ++q) { r[q] = pg8::row_rnorm(rowss, m0 + q);
#pragma unroll
            for (int j = 0; j < 2; ++j) xv[q][j] = *(const GAS v4u*)(x3 + (size_t)(m0 + q) * D + c0 + 512 * j); }
#pragma unroll
        for (int q = 0; q < 4; ++q)
#pragma unroll
            for (int j = 0; j < 2; ++j) {
                const v4u a = xv[q][j]; GAS f32x4* o = (GAS f32x4*)(F.out + (size_t)(m0 + q) * D + c0 + 512 * j);
                o[0] = (f32x4){bflo(a.x), bfhi(a.x), bflo(a.y), bfhi(a.y)} * r[q] * g[j][0];
                o[1] = (f32x4){bflo(a.z), bfhi(a.z), bflo(a.w), bfhi(a.w)} * r[q] * g[j][1];
            }
    }
}

__device__ __forceinline__ void gating_phase(Frame& F, int rep) {
    LAS float* km = (LAS float*)(F.lds + RING_OFF);
    const float* kmeanp = (const float*)(F.ws + WS_KMEANP);
    const bf16* q = (const bf16*)(F.ws + WS_Q);
    unsigned* sel = (unsigned*)(F.ws + WS_SEL);
    constexpr int NITEM = BATCH * NH * (NBLK - 1);
    LAS unsigned* qslot = (LAS unsigned*)(F.lds + 32768);
    for (;;) {
        __syncthreads();
        if (F.tid == 0) qslot[0] = __hip_atomic_fetch_add((unsigned*)(F.ctl + CW_QUEUE + 128 + 64 * rep), 1u, RLX_AGENT);
        __syncthreads();
        const int it = (int)qslot[0];
        if (it >= NITEM) break;
        const int i = 31 - (it >> 5), h = it & 7, b = (it >> 3) & 3;
        for (int e = F.tid; e < i * 64; e += NWAVES * 64) { const int n = e >> 6, d = e & 63;
            km[e] = (kmeanp[(size_t)((b * NBLK + n) * 2 + 0) * AW + h * HD + d] + kmeanp[(size_t)((b * NBLK + n) * 2 + 1) * AW + h * HD + d]) * (1.0f / 256.0f); }
        __syncthreads();
        const int ql = F.lane & 31, half = F.lane >> 5, t = i * MBLK + F.wave * 32 + ql;
        const bf16* qrow = q + (size_t)(b * SEQ + t) * AW + h * HD;
        float qf[64];
#pragma unroll
        for (int c = 0; c < 8; ++c) { const v4u w = *(const GAS v4u*)(qrow + 8 * c);
            qf[8 * c + 0] = bflo(w.x); qf[8 * c + 1] = bfhi(w.x); qf[8 * c + 2] = bflo(w.y); qf[8 * c + 3] = bfhi(w.y); qf[8 * c + 4] = bflo(w.z); qf[8 * c + 5] = bfhi(w.z); qf[8 * c + 6] = bflo(w.w); qf[8 * c + 7] = bfhi(w.w); }
        float v0 = -3e38f, v1 = -3e38f, v2 = -3e38f; int i0 = 255, i1 = 255, i2 = 255;
        for (int n = half; n < i; n += 2) {
            const LAS f32x4* kr = (const LAS f32x4*)(km + n * 64);
            float dot = 0.f;
#pragma unroll
            for (int c = 0; c < 16; ++c) { const f32x4 kv = kr[c]; dot += qf[4 * c] * kv[0] + qf[4 * c + 1] * kv[1] + qf[4 * c + 2] * kv[2] + qf[4 * c + 3] * kv[3]; }
            if (dot > v0) { v2 = v1; i2 = i1; v1 = v0; i1 = i0; v0 = dot; i0 = n; }
            else if (dot > v1) { v2 = v1; i2 = i1; v1 = dot; i1 = n; }
            else if (dot > v2) { v2 = dot; i2 = n; }
        }
        const float ov[3] = {__shfl_xor(v0, 32), __shfl_xor(v1, 32), __shfl_xor(v2, 32)};
        const int oi[3] = {__shfl_xor(i0, 32), __shfl_xor(i1, 32), __shfl_xor(i2, 32)};
#pragma unroll
        for (int k = 0; k < 3; ++k) {
            const float d = ov[k]; const int n = oi[k];
            if (d > v0 || (d == v0 && n < i0)) { v2 = v1; i2 = i1; v1 = v0; i1 = i0; v0 = d; i0 = n; }
            else if (d > v1 || (d == v1 && n < i1)) { v2 = v1; i2 = i1; v1 = d; i1 = n; }
            else if (d > v2 || (d == v2 && n < i2)) { v2 = d; i2 = n; }
        }
        if (half == 0) sel[(size_t)(b * NH + h) * SEQ + t] = (unsigned)i0 | ((unsigned)i1 << 8) | ((unsigned)i2 << 16);
    }
}

namespace att {
typedef float f32x16 __attribute__((ext_vector_type(16)));
typedef short s16x4 __attribute__((ext_vector_type(4)));
typedef short v4i16_t __attribute__((ext_vector_type(4)));
typedef __bf16 bf16x2_t __attribute__((ext_vector_type(2)));
constexpr float ATT_THR = 8.0f;
constexpr int ATT_K = 0, ATT_V = 32768, ATT_LIST = 65536, ATT_WS = 81920, ATT_OST = 83968, ATT_CNT = 116736;
__device__ __forceinline__ int crow(int r, int hi) { return (r & 3) + 8 * (r >> 2) + 4 * hi; }
__device__ __forceinline__ unsigned cvtpk(float lo, float hi) { f32x2 v = {lo, hi}; bf16x2_t b = __builtin_convertvector(v, bf16x2_t); return __builtin_bit_cast(unsigned, b); }
__device__ __forceinline__ s16x4 vtr(const LAS unsigned char* p) { return __builtin_bit_cast(s16x4, __builtin_amdgcn_ds_read_tr16_b64_v4i16((LAS v4i16_t*)p)); }
__device__ __forceinline__ float swapmax(float m) { auto rr = __builtin_amdgcn_permlane32_swap(__float_as_uint(m), __float_as_uint(m), false, false); return fmaxf(__uint_as_float(rr[0]), __uint_as_float(rr[1])); }
__device__ __forceinline__ float swapsum(float m) { auto rr = __builtin_amdgcn_permlane32_swap(__float_as_uint(m), __float_as_uint(m), false, false); return __uint_as_float(rr[0]) + __uint_as_float(rr[1]); }

__device__ __forceinline__ void load_kv(Frame& F, int b, int h, int j) {
    const bf16* K = (const bf16*)(F.ws + WS_K); const bf16* V = (const bf16*)(F.ws + WS_V);
    const size_t row0 = (size_t)(b * SEQ + j * MBLK);
#pragma unroll
    for (int kt = 0; kt < 4; ++kt) {
        const bf16* ksrc = K + (row0 + kt * 64 + F.lane) * AW + h * HD + F.wave * 8;
        __builtin_amdgcn_global_load_lds((const unsigned*)ksrc, (LAS unsigned*)(F.lds + ATT_K + kt * 8192 + F.wave * 1024), 16, 0, 0);
        const bf16* vsrc = V + (row0 + kt * 64 + 16 * (F.wave & 3) + (F.lane >> 2)) * AW + h * HD + (F.wave >> 2) * 32 + (F.lane & 3) * 8;
        __builtin_amdgcn_global_load_lds((const unsigned*)vsrc, (LAS unsigned*)(F.lds + ATT_V + kt * 8192 + F.wave * 1024), 16, 0, 0);
    }
}

template <bool CAUSAL>
__device__ __forceinline__ void attn_tile(Frame& F, const bf16x8 (&qr)[4], int reli, float slope2, int nkt, f32x16 (&o)[2], float& m_out, float& l_out) {
    const int lane = F.lane, r32 = lane & 31, hi = lane >> 5;
    LAS float* wsf = (LAS float*)(F.lds + ATT_WS + F.wave * 256);
    float m = 0.f, l = 0.f;
#pragma unroll
    for (int r = 0; r < 16; ++r) { o[0][r] = 0.f; o[1][r] = 0.f; }
    const float base0 = slope2 * (float)(4 * hi - reli);
    for (int kt = nkt - 1; kt >= 0; --kt) {
        const bool first = (kt == nkt - 1);
        const LAS unsigned char* Ks = F.lds + ATT_K + kt * 8192 + hi * 1024 + r32 * 16;
        f32x16 p0, p1;
        const float bkt = base0 + slope2 * (float)(64 * kt) - m;
#pragma unroll
        for (int r = 0; r < 16; ++r) { p0[r] = bkt + slope2 * (float)((r & 3) + 8 * (r >> 2)); p1[r] = p0[r] + slope2 * 32.0f; }
#pragma unroll
        for (int d0 = 0; d0 < 4; ++d0) {
            const bf16x8 a0 = *(const LAS bf16x8*)(Ks + d0 * 2048), a1 = *(const LAS bf16x8*)(Ks + d0 * 2048 + 512);
            p0 = __builtin_amdgcn_mfma_f32_32x32x16_bf16(a0, qr[d0], p0, 0, 0, 0);
            p1 = __builtin_amdgcn_mfma_f32_32x32x16_bf16(a1, qr[d0], p1, 0, 0, 0);
        }
        if (CAUSAL && first) {
#pragma unroll
            for (int r = 0; r < 16; ++r) { const int kp = 64 * kt + crow(r, hi); if (kp > reli) p0[r] = -1e30f; if (kp + 32 > reli) p1[r] = -1e30f; }
        }
        float mt = fmaxf(p0[0], p1[0]);
#pragma unroll
        for (int r = 1; r < 16; ++r) mt = fmaxf(mt, fmaxf(p0[r], p1[r]));
        mt = swapmax(mt);
        if (first || __any(mt > ATT_THR)) {
            const float delta = first ? mt : fmaxf(mt, 0.f);
            m += delta;
#pragma unroll
            for (int r = 0; r < 16; ++r) { p0[r] -= delta; p1[r] -= delta; }
            if (!first) {
                const float alpha = fast_exp2(-delta);
                l *= alpha;
                if (hi == 0) wsf[r32] = alpha;
                asm volatile("s_waitcnt lgkmcnt(0)" ::: "memory");
#pragma unroll
                for (int r = 0; r < 16; ++r) { const float a = wsf[crow(r, hi)]; o[0][r] *= a; o[1][r] *= a; }
                asm volatile("" ::: "memory");
            }
        }
        float rs = 0.f;
#pragma unroll
        for (int r = 0; r < 16; ++r) { p0[r] = fast_exp2(p0[r]); p1[r] = fast_exp2(p1[r]); rs += p0[r] + p1[r]; }
        l += rs;
        v4u pw0, pw1, pw2, pw3;
        pw0.x = cvtpk(p0[0], p0[1]); pw0.y = cvtpk(p0[2], p0[3]); pw0.z = cvtpk(p0[4], p0[5]); pw0.w = cvtpk(p0[6], p0[7]);
        pw1.x = cvtpk(p0[8], p0[9]); pw1.y = cvtpk(p0[10], p0[11]); pw1.z = cvtpk(p0[12], p0[13]); pw1.w = cvtpk(p0[14], p0[15]);
        pw2.x = cvtpk(p1[0], p1[1]); pw2.y = cvtpk(p1[2], p1[3]); pw2.z = cvtpk(p1[4], p1[5]); pw2.w = cvtpk(p1[6], p1[7]);
        pw3.x = cvtpk(p1[8], p1[9]); pw3.y = cvtpk(p1[10], p1[11]); pw3.z = cvtpk(p1[12], p1[13]); pw3.w = cvtpk(p1[14], p1[15]);
        const LAS unsigned char* vp = F.lds + ATT_V + kt * 8192 + ((lane >> 4) & 1) * 32 + (lane & 3) * 8 + (4 * hi + ((lane & 15) >> 2)) * 64;
#pragma unroll
        for (int d0 = 0; d0 < 2; ++d0) {
#define ATT_PV(ks, pw) { const s16x4 lo = vtr(vp + d0 * 4096 + (ks) * 1024), hh = vtr(vp + d0 * 4096 + (ks) * 1024 + 512); \
            const bf16x8 vf = (bf16x8){lo[0], lo[1], lo[2], lo[3], hh[0], hh[1], hh[2], hh[3]}; \
            o[d0] = __builtin_amdgcn_mfma_f32_32x32x16_bf16(__builtin_bit_cast(bf16x8, pw), vf, o[d0], 0, 0, 0); }
            ATT_PV(0, pw0) ATT_PV(1, pw1) ATT_PV(2, pw2) ATT_PV(3, pw3)
#undef ATT_PV
        }
    }
    m_out = m; l_out = swapsum(l);
}

__device__ __forceinline__ void stage_o(Frame& F, const f32x16 (&o)[2], float l) {
    const int lane = F.lane, r32 = lane & 31, hi = lane >> 5;
    LAS float* wsf = (LAS float*)(F.lds + ATT_WS + F.wave * 256);
    LAS bf16* stg = (LAS bf16*)(F.lds + ATT_OST + F.wave * 4096);
    if (hi == 0) wsf[32 + r32] = l;
    asm volatile("s_waitcnt lgkmcnt(0)" ::: "memory");
#pragma unroll
    for (int r = 0; r < 16; ++r) { const int orow = crow(r, hi); const float rl = fast_rcp(wsf[32 + orow]);
        stg[orow * 64 + r32] = (bf16)f2bf(o[0][r] * rl); stg[orow * 64 + 32 + r32] = (bf16)f2bf(o[1][r] * rl); }
    asm volatile("s_waitcnt lgkmcnt(0)" ::: "memory");
}

__device__ __forceinline__ void gathered_phase(Frame& F, int rep) {
    const bf16* Q = (const bf16*)(F.ws + WS_Q);
    const unsigned* sel = (const unsigned*)(F.ws + WS_SEL);
    bf16* part = (bf16*)(F.ws + WS_PART); float* lseb = (float*)(F.ws + WS_LSE);
    LAS unsigned short* list = (LAS unsigned short*)(F.lds + ATT_LIST);
    LAS unsigned* cnt = (LAS unsigned*)(F.lds + ATT_CNT);
    constexpr int NITEM = BATCH * NH * (NBLK - 1);
    const int lane = F.lane, r32 = lane & 31, hi = lane >> 5;
    for (;;) {
        __syncthreads();
        if (F.tid == 0) { cnt[1] = __hip_atomic_fetch_add((unsigned*)(F.ctl + CW_QUEUE + 64 * rep), 1u, RLX_AGENT); cnt[0] = 0u; }
        __syncthreads();
        const int item = (int)cnt[1];
        if (item >= NITEM) break;
        const int j = item >> 5, bh = item & 31, b = bh >> 3, h = bh & 7;
        load_kv(F, b, h, j);
        const unsigned* selrow = sel + (size_t)bh * SEQ;
        const int tstart = (j + 1) * MBLK, nk = (SEQ - tstart + NWAVES * 64 - 1) / (NWAVES * 64);
        unsigned sw[16];
#pragma unroll
        for (int k = 0; k < 16; ++k) { const int t = tstart + k * NWAVES * 64 + F.tid; sw[k] = (k < nk && t < SEQ) ? selrow[t] : 0xffffffffu; }
#pragma unroll
        for (int k = 0; k < 16; ++k) if (k < nk) {
            const int t = tstart + k * NWAVES * 64 + F.tid;
            const int own = t >> 8, nv = own < 3 ? own : 3;
            int slot = -1;
            if ((int)(sw[k] & 255u) == j && nv > 0) slot = 0; else if ((int)((sw[k] >> 8) & 255u) == j && nv > 1) slot = 1; else if ((int)((sw[k] >> 16) & 255u) == j && nv > 2) slot = 2;
            const bool match = t < SEQ && slot >= 0;
            const unsigned long long bal = __ballot(match);
            const int tot = __popcll(bal), pre = __popcll(bal & ((1ull << lane) - 1ull));
            unsigned base = 0u;
            if (lane == 0 && tot) base = __hip_atomic_fetch_add(cnt, (unsigned)tot, __ATOMIC_RELAXED, __HIP_MEMORY_SCOPE_WORKGROUP);
            base = (unsigned)__builtin_amdgcn_readfirstlane((int)base);
            if (match) list[base + pre] = (unsigned short)(t | (slot << 13));
        }
        asm volatile("s_waitcnt vmcnt(0) lgkmcnt(0)" ::: "memory");
        __syncthreads();
        const int n = (int)cnt[0];
        const int ntile = (n + 31) >> 5;
        const float slope2 = exp2f(-(float)(h + 1)) * LOG2E;
        bf16x8 qn[4]; unsigned en = 0u;
        if (F.wave < ntile) { const int idx = F.wave * 32 + r32; en = list[idx < n ? idx : n - 1];
            const bf16* qrow = Q + (size_t)(b * SEQ + (int)(en & 0x1fffu)) * AW + h * HD;
#pragma unroll
            for (int d0 = 0; d0 < 4; ++d0) qn[d0] = *(const GAS bf16x8*)(qrow + d0 * 16 + hi * 8); }
        for (int tile = F.wave; tile < ntile; tile += NWAVES) {
            const int idx = tile * 32 + r32;
            const unsigned e = en; const int t = (int)(e & 0x1fffu);
            bf16x8 qr[4];
#pragma unroll
            for (int d0 = 0; d0 < 4; ++d0) qr[d0] = qn[d0];
            if (tile + NWAVES < ntile) { const int idx2 = (tile + NWAVES) * 32 + r32; en = list[idx2 < n ? idx2 : n - 1];
                const bf16* qrow = Q + (size_t)(b * SEQ + (int)(en & 0x1fffu)) * AW + h * HD;
#pragma unroll
                for (int d0 = 0; d0 < 4; ++d0) qn[d0] = *(const GAS bf16x8*)(qrow + d0 * 16 + hi * 8); }
            f32x16 o[2]; float m, l;
            attn_tile<false>(F, qr, t - j * MBLK, slope2, 4, o, m, l);
            if (hi == 0 && idx < n) lseb[((size_t)(b * SEQ + t) * NH + h) * 3 + (e >> 13)] = m + __log2f(l);
            stage_o(F, o, l);
            const LAS bf16* stg = (const LAS bf16*)(F.lds + ATT_OST + F.wave * 4096);
#pragma unroll
            for (int i = 0; i < 4; ++i) { const int row = i * 8 + (lane >> 3), ch = lane & 7, ri = tile * 32 + row;
                if (ri < n) { const unsigned er = list[ri]; const v4u v = *(const LAS v4u*)(stg + row * 64 + ch * 8);
                    *(GAS v4u*)(part + ((size_t)(b * SEQ + (int)(er & 0x1fffu)) * 3 + (er >> 13)) * AW + h * HD + ch * 8) = v; } }
            asm volatile("s_waitcnt lgkmcnt(0)" ::: "memory");
        }
    }
}

__device__ __forceinline__ void own_phase(Frame& F) {
    const bf16* Q = (const bf16*)(F.ws + WS_Q);
    const bf16* part = (const bf16*)(F.ws + WS_PART); const float* lseb = (const float*)(F.ws + WS_LSE);
    bf16* yatt = (bf16*)(F.ws + WS_YATT);
    constexpr int NITEM = BATCH * NH * NBLK;
    const int lane = F.lane, r32 = lane & 31, hi = lane >> 5;
    for (int it = F.vcu; it < NITEM; it += F.G) {
        const int i = it & 31, bh = it >> 5, b = bh >> 3, h = bh & 7;
        __syncthreads();
        load_kv(F, b, h, i);
        const float slope2 = exp2f(-(float)(h + 1)) * LOG2E;
        const int reli = F.wave * 32 + r32, t = i * MBLK + reli;
        bf16x8 qr[4];
        { const bf16* qrow = Q + (size_t)(b * SEQ + t) * AW + h * HD;
#pragma unroll
          for (int d0 = 0; d0 < 4; ++d0) qr[d0] = *(const GAS bf16x8*)(qrow + d0 * 16 + hi * 8); }
        asm volatile("s_waitcnt vmcnt(0)" ::: "memory");
        __syncthreads();
        f32x16 o[2]; float m, l;
        attn_tile<true>(F, qr, reli, slope2, (F.wave >> 1) + 1, o, m, l);
        LAS float* wsf = (LAS float*)(F.lds + ATT_WS + F.wave * 256);
        if (hi == 0) wsf[r32] = m + __log2f(l);
        stage_o(F, o, l);
        const LAS bf16* stg = (const LAS bf16*)(F.lds + ATT_OST + F.wave * 4096);
        const int nv = i < 3 ? i : 3;
#pragma unroll
        for (int k = 0; k < 4; ++k) {
            const int row = k * 8 + (lane >> 3), ch = lane & 7, tr = i * MBLK + F.wave * 32 + row;
            const v4u ov = *(const LAS v4u*)(stg + row * 64 + ch * 8);
            const float lown = wsf[row];
            float ls[3]; float M = lown;
#pragma unroll
            for (int s2 = 0; s2 < 3; ++s2) { ls[s2] = (s2 < nv) ? lseb[((size_t)(b * SEQ + tr) * NH + h) * 3 + s2] : -1e30f; M = fmaxf(M, ls[s2]); }
            float wown = fast_exp2(lown - M), W = wown;
            float a[8] = {bflo(ov.x) * wown, bfhi(ov.x) * wown, bflo(ov.y) * wown, bfhi(ov.y) * wown, bflo(ov.z) * wown, bfhi(ov.z) * wown, bflo(ov.w) * wown, bfhi(ov.w) * wown};
#pragma unroll
            for (int s2 = 0; s2 < 3; ++s2) if (s2 < nv) {
                const float w = fast_exp2(ls[s2] - M); W += w;
                const v4u pv = *(const GAS v4u*)(part + ((size_t)(b * SEQ + tr) * 3 + s2) * AW + h * HD + ch * 8);
                a[0] += w * bflo(pv.x); a[1] += w * bfhi(pv.x); a[2] += w * bflo(pv.y); a[3] += w * bfhi(pv.y); a[4] += w * bflo(pv.z); a[5] += w * bfhi(pv.z); a[6] += w * bflo(pv.w); a[7] += w * bfhi(pv.w);
            }
            const float rw = fast_rcp(W);
            v4u outv; outv.x = pk2(a[0] * rw, a[1] * rw); outv.y = pk2(a[2] * rw, a[3] * rw); outv.z = pk2(a[4] * rw, a[5] * rw); outv.w = pk2(a[6] * rw, a[7] * rw);
            *(GAS v4u*)(yatt + (size_t)(b * SEQ + tr) * AW + h * HD + ch * 8) = outv;
        }
        asm volatile("s_waitcnt lgkmcnt(0)" ::: "memory");
    }
}
}

struct Args { const float* in[26]; float* out; unsigned char* ws; int ph_lo, ph_hi, li, pad; };

__global__ void __launch_bounds__(NWAVES * 64, 2) hybrid_fwd(Args args) {
    extern __shared__ __attribute__((aligned(16))) unsigned char lds[];
    Frame F;
    F.lds = (LAS unsigned char*)lds;
    F.MISC = (volatile LAS unsigned*)(F.lds + MISC_OFF);
    F.tid = threadIdx.x; F.lane = F.tid & 63; F.wave = __builtin_amdgcn_readfirstlane(F.tid >> 6);
    F.G = gridDim.x; { const int bx = blockIdx.x; F.vcu = (F.G % 8 == 0) ? (bx % 8) * (F.G / 8) + bx / 8 : bx; }
    F.ws = args.ws; F.ctl = (gu32*)(args.ws + WS_CTL); F.out = args.out;
#pragma unroll
    for (int i = 0; i < 26; ++i) F.in[i] = args.in[i];
    for (int u = F.tid; u < 64; u += NWAVES * 64) ((LAS unsigned*)(F.lds + MISC_OFF))[u] = 0u;
    __syncthreads();
    XcdBarrier bar; bar.bar = (unsigned*)(F.ctl + CW_BAR); bar.x = 0; bar.st = nullptr;
    if (MK_N_LAUNCHES == 1) bar = xcd_barrier_post((unsigned*)(F.ctl + CW_BAR), F.MISC + 8);
#define GRID_BAR() do { if (MK_N_LAUNCHES == 1) xcd_barrier(bar); } while (0)
#ifndef DUP_MASK
#define DUP_MASK 0
#endif
#define NREP(k) (((DUP_MASK >> (k)) & 1) ? 2 : 1)
    const int lo = args.ph_lo, hi = args.ph_hi;
#define IN(k) (lo <= (k) && (k) < hi)
#define BOTH(k) (IN(k) && IN((k) + 1))
    unsigned char* ws = args.ws;
    const float* ada = (const float*)(ws + WS_ADA);
    float* rowss = (float*)(ws + WS_ROWSS);
    const int bx = (int)blockIdx.x;

    if (IN(0)) { _Pragma("unroll") for (int rep = 0; rep < NREP(0); ++rep) { if (rep) GRID_BAR(); p0_prologue(F); } if (BOTH(0)) GRID_BAR(); }
    if (IN(1)) { _Pragma("unroll") for (int rep = 0; rep < NREP(1); ++rep) { if (rep) GRID_BAR(); p1_phase(F); } if (BOTH(1)) GRID_BAR(); }
    if (IN(2)) { _Pragma("unroll") for (int rep = 0; rep < NREP(2); ++rep) { if (rep) GRID_BAR();
        pg8::Gemm g{(const bf16*)F.out, (const bf16*)(ws + WS_W1T), D, D, D, nullptr, nullptr, 0}; pg8::StaticOrder S; S.init(T, NGU, F.G, bx);
        pg8::EpiSwiGLU<false> E{(bf16*)(ws + WS_ACT), nullptr, nullptr, (LAS float*)(F.lds + RN_OFF)};
        pg8::gemm_phase<pg8::EpiSwiGLU<false>, pg8::StaticOrder, true>(F.lds + RING_OFF, g, S, E);
        } if (BOTH(2)) GRID_BAR();
    }
    if (IN(3)) { _Pragma("unroll") for (int rep = 0; rep < NREP(3); ++rep) { if (rep) GRID_BAR();
        pg8::Gemm g{(const bf16*)(ws + WS_ACT), (const bf16*)(ws + WS_W2T), FF, FF, FF, nullptr, nullptr, 0}; pg8::StaticOrder S; S.init(T, D, F.G, bx);
        pg8::EpiResid<true, 0> E{(const bf16*)F.out + (size_t)T * D, (bf16*)F.out, ada + 2 * D, (bf16*)(ws + WS_X1S), (const float*)(ws + WS_CS2), rowss, 0.5f};
        pg8::gemm_phase<pg8::EpiResid<true, 0>, pg8::StaticOrder, true>(F.lds + RING_OFF, g, S, E);
        } if (BOTH(3)) GRID_BAR();
    }
    if (IN(4)) { _Pragma("unroll") for (int rep = 0; rep < NREP(4); ++rep) { if (rep) GRID_BAR();
        pg8::Gemm g{(const bf16*)(ws + WS_X1S), (const bf16*)(ws + WS_WINT), D, D, D, nullptr, nullptr, 0}; pg8::StaticOrder S; S.init(T, NIN, F.G, bx);
        pg8::EpiIn E{rowss, (const float*)(ws + WS_BIAS2), (bf16*)(ws + WS_Q), (bf16*)(ws + WS_K), (bf16*)(ws + WS_V), (bf16*)(ws + WS_SSMA), (unsigned char*)(ws + WS_SGA), (unsigned char*)(ws + WS_SGS), (float*)(ws + WS_KMEANP), (LAS float*)(F.lds + RN_OFF)};
        pg8::gemm_phase<pg8::EpiIn, pg8::StaticOrder, true>(F.lds + RING_OFF, g, S, E);
        } if (BOTH(4)) GRID_BAR();
    }
    if (IN(5)) { _Pragma("unroll") for (int rep = 0; rep < NREP(5); ++rep) { if (rep) GRID_BAR();
        {
            pg8::Gemm g{(const bf16*)(ws + WS_SSMA), (const bf16*)(ws + WS_BS), KSSM, 512, 512, nullptr, nullptr, 0}; pg8::BlockDiagOrder S; S.init(SG, 4, 1, F.G, bx);
            pg8::EpiSsmState E{(bf16*)(ws + WS_SSMA), F.in[IN_LAMRE], F.in[IN_LAMIM], F.in[IN_LOGDT]};
            pg8::gemm_phase<pg8::EpiSsmState, pg8::BlockDiagOrder, false>(F.lds + RING_OFF, g, S, E);
        }
        gating_phase(F, rep);
        } if (BOTH(5)) GRID_BAR();
    }
    if (IN(6)) { _Pragma("unroll") for (int rep = 0; rep < NREP(6); ++rep) { if (rep) GRID_BAR();
        {
            pg8::Gemm g{(const bf16*)(ws + WS_SSMA), (const bf16*)(ws + WS_BM), KSSM, KSSM, KSSM, nullptr, nullptr, 0}; pg8::BlockDiagOrder S; S.init(SG, 4, 2, F.G, bx);
            pg8::EpiSsmMain E{(const bf16*)(ws + WS_SSMA), F.in[IN_SSMD], (bf16*)(ws + WS_Y1)};
            pg8::gemm_phase<pg8::EpiSsmMain, pg8::BlockDiagOrder, true>(F.lds + RING_OFF, g, S, E);
        }
        att::gathered_phase(F, rep);
        } if (BOTH(6)) GRID_BAR();
    }
    if (IN(7)) { _Pragma("unroll") for (int rep = 0; rep < NREP(7); ++rep) { if (rep) GRID_BAR();
        pg8::Gemm g{(const bf16*)(ws + WS_Y1), (const bf16*)(ws + WS_WGLU), SW, SW, SW, nullptr, nullptr, 0}; pg8::StaticOrder S; S.init(T, SW, F.G, bx);
        pg8::EpiGlu E{(const bf16*)(ws + WS_Y1), F.in[IN_BGLU], (bf16*)(ws + WS_YSSM)};
        pg8::gemm_phase<pg8::EpiGlu, pg8::StaticOrder, true>(F.lds + RING_OFF, g, S, E);
        att::own_phase(F);
        } if (BOTH(7)) GRID_BAR();
    }
    if (IN(8)) { _Pragma("unroll") for (int rep = 0; rep < NREP(8); ++rep) { if (rep) GRID_BAR();
        pg8::Gemm g{(const bf16*)(ws + WS_YATT), (const bf16*)(ws + WS_WBRA), AW, AW, AW, (const bf16*)(ws + WS_YSSM), (const bf16*)(ws + WS_WBRS), SW}; pg8::StaticOrder S; S.init(T, D, F.G, bx);
        pg8::EpiMerge E{(const unsigned char*)(ws + WS_SGA), (const unsigned char*)(ws + WS_SGS), (bf16*)(ws + WS_MERGED)};
        pg8::gemm_phase<pg8::EpiMerge, pg8::StaticOrder, true>(F.lds + RING_OFF, g, S, E);
        } if (BOTH(8)) GRID_BAR();
    }
    if (IN(9)) { _Pragma("unroll") for (int rep = 0; rep < NREP(9); ++rep) { if (rep) GRID_BAR();
        pg8::Gemm g{(const bf16*)(ws + WS_MERGED), (const bf16*)(ws + WS_WOUT), D, D, D, nullptr, nullptr, 0}; pg8::StaticOrder S; S.init(T, D, F.G, bx);
        pg8::EpiResid<true, 1> E{(const bf16*)F.out, (bf16*)F.out + (size_t)T * D, ada + 5 * D, (bf16*)(ws + WS_X2S), (const float*)(ws + WS_CS3), rowss, 1.0f};
        pg8::gemm_phase<pg8::EpiResid<true, 1>, pg8::StaticOrder, true>(F.lds + RING_OFF, g, S, E);
        } if (BOTH(9)) GRID_BAR();
    }
    if (IN(10)) { _Pragma("unroll") for (int rep = 0; rep < NREP(10); ++rep) { if (rep) GRID_BAR();
        pg8::Gemm g{(const bf16*)(ws + WS_X2S), (const bf16*)(ws + WS_W3T), D, D, D, nullptr, nullptr, 0}; pg8::StaticOrder S; S.init(T, NGU, F.G, bx);
        pg8::EpiSwiGLU<true> E{(bf16*)(ws + WS_ACT), rowss, (const float*)(ws + WS_BIAS3), (LAS float*)(F.lds + RN_OFF)};
        pg8::gemm_phase<pg8::EpiSwiGLU<true>, pg8::StaticOrder, true>(F.lds + RING_OFF, g, S, E);
        } if (BOTH(10)) GRID_BAR();
    }
    if (IN(11)) { _Pragma("unroll") for (int rep = 0; rep < NREP(11); ++rep) { if (rep) GRID_BAR();
        pg8::Gemm g{(const bf16*)(ws + WS_ACT), (const bf16*)(ws + WS_W4T), FF, FF, FF, nullptr, nullptr, 0}; pg8::StaticOrder S; S.init(T, D, F.G, bx);
        pg8::EpiResid<false, 2> E{(const bf16*)F.out + (size_t)T * D, (bf16*)(ws + WS_X3), ada + 8 * D, nullptr, nullptr, rowss, 0.5f};
        pg8::gemm_phase<pg8::EpiResid<false, 2>, pg8::StaticOrder, true>(F.lds + RING_OFF, g, S, E);
        } if (BOTH(11)) GRID_BAR();
    }
    if (IN(12)) { _Pragma("unroll") for (int rep = 0; rep < NREP(12); ++rep) { if (rep) GRID_BAR(); final_norm_phase(F); }  }
#undef IN
#undef BOTH
}

extern "C" void kernel_launch(void* const* d_in, const int* in_sizes, int n_in, void* d_out, int out_size, void* d_ws, size_t ws_size, hipStream_t stream) {
    static int grid = 0;
    if (grid == 0) {
        if (n_in != 26 || in_sizes[0] != T * D || out_size != T * D || ws_size < WS_END) { fprintf(stderr, "kernel_launch: unexpected shapes (n_in %d, in0 %d, out %d, ws %zu < %zu); nothing launched\n", n_in, n_in > 0 ? in_sizes[0] : -1, out_size, ws_size, (size_t)WS_END); grid = -1; return; }
        int dev = 0, cus = 0;
        if (hipGetDevice(&dev) != hipSuccess || hipDeviceGetAttribute(&cus, hipDeviceAttributeMultiprocessorCount, dev) != hipSuccess) { grid = -1; return; }
        if (hipFuncSetAttribute((const void*)hybrid_fwd, hipFuncAttributeMaxDynamicSharedMemorySize, LDS_BYTES) != hipSuccess) { fprintf(stderr, "kernel_launch: hipFuncSetAttribute failed\n"); grid = -1; return; }
        (void)hipGetLastError();
        grid = cus;
    }
    if (grid < 0) return;
    if (hipMemsetAsync((char*)d_ws + WS_CTL, 0, CTL_ZERO_BYTES, stream) != hipSuccess) return;
    Args a{};
    for (int i = 0; i < 26; ++i) a.in[i] = (const float*)d_in[i];
    a.out = (float*)d_out; a.ws = (unsigned char*)d_ws;
    for (int li = 0; li < MK_N_LAUNCHES; ++li) {
        a.ph_lo = (MK_N_LAUNCHES == 1) ? 0 : li; a.ph_hi = (MK_N_LAUNCHES == 1) ? N_PHASES : li + 1; a.li = li;
        hipLaunchKernelGGL(hybrid_fwd, dim3(grid), dim3(NWAVES * 64), LDS_BYTES, stream, a);
    }
}
```
